# Optimizing an MI355X kernel written in HIP

```python
import math
import jax, jax.numpy as jnp
from jax import lax
import numpy as np

D_MODEL = 1024
BATCH = 4
SEQ = 8192
DEPTH = 1

CHUNK = 64
Q_BLOCK = 128
ROPE_THETA = 10000.0
EPS = 1e-6

DA_HEADS = 4
DA_HEAD_DIM = 64
DA_V_DIM = 2 * DA_HEAD_DIM
DA_WIDTH = DA_HEADS * DA_V_DIM

SG_GROUPS = 4
SG_BLOCK = 128
SG_GROUP_DIM = 128
SG_WIDTH = SG_GROUPS * SG_GROUP_DIM

IN_WIDTH = 3 * DA_WIDTH + 2 * SG_WIDTH

PEER_HEADS = 8
PEER_NKEYS = 128
PEER_N_EXPERTS = PEER_NKEYS * PEER_NKEYS
PEER_KEY_DIM = 256
PEER_HALF = PEER_KEY_DIM // 2
PEER_TOPK = 16
PEER_TOKEN_BLOCK = 128

kernel_name = "chunk_causal_diffattn_sgu_peer_block"


def rmsnorm(x, g):
    xf = x.astype(jnp.float32)
    y = xf * lax.rsqrt(jnp.mean(xf * xf, axis=-1, keepdims=True) + EPS)
    return (y * g.astype(jnp.float32)).astype(x.dtype)


def layernorm(x, g, b):
    xf = x.astype(jnp.float32)
    mu = jnp.mean(xf, axis=-1, keepdims=True)
    xc = xf - mu
    y = xc * lax.rsqrt(jnp.mean(xc * xc, axis=-1, keepdims=True) + EPS)
    return (y * g.astype(jnp.float32) + b.astype(jnp.float32)).astype(x.dtype)


def rope_tables(seq, dim):
    inv = 1.0 / (ROPE_THETA ** (jnp.arange(0, dim, 2, dtype=jnp.float32) / dim))
    ang = jnp.arange(seq, dtype=jnp.float32)[:, None] * inv[None, :]
    return jnp.cos(ang), jnp.sin(ang)


def apply_rope(x, cos, sin):
    d2 = x.shape[-1] // 2
    x1, x2 = x[..., :d2], x[..., d2:]
    c = cos[None, :, None, None, :].astype(x.dtype)
    s = sin[None, :, None, None, :].astype(x.dtype)
    return jnp.concatenate([x1 * c - x2 * s, x1 * s + x2 * c], axis=-1)


def diff_attention(q, k, v, lam, subln_g, lambda_init):
    B, S, H, _, d = q.shape
    nblk = S // Q_BLOCK
    scale = d ** -0.5
    qb = q.reshape(B, nblk, Q_BLOCK, H, 2, d).transpose(1, 0, 2, 3, 4, 5)
    key_chunk = jnp.arange(S) // CHUNK

    def one_block(args):
        i, qi = args
        s = jnp.einsum('bqhcd,bkhcd->bhcqk', qi, k).astype(jnp.float32) * scale
        q_chunk = (i * Q_BLOCK + jnp.arange(Q_BLOCK)) // CHUNK
        mask = key_chunk[None, :] <= q_chunk[:, None]
        s = jnp.where(mask, s, -jnp.inf)
        p = jax.nn.softmax(s, axis=-1)
        a = p[:, :, 0] - lam * p[:, :, 1]
        return jnp.einsum('bhqk,bkhe->bqhe', a.astype(v.dtype), v)

    o = lax.map(one_block, (jnp.arange(nblk), qb))
    o = o.transpose(1, 0, 2, 3, 4).reshape(B, S, H, 2 * d)
    o = rmsnorm(o, subln_g) * (1.0 - lambda_init)
    return o.reshape(B, S, H * 2 * d)


def spatial_gating(u, v, ln_g, ln_b, w_s, b_s):
    B, S, _ = v.shape
    v = layernorm(v, ln_g, ln_b)
    n = S // SG_BLOCK
    vb = v.reshape(B, n, SG_BLOCK, SG_GROUPS, SG_GROUP_DIM)
    pc = jnp.arange(SG_BLOCK) // CHUNK
    mask = (pc[None, :] <= pc[:, None]).astype(w_s.dtype)
    s = jnp.einsum('gij,bnjgc->bnigc', w_s * mask[None], vb) + b_s.T[None, None, :, :, None]
    return u * s.reshape(B, S, SG_WIDTH)


def peer(h, w_q, sub_keys, u_tab, v_tab):
    B, S, D = h.shape
    T = B * S
    K = PEER_TOPK
    hf = h.reshape(T, D)
    q = (hf @ w_q).reshape(T, PEER_HEADS, 2, PEER_HALF)
    sc = jnp.einsum('thpc,hpkc->thpk', q, sub_keys).astype(jnp.float32)
    s1, i1 = lax.top_k(sc[:, :, 0], K)
    s2, i2 = lax.top_k(sc[:, :, 1], K)
    cand = (s1[..., :, None] + s2[..., None, :]).reshape(T, PEER_HEADS, K * K)
    cidx = (i1[..., :, None] * PEER_NKEYS + i2[..., None, :]).reshape(T, PEER_HEADS, K * K)
    top_s, pos = lax.top_k(cand, K)
    idx = jnp.take_along_axis(cidx, pos, axis=-1)
    g = jax.nn.softmax(top_s, axis=-1).astype(h.dtype)

    tb = PEER_TOKEN_BLOCK
    nb = T // tb
    HK = PEER_HEADS * K

    def one_block(args):
        xb, ib, gb = args
        a = jax.nn.gelu(jnp.einsum('td,ted->te', xb, u_tab[ib]), approximate=False)
        return jnp.einsum('te,ted->td', gb * a, v_tab[ib])

    out = lax.map(one_block, (hf.reshape(nb, tb, D), idx.reshape(nb, tb, HK), g.reshape(nb, tb, HK)))
    return out.reshape(B, S, D)


def setup_inputs(seed: int = 0) -> dict:
    key = jax.random.key(seed)
    ks = jax.random.split(key, 24)
    D = D_MODEL
    nrm = lambda k, shape, std: jax.random.normal(k, shape, jnp.float32) * std
    return {
        "x": nrm(ks[0], (BATCH, SEQ, D), 1.0),
        "norm1_g": 1.0 + nrm(ks[1], (DEPTH, D), 0.02),
        "w_in": nrm(ks[2], (DEPTH, D, IN_WIDTH), D ** -0.5),
        "lambda_q1": nrm(ks[3], (DEPTH, DA_HEAD_DIM), 0.1),
        "lambda_k1": nrm(ks[4], (DEPTH, DA_HEAD_DIM), 0.1),
        "lambda_q2": nrm(ks[5], (DEPTH, DA_HEAD_DIM), 0.1),
        "lambda_k2": nrm(ks[6], (DEPTH, DA_HEAD_DIM), 0.1),
        "subln_g": 1.0 + nrm(ks[7], (DEPTH, DA_V_DIM), 0.02),
        "sgu_ln_g": 1.0 + nrm(ks[8], (DEPTH, SG_WIDTH), 0.02),
        "sgu_ln_b": nrm(ks[9], (DEPTH, SG_WIDTH), 0.02),
        "w_spatial": nrm(ks[10], (DEPTH, SG_GROUPS, SG_BLOCK, SG_BLOCK), SG_BLOCK ** -0.5),
        "b_spatial": 1.0 + nrm(ks[11], (DEPTH, SG_GROUPS, SG_BLOCK), 0.02),
        "w_branch_a": nrm(ks[12], (DEPTH, DA_WIDTH, D), DA_WIDTH ** -0.5),
        "w_branch_b": nrm(ks[13], (DEPTH, SG_WIDTH, D), SG_WIDTH ** -0.5),
        "w_gate": nrm(ks[14], (DEPTH, D, 2 * D), D ** -0.5),
        "b_gate": nrm(ks[15], (DEPTH, 2 * D), 0.02),
        "w_out": nrm(ks[16], (DEPTH, D, D), D ** -0.5),
        "norm2_g": 1.0 + nrm(ks[17], (DEPTH, D), 0.02),
        "peer_wq": nrm(ks[18], (DEPTH, D, PEER_HEADS * PEER_KEY_DIM), D ** -0.5),
        "peer_subkeys": nrm(ks[19], (DEPTH, PEER_HEADS, 2, PEER_NKEYS, PEER_HALF), PEER_HALF ** -0.5),
        "peer_u": nrm(ks[20], (DEPTH, PEER_N_EXPERTS, D), D ** -0.5),
        "peer_v": nrm(ks[21], (DEPTH, PEER_N_EXPERTS, D), 0.5),
        "norm_f_g": 1.0 + nrm(ks[22], (D,), 0.02),
    }


def reference(x, norm1_g, w_in, lambda_q1, lambda_k1, lambda_q2, lambda_k2, subln_g,
              sgu_ln_g, sgu_ln_b, w_spatial, b_spatial, w_branch_a, w_branch_b,
              w_gate, b_gate, w_out, norm2_g, peer_wq, peer_subkeys, peer_u, peer_v,
              norm_f_g):
    B, S, D = x.shape
    cos, sin = rope_tables(S, DA_HEAD_DIM)
    for l in range(DEPTH):
        lambda_init = 0.8 - 0.6 * math.exp(-0.3 * l)
        h = rmsnorm(x, norm1_g[l])
        proj = h @ w_in[l]
        qa, ka, va, su, sv = jnp.split(proj, np.cumsum([DA_WIDTH, DA_WIDTH, DA_WIDTH, SG_WIDTH]).tolist(), axis=-1)
        qa = apply_rope(qa.reshape(B, S, DA_HEADS, 2, DA_HEAD_DIM), cos, sin)
        ka = apply_rope(ka.reshape(B, S, DA_HEADS, 2, DA_HEAD_DIM), cos, sin)
        va = va.reshape(B, S, DA_HEADS, DA_V_DIM)
        lam = (jnp.exp(jnp.sum(lambda_q1[l].astype(jnp.float32) * lambda_k1[l].astype(jnp.float32)))
               - jnp.exp(jnp.sum(lambda_q2[l].astype(jnp.float32) * lambda_k2[l].astype(jnp.float32)))
               + lambda_init)
        y_a = diff_attention(qa, ka, va, lam, subln_g[l], lambda_init)
        y_b = spatial_gating(jax.nn.gelu(su, approximate=False), jax.nn.gelu(sv, approximate=False),
                             sgu_ln_g[l], sgu_ln_b[l], w_spatial[l], b_spatial[l])
        gates = jax.nn.sigmoid(h @ w_gate[l] + b_gate[l]).reshape(B, S, 2, D)
        merged = gates[:, :, 0] * (y_a @ w_branch_a[l]) + gates[:, :, 1] * (y_b @ w_branch_b[l])
        x = x + merged @ w_out[l]
        x = x + peer(rmsnorm(x, norm2_g[l]), peer_wq[l], peer_subkeys[l], peer_u[l], peer_v[l])
    return rmsnorm(x, norm_f_g)
```

```cpp
#include <hip/hip_runtime.h>
#include <hip/hip_cooperative_groups.h>
#include <cstdio>
#include <cstdint>
namespace cg = cooperative_groups;

#ifndef DBG
#define DBG 0
#endif
#define ATT_AHEAD 4
namespace pg8 {
#define PG8_LAS __attribute__((address_space(3)))
typedef unsigned short bf16_t;
typedef short bf16x8 __attribute__((ext_vector_type(8)));
typedef float f32x4 __attribute__((ext_vector_type(4)));
typedef unsigned u32x4 __attribute__((ext_vector_type(4)));
constexpr int BM = 256, BK = 64, HALF = 128, HTB = HALF * BK * 2  , STAGE_BYTES = 8 * HTB, NXCD = 8, WGM = 8;

__host__ __device__ __forceinline__ int lds_byte(int r, int c) { const int st = (r >> 4) * 2 + (c >> 5), rr = r & 15, cc = c & 31, ob = rr * 64 + cc * 2; return st * 1024 + (ob ^ (((ob >> 9) & 1) << 5)); }
__host__ __device__ __forceinline__ void stage_rc(int b, int& R, int& C) { const int st = b / 1024, sb = b % 1024, swz = sb ^ (((sb >> 9) & 1) << 5); R = (st >> 1) * 16 + swz / 64; C = (st & 1) * 32 + (swz % 64) / 2; }
__host__ __device__ __forceinline__ int perm32(int rho) { const int n = rho >> 4, i = rho & 15; return 8 * (i >> 2) + 4 * n + (i & 3); }

struct Unit { int pm, pn; };
struct Gemm { const bf16_t* A; const bf16_t* Bt; int M, N, K; };

struct StaticOrder {
    int nM, nN, nwg, G, c;
    __host__ __device__ void init(int M, int N, int G_, int c_) { nM = M / BM; nN = N / BM; nwg = nM * nN; G = G_; c = c_; }
    __host__ __device__ bool next(int i, Unit& u) const {
        const long L = (long)i * G + c; if (L >= nwg) return false;
        int wgid = (int)L; { const int q = nwg / NXCD, r = nwg % NXCD, xcd = wgid % NXCD, off = wgid / NXCD; wgid = (xcd < r ? xcd * (q + 1) : r * (q + 1) + (xcd - r) * q) + off; }
        const int nig = WGM * nN, gid = wgid / nig, fm = gid * WGM, gsz = (nM - fm) < WGM ? (nM - fm) : WGM;
        u.pm = fm + ((wgid % nig) % gsz); u.pn = (wgid % nig) / gsz; return true;
    }
    __device__ __forceinline__ void a_ready(const Unit&) const {}
    __device__ __forceinline__ void done(const Unit&) const {}
};

__device__ __forceinline__ unsigned cvt_pk_bf16(float lo, float hi) { unsigned r; asm volatile("v_cvt_pk_bf16_f32 %0, %1, %2" : "=v"(r) : "v"(lo), "v"(hi)); return r; }
typedef float f32x2 __attribute__((ext_vector_type(2)));
__device__ __forceinline__ f32x2 gelu_pk(f32x2 v) {
    const f32x2 av = __builtin_elementwise_abs(v), d = av * 0.2316418882f + 1.0f;
    f32x2 t; t.x = __builtin_amdgcn_rcpf(d.x); t.y = __builtin_amdgcn_rcpf(d.y);
    f32x2 q = t * 0.5307027145f + (-0.7265760135f); q = q * t + 0.7107068705f; q = q * t + (-0.142248368f); q = q * t + 0.127414796f; q = q * t;
    const f32x2 s = (v * v) * (-0.72134752044f);
    f32x2 e; e.x = __builtin_amdgcn_exp2f(s.x); e.y = __builtin_amdgcn_exp2f(s.y);
    const f32x2 m = v * (q * e), r = v - m;
    f32x2 o; o.x = v.x < 0.f ? m.x : r.x; o.y = v.y < 0.f ? m.y : r.y; return o;
}

template <class Epi, class Sched, bool ALIGN_EPI = false, bool SP2 = false>
__device__ __forceinline__ void gemm_phase(PG8_LAS unsigned char* lds, const Gemm g, const Sched& S, const Epi& E) {
    int tid_ = threadIdx.x; asm volatile("" : "+v"(tid_));
    const int tid = tid_, wid = __builtin_amdgcn_readfirstlane(tid >> 6), lane = tid & 63, wr = wid >> 2, wc = wid & 3, fr = lane & 15, fq = lane >> 4;
    const int K = g.K, nt = K / BK;
    unsigned voffA[2], voffB[2];
#pragma unroll
    for (int i = 0; i < 2; ++i) { int R, C; stage_rc(tid * 16 + i * 8192, R, C); const int Rb = Epi::PERM ? ((R & ~31) + perm32(R & 31)) : R;
        voffA[i] = (unsigned)(R * K + C) * 2u; voffB[i] = (unsigned)(Rb * K + C) * 2u; }
    const size_t kstep = (size_t)(BK * 2);
    const size_t hstep = (size_t)HALF * K * 2;
    const size_t tstep = 2 * hstep;
    const unsigned ldsw = (unsigned)wid * 1024u;
    const int aoff = lds_byte(wr * 64 + fr, fq * 8), boff = lds_byte(wc * 32 + fr, fq * 8);
#define PG8_SA(b, h) (((b) * 2 + (h)) * HTB)
#define PG8_SB(b, h) ((4 + (b) * 2 + (h)) * HTB)
#define PG8_STAGE(bufoff, gbase, voff) do { _Pragma("unroll") for (int _i = 0; _i < 2; ++_i) \
        __builtin_amdgcn_global_load_lds((const unsigned*)((const char*)(gbase) + (voff)[_i]), (PG8_LAS unsigned*)(lds + (bufoff) + ldsw + _i * 8192), 16, 0, 0); } while (0)
#define PG8_LDA(dst, b, h) do { _Pragma("unroll") for (int m = 0; m < 4; ++m) _Pragma("unroll") for (int k = 0; k < 2; ++k) dst[m][k] = *(const PG8_LAS bf16x8*)(lds + PG8_SA(b, h) + aoff + m * 2048 + k * 1024); } while (0)
#define PG8_LDB(dst, b, h) do { _Pragma("unroll") for (int n = 0; n < 2; ++n) _Pragma("unroll") for (int k = 0; k < 2; ++k) dst[n][k] = *(const PG8_LAS bf16x8*)(lds + PG8_SB(b, h) + boff + n * 2048 + k * 1024); } while (0)
#define PG8_MMA(ai, bj, At, Bt) do { __builtin_amdgcn_s_setprio(1); _Pragma("unroll") for (int m = 0; m < 4; ++m) _Pragma("unroll") for (int n = 0; n < 2; ++n) _Pragma("unroll") for (int k = 0; k < 2; ++k) \
        acc[ai][bj][m][n] = __builtin_amdgcn_mfma_f32_16x16x32_bf16(Bt[n][k], At[m][k], acc[ai][bj][m][n], 0, 0, 0); __builtin_amdgcn_s_setprio(0); } while (0)
#define PG8_WAIT_V(n) asm volatile("s_waitcnt vmcnt(" #n ")" ::: "memory")
#define PG8_WAIT_L(n) asm volatile("s_waitcnt lgkmcnt(" #n ")" ::: "memory")
#define PG8_BAR __builtin_amdgcn_s_barrier()
#define PG8_SCHED __builtin_amdgcn_sched_barrier(0)
    Unit cur, nxt; int ui = 0;
    if (!S.next(0, cur)) return;
    f32x4 acc[2][2][4][2];
#pragma unroll
    for (int a = 0; a < 2; ++a)
#pragma unroll
        for (int b = 0; b < 2; ++b)
#pragma unroll
            for (int m = 0; m < 4; ++m)
#pragma unroll
                for (int n = 0; n < 2; ++n) acc[a][b][m][n] = (f32x4){0.f, 0.f, 0.f, 0.f};
    bf16x8 At[4][2], B0[2][2], B1[2][2];
    const char* cA = (const char*)g.A + (size_t)cur.pm * tstep; const char* cB = (const char*)g.Bt + (size_t)cur.pn * tstep;
    S.a_ready(cur);
    if constexpr (SP2) {
        PG8_STAGE(PG8_SB(0, 0), cB, voffB); PG8_STAGE(PG8_SB(0, 1), cB + hstep, voffB); PG8_STAGE(PG8_SA(0, 0), cA, voffA); PG8_STAGE(PG8_SA(0, 1), cA + hstep, voffA);
        if (wr == 1) PG8_BAR;
        PG8_WAIT_V(2); PG8_BAR;
        PG8_STAGE(PG8_SB(1, 0), cB + kstep, voffB); PG8_STAGE(PG8_SA(1, 0), cA + kstep, voffA); PG8_STAGE(PG8_SB(1, 1), cB + hstep + kstep, voffB);
        PG8_WAIT_V(6); PG8_BAR;
    } else {
        PG8_STAGE(PG8_SB(0, 0), cB, voffB); PG8_STAGE(PG8_SA(0, 0), cA, voffA); PG8_STAGE(PG8_SB(0, 1), cB + hstep, voffB); PG8_STAGE(PG8_SA(0, 1), cA + hstep, voffA);
        if (wr == 1) PG8_BAR;
        PG8_WAIT_V(4); PG8_BAR;
        PG8_STAGE(PG8_SB(1, 0), cB + kstep, voffB); PG8_STAGE(PG8_SA(1, 0), cA + kstep, voffA); PG8_STAGE(PG8_SB(1, 1), cB + hstep + kstep, voffB);
        PG8_WAIT_V(6); PG8_BAR;
    }
    for (;;) {
        const bool has_next = S.next(ui + 1, nxt);
        const char* nA = has_next ? (const char*)g.A + (size_t)nxt.pm * tstep : cA; const char* nB = has_next ? (const char*)g.Bt + (size_t)nxt.pn * tstep : cB;
        for (int t = 0; t < nt; t += 2) {
            const bool last = (t == nt - 2);
            const char* a1 = cA + (size_t)(t + 1) * kstep;
            const char* a2 = last ? nA : cA + (size_t)(t + 2) * kstep; const char* b2 = last ? nB : cB + (size_t)(t + 2) * kstep;
            const char* a3 = a2 + kstep; const char* b3 = b2 + kstep;
            if (last && has_next) S.a_ready(nxt);
            if constexpr (SP2) {
            PG8_LDB(B0, 0, 0); PG8_LDB(B1, 0, 1); PG8_SCHED; PG8_LDA(At, 0, 0); PG8_STAGE(PG8_SA(1, 1), a1 + hstep, voffA);
            PG8_WAIT_V(8); PG8_WAIT_L(0); PG8_BAR; PG8_MMA(0, 0, At, B0); PG8_MMA(0, 1, At, B1); PG8_BAR; PG8_SCHED;
            PG8_LDA(At, 0, 1); PG8_STAGE(PG8_SB(0, 0), b2, voffB); PG8_STAGE(PG8_SB(0, 1), b2 + hstep, voffB); PG8_STAGE(PG8_SA(0, 0), a2, voffA);
            PG8_WAIT_V(8); PG8_WAIT_L(0); PG8_BAR; PG8_MMA(1, 0, At, B0); PG8_MMA(1, 1, At, B1); PG8_BAR; PG8_SCHED;
            PG8_LDB(B0, 1, 0); PG8_LDB(B1, 1, 1); PG8_SCHED; PG8_LDA(At, 1, 0); PG8_STAGE(PG8_SA(0, 1), a2 + hstep, voffA);
            PG8_WAIT_V(8); PG8_WAIT_L(0); PG8_BAR; PG8_MMA(0, 0, At, B0); PG8_MMA(0, 1, At, B1); PG8_BAR; PG8_SCHED;
            PG8_LDA(At, 1, 1); PG8_STAGE(PG8_SB(1, 0), b3, voffB); PG8_STAGE(PG8_SB(1, 1), b3 + hstep, voffB); PG8_STAGE(PG8_SA(1, 0), a3, voffA);
            PG8_WAIT_V(8); PG8_WAIT_L(0); PG8_BAR; PG8_MMA(1, 0, At, B0); PG8_MMA(1, 1, At, B1); PG8_BAR; PG8_SCHED;
            } else {
            PG8_LDB(B0, 0, 0); PG8_SCHED; PG8_LDA(At, 0, 0); PG8_STAGE(PG8_SA(1, 1), a1 + hstep, voffA);
            PG8_WAIT_L(8); PG8_BAR; PG8_WAIT_L(0); PG8_MMA(0, 0, At, B0); PG8_BAR; PG8_SCHED;
            PG8_LDB(B1, 0, 1); PG8_STAGE(PG8_SB(0, 0), b2, voffB);
            PG8_BAR; PG8_WAIT_L(0); PG8_MMA(0, 1, At, B1); PG8_BAR;
            PG8_LDA(At, 0, 1); PG8_STAGE(PG8_SA(0, 0), a2, voffA);
            PG8_BAR; PG8_WAIT_L(0); PG8_MMA(1, 0, At, B0); PG8_BAR; PG8_SCHED;
            PG8_STAGE(PG8_SB(0, 1), b2 + hstep, voffB);
            PG8_WAIT_V(6); PG8_BAR; PG8_MMA(1, 1, At, B1); PG8_BAR;
            PG8_LDB(B0, 1, 0); PG8_SCHED; PG8_LDA(At, 1, 0); PG8_STAGE(PG8_SA(0, 1), a2 + hstep, voffA);
            PG8_WAIT_L(8); PG8_BAR; PG8_WAIT_L(0); PG8_MMA(0, 0, At, B0); PG8_BAR; PG8_SCHED;
            PG8_LDB(B1, 1, 1); PG8_STAGE(PG8_SB(1, 0), b3, voffB);
            PG8_BAR; PG8_WAIT_L(0); PG8_MMA(0, 1, At, B1); PG8_BAR;
            PG8_LDA(At, 1, 1); PG8_STAGE(PG8_SA(1, 0), a3, voffA);
            PG8_BAR; PG8_WAIT_L(0); PG8_MMA(1, 0, At, B0); PG8_BAR; PG8_SCHED;
            PG8_STAGE(PG8_SB(1, 1), b3 + hstep, voffB);
            PG8_WAIT_V(6); PG8_BAR; PG8_MMA(1, 1, At, B1); PG8_BAR;
            }
        }
        if constexpr (ALIGN_EPI) { if (wr == 0) PG8_BAR; }
        if constexpr (!Epi::AFTER_DRAIN) { E(acc, cur, wr, wc, fr, fq); S.done(cur); }
        if (!has_next) break;
#pragma unroll
        for (int a = 0; a < 2; ++a)
#pragma unroll
            for (int b = 0; b < 2; ++b)
#pragma unroll
                for (int m = 0; m < 4; ++m)
#pragma unroll
                    for (int n = 0; n < 2; ++n) acc[a][b][m][n] = (f32x4){0.f, 0.f, 0.f, 0.f};
        cur = nxt; cA = nA; cB = nB; ++ui;
        if constexpr (ALIGN_EPI) { if (wr == 1) PG8_BAR; }
    }
    PG8_WAIT_V(0);
    if constexpr (!ALIGN_EPI) { if (wr == 0) PG8_BAR; }
    PG8_BAR;
    if constexpr (Epi::AFTER_DRAIN) { E.fused(acc, cur, wr, wc, fr, fq, lds, wid, lane); S.done(cur); }
#undef PG8_SA
#undef PG8_SB
#undef PG8_STAGE
#undef PG8_LDA
#undef PG8_LDB
#undef PG8_MMA
#undef PG8_WAIT_V
#undef PG8_WAIT_L
#undef PG8_BAR
#undef PG8_SCHED
}
}
constexpr int NB = 4, SEQ = 8192, DM = 1024, T = NB * SEQ;
constexpr int HW = 512;
constexpr int N1 = 4608;
constexpr int NEXP = 16384, PK_TOP = 16, PK_HEADS = 8;
constexpr float EPS = 1e-6f;
constexpr float QSCALE = 0.125f * 1.4426950408889634f;
constexpr float LAMBDA_INIT = 0.2f;

constexpr size_t MiB = 1u << 20;
constexpr size_t WS_CTL = 0, CTL_ZERO_BYTES = 65536;
constexpr int CW_BAR = 1024;
constexpr size_t WS_W1T = 2 * MiB;
constexpr size_t WS_WAB = 11 * MiB;
constexpr size_t WS_WO2 = 13 * MiB;
constexpr size_t WS_WEF = 17 * MiB;
constexpr size_t WS_ROPE = 21 * MiB;
constexpr size_t WS_WSM = 23 * MiB;
constexpr size_t WS_MISC = 23 * MiB + 512 * 1024;
constexpr size_t WS_UQ = 24 * MiB;
constexpr size_t WS_VQ = 40 * MiB;
constexpr size_t WS_SUQ = 56 * MiB;
constexpr size_t WS_XB = 88 * MiB;
constexpr size_t WS_Q = 152 * MiB;
constexpr size_t WS_SU = 184 * MiB;
constexpr size_t WS_GATES = 216 * MiB;
constexpr size_t WS_K = 344 * MiB;
constexpr size_t WS_V = 376 * MiB;
constexpr size_t WS_SV = 408 * MiB;
constexpr size_t WS_G = 344 * MiB;
constexpr size_t WS_SCORES = 152 * MiB;
constexpr size_t WS_SSQ = 472 * MiB;
constexpr size_t WS_IDX = 474 * MiB;
constexpr size_t WS_GW = 490 * MiB;
constexpr size_t WS_PART = 152 * MiB;
constexpr size_t WS_COEF = 280 * MiB;
constexpr size_t WS_X1Q = 408 * MiB;
constexpr size_t WS_X1S = 440 * MiB;
constexpr size_t WS_IDX16 = 444 * MiB;
constexpr size_t WS_YB = 216 * MiB;
constexpr size_t WS_SSQ2 = 296 * MiB;
constexpr size_t WS_END = 506 * MiB;
static_assert(WS_SCORES + (size_t)T * 2048 * 4 <= WS_SSQ && WS_G + (size_t)T * 2048 * 2 <= WS_SSQ, "ws map");

constexpr int RING_BYTES = 131072;
constexpr int BAR_LDS_OFF = 147456 - 64;
constexpr int LDS_BYTES = 147456;
constexpr int NWAVES = 8;

#define GAS __attribute__((address_space(1)))
#define LAS __attribute__((address_space(3)))
typedef unsigned short bf16;
typedef unsigned v4u __attribute__((ext_vector_type(4)));
typedef unsigned v2u __attribute__((ext_vector_type(2)));
typedef float f32x4 __attribute__((ext_vector_type(4)));
typedef float f32x2 __attribute__((ext_vector_type(2)));
typedef float f32x16 __attribute__((ext_vector_type(16)));
typedef short bf16x8 __attribute__((ext_vector_type(8)));
typedef short s16x4 __attribute__((ext_vector_type(4)));
#define LDS_WAIT() asm volatile("s_waitcnt lgkmcnt(0)" ::: "memory")
#define VM_WAIT() asm volatile("s_waitcnt vmcnt(0)" ::: "memory")
#define CFENCE() asm volatile("" ::: "memory")
__device__ __forceinline__ unsigned f2bf(float f) { unsigned u = __builtin_bit_cast(unsigned, f); return (u + 0x7fffu + ((u >> 16) & 1u)) >> 16; }
__device__ __forceinline__ unsigned pk2(float lo, float hi) { return f2bf(lo) | (f2bf(hi) << 16); }
typedef __bf16 bf16x2_t __attribute__((ext_vector_type(2)));
__device__ __forceinline__ unsigned cvtpk(float lo, float hi) { const f32x2 v = {lo, hi}; const bf16x2_t b = __builtin_convertvector(v, bf16x2_t); return __builtin_bit_cast(unsigned, b); }
__device__ __forceinline__ float bf_lo(unsigned w) { return __builtin_bit_cast(float, w << 16); }
__device__ __forceinline__ float bf_hi(unsigned w) { return __builtin_bit_cast(float, w & 0xffff0000u); }
__device__ __forceinline__ float bf2f(bf16 b) { return __builtin_bit_cast(float, (unsigned)b << 16); }
__device__ __forceinline__ float wave_sum(float v) {
#pragma unroll
    for (int o = 1; o < 64; o <<= 1) v += __shfl_xor(v, o);
    return v;
}
__device__ __forceinline__ float gelu1(float v) {
    const float av = __builtin_fabsf(v), t = __builtin_amdgcn_rcpf(av * 0.2316418882f + 1.0f);
    float q = t * 0.5307027145f + (-0.7265760135f); q = q * t + 0.7107068705f; q = q * t + (-0.142248368f); q = q * t + 0.127414796f; q = q * t;
    const float e = __builtin_amdgcn_exp2f((v * v) * (-0.72134752044f));
    const float m = v * (q * e);
    return v < 0.f ? m : v - m;
}

struct Frame {
    LAS unsigned char* lds;
    int tid, lane, wave, vcu, G;
    const float* in[23]; float* out; unsigned char* ws;
};

__device__ __forceinline__ int rowmap_fn(int n, int rowmode, int row_off) {
    if (rowmode == 1 && n < 1024) return (n & ~63) | (2 * (n & 31) + ((n >> 5) & 1));
    return row_off + n;
}
__device__ __forceinline__ void p0_transpose_item(const float* W, int N, bf16* WT, int ldt, int koff, int rowmode, int row_off, LAS float* scr, int item, int lane) {
    const int nblk = N / 32, kb = item / nblk, nb = item % nblk, k0 = 64 * kb, n0 = 32 * nb;
#pragma unroll 8
    for (int i = 0; i < 32; ++i) { const int kk = 2 * i + (lane >> 5); scr[kk * 33 + (lane & 31)] = W[(size_t)(k0 + kk) * N + n0 + (lane & 31)]; }
    LDS_WAIT(); CFENCE();
    const int c = lane & 7;
#pragma unroll
    for (int j = 0; j < 4; ++j) { const int n = (lane >> 3) + 8 * j; const LAS float* s = scr + (8 * c) * 33 + n;
        v4u o; o.x = pk2(s[0 * 33], s[1 * 33]); o.y = pk2(s[2 * 33], s[3 * 33]); o.z = pk2(s[4 * 33], s[5 * 33]); o.w = pk2(s[6 * 33], s[7 * 33]);
        *(v4u*)(WT + (size_t)rowmap_fn(n0 + n, rowmode, row_off) * ldt + koff + k0 + 8 * c) = o; }
    LDS_WAIT(); CFENCE();
}

__device__ __forceinline__ void table_row_store(unsigned char* ws, const f32x4 (&v)[4], bool isu, int e, int lane) {
    float am = 0.f;
#pragma unroll
    for (int j = 0; j < 4; ++j) am = fmaxf(am, fmaxf(fmaxf(fabsf(v[j][0]), fabsf(v[j][1])), fmaxf(fabsf(v[j][2]), fabsf(v[j][3]))));
    { int iv = __builtin_bit_cast(int, am);
      iv = max(iv, __builtin_amdgcn_mov_dpp(iv, 0xB1, 0xF, 0xF, true)); iv = max(iv, __builtin_amdgcn_mov_dpp(iv, 0x4E, 0xF, 0xF, true));
      iv = max(iv, __builtin_amdgcn_mov_dpp(iv, 0x141, 0xF, 0xF, true)); iv = max(iv, __builtin_amdgcn_mov_dpp(iv, 0x140, 0xF, 0xF, true));
      iv = max(max(__builtin_amdgcn_readlane(iv, 0), __builtin_amdgcn_readlane(iv, 16)), max(__builtin_amdgcn_readlane(iv, 32), __builtin_amdgcn_readlane(iv, 48)));
      am = __builtin_bit_cast(float, iv); }
    v4u q;
    if (isu) {
        const float sc = am > 0.f ? 127.0f / am : 0.f;
        unsigned wq[4];
#pragma unroll
        for (int j = 0; j < 4; ++j) wq[j] = ((unsigned)__float2int_rn(v[j][0] * sc) & 0xffu) | (((unsigned)__float2int_rn(v[j][1] * sc) & 0xffu) << 8) | (((unsigned)__float2int_rn(v[j][2] * sc) & 0xffu) << 16) | (((unsigned)__float2int_rn(v[j][3] * sc) & 0xffu) << 24);
        q = (v4u){wq[0], wq[1], wq[2], wq[3]};
    } else {
        const float sc = am > 0.f ? 224.0f / am : 0.f;
        { int w = 0; w = __builtin_amdgcn_cvt_pk_fp8_f32(v[0][0] * sc, v[0][1] * sc, w, false); w = __builtin_amdgcn_cvt_pk_fp8_f32(v[0][2] * sc, v[0][3] * sc, w, true); q.x = (unsigned)w; }
        { int w = 0; w = __builtin_amdgcn_cvt_pk_fp8_f32(v[1][0] * sc, v[1][1] * sc, w, false); w = __builtin_amdgcn_cvt_pk_fp8_f32(v[1][2] * sc, v[1][3] * sc, w, true); q.y = (unsigned)w; }
        { int w = 0; w = __builtin_amdgcn_cvt_pk_fp8_f32(v[2][0] * sc, v[2][1] * sc, w, false); w = __builtin_amdgcn_cvt_pk_fp8_f32(v[2][2] * sc, v[2][3] * sc, w, true); q.z = (unsigned)w; }
        { int w = 0; w = __builtin_amdgcn_cvt_pk_fp8_f32(v[3][0] * sc, v[3][1] * sc, w, false); w = __builtin_amdgcn_cvt_pk_fp8_f32(v[3][2] * sc, v[3][3] * sc, w, true); q.w = (unsigned)w; }
    }
    *(v4u*)(ws + (isu ? WS_UQ : WS_VQ) + (size_t)(lane >> 3) * (NEXP * 128) + (size_t)e * 128 + 16 * (lane & 7)) = q;
    if (lane == 0) ((float*)(ws + WS_SUQ))[2 * e + (isu ? 0 : 1)] = am * (isu ? (1.0f / 127.0f) : (1.0f / 224.0f));
}

__device__ __forceinline__ void p0_prologue(Frame& F) {
    unsigned char* ws = F.ws;
    const int gw = F.vcu * NWAVES + F.wave, NGW = F.G * NWAVES;
    const int gt = F.vcu * (NWAVES * 64) + F.tid, NGT = F.G * NWAVES * 64;
    {
        LAS float* scr = (LAS float*)(F.lds + F.wave * 16384);
        bf16* W1T = (bf16*)(ws + WS_W1T); bf16* WAB = (bf16*)(ws + WS_WAB); bf16* WO2 = (bf16*)(ws + WS_WO2);
        constexpr int I_IN = 16 * 80, I_GT = 16 * 64, I_A = 8 * 32, I_B = 8 * 32, I_O = 16 * 32;
        constexpr int NIT = I_IN + I_GT + I_A + I_B + I_O;
        for (int it = gw; it < NIT; it += NGW) {
            int r = it;
            if (r < I_IN) { p0_transpose_item(F.in[2], 2560, W1T, 1024, 0, 1, 0, scr, r, F.lane); continue; } r -= I_IN;
            if (r < I_GT) { p0_transpose_item(F.in[14], 2048, W1T, 1024, 0, 0, 2560, scr, r, F.lane); continue; } r -= I_GT;
            if (r < I_A) { p0_transpose_item(F.in[12], 1024, WAB, 512, 0, 0, 0, scr, r, F.lane); continue; } r -= I_A;
            if (r < I_B) { p0_transpose_item(F.in[13], 1024, WAB, 512, 0, 0, 1024, scr, r, F.lane); continue; } r -= I_B;
            p0_transpose_item(F.in[16], 1024, WO2, 1024, 0, 0, 0, scr, r, F.lane);
        }
    }
    __syncthreads();
    {
        const float* wq = F.in[18]; const float* keys = F.in[19]; const float* g2 = F.in[17];
        bf16* WEF = (bf16*)(ws + WS_WEF);
        const int r32 = F.lane & 31, hi = F.lane >> 5;
        for (int task = gw; task < 16 * 4 * 32; task += NGW) {
            const int hp = task >> 7, k0 = ((task >> 5) & 3) * 32, d0 = (task & 31) * 32;
            const float* ap = keys + (size_t)(hp * 128 + k0 + r32) * 128 + 8 * hi;
            const float* bp = wq + (size_t)(d0 + r32) * 2048 + hp * 128 + 8 * hi;
            f32x16 acc = (f32x16){};
#pragma unroll 1
            for (int half = 0; half < 2; ++half) {
                f32x4 av[8], bv[8];
#pragma unroll
                for (int s = 0; s < 4; ++s) { av[2 * s] = *(const f32x4*)(ap + 16 * (4 * half + s)); av[2 * s + 1] = *(const f32x4*)(ap + 16 * (4 * half + s) + 4);
                    bv[2 * s] = *(const f32x4*)(bp + 16 * (4 * half + s)); bv[2 * s + 1] = *(const f32x4*)(bp + 16 * (4 * half + s) + 4); }
#pragma unroll
                for (int s = 0; s < 4; ++s) {
                    unsigned ah[4], al[4], bh[4], bl[4];
#pragma unroll
                    for (int q = 0; q < 4; ++q) { const f32x4 a4 = av[2 * s + (q >> 1)], b4 = bv[2 * s + (q >> 1)]; const int e = (q & 1) * 2;
                        const unsigned ha = cvtpk(a4[e], a4[e + 1]), hb = cvtpk(b4[e], b4[e + 1]);
                        ah[q] = ha; bh[q] = hb;
                        al[q] = cvtpk(a4[e] - bf_lo(ha), a4[e + 1] - bf_hi(ha)); bl[q] = cvtpk(b4[e] - bf_lo(hb), b4[e + 1] - bf_hi(hb)); }
                    const bf16x8 Ah = __builtin_bit_cast(bf16x8, (v4u){ah[0], ah[1], ah[2], ah[3]}), Al = __builtin_bit_cast(bf16x8, (v4u){al[0], al[1], al[2], al[3]});
                    const bf16x8 Bh = __builtin_bit_cast(bf16x8, (v4u){bh[0], bh[1], bh[2], bh[3]}), Bl = __builtin_bit_cast(bf16x8, (v4u){bl[0], bl[1], bl[2], bl[3]});
                    acc = __builtin_amdgcn_mfma_f32_32x32x16_bf16(Ah, Bh, acc, 0, 0, 0);
                    acc = __builtin_amdgcn_mfma_f32_32x32x16_bf16(Ah, Bl, acc, 0, 0, 0);
                    acc = __builtin_amdgcn_mfma_f32_32x32x16_bf16(Al, Bh, acc, 0, 0, 0);
                }
            }
            const float gd = g2[d0 + r32];
#pragma unroll
            for (int r = 0; r < 16; ++r) { const int k = k0 + (r & 3) + 8 * (r >> 2) + 4 * hi;
                WEF[(size_t)(hp * 128 + k) * 1024 + d0 + r32] = (bf16)f2bf(acc[r] * gd); }
        }
    }
    {
        const float* x = F.in[0]; const float* g1 = F.in[1]; bf16* XB = (bf16*)(ws + WS_XB);
        f32x4 gv[4];
#pragma unroll
        for (int j = 0; j < 4; ++j) gv[j] = *((const f32x4*)g1 + F.lane + 64 * j);
        for (int m = gw; m < T; m += NGW) {
            const f32x4* xr = (const f32x4*)(x + (size_t)m * DM) + F.lane;
            f32x4 v[4]; float s = 0.f;
#pragma unroll
            for (int j = 0; j < 4; ++j) { v[j] = xr[64 * j]; s += (v[j].x * v[j].x + v[j].y * v[j].y) + (v[j].z * v[j].z + v[j].w * v[j].w); }
            const float rstd = 1.0f / sqrtf(wave_sum(s) * (1.f / DM) + EPS);
            unsigned long long* o8 = (unsigned long long*)(XB + (size_t)m * DM) + F.lane;
#pragma unroll
            for (int j = 0; j < 4; ++j) o8[64 * j] = (unsigned long long)pk2(v[j].x * rstd * gv[j].x, v[j].y * rstd * gv[j].y) | ((unsigned long long)pk2(v[j].z * rstd * gv[j].z, v[j].w * rstd * gv[j].w) << 32);
        }
    }
    {
        float* rope = (float*)(ws + WS_ROPE);
        for (int i = gt; i < SEQ * 32; i += NGT) {
            const int pos = i >> 5, j = i & 31;
            const float inv = 1.0f / powf(10000.0f, (float)(2 * j) * (1.0f / 64.0f));
            const float ang = (float)pos * inv;
            double rv = (double)ang * 0.15915494309189535; rv -= floor(rv);
            const float fr = (float)rv; const float sn = __builtin_amdgcn_sinf(fr), cs = __builtin_amdgcn_cosf(fr);
            *(f32x2*)(rope + 2 * (size_t)i) = (f32x2){cs, sn};
        }
        const float* wsp = F.in[10]; bf16* WSM = (bf16*)(ws + WS_WSM);
        for (int i = gt; i < 4 * 128 * 128; i += NGT) { const int ii = (i >> 7) & 127, jj = i & 127; WSM[i] = (bf16)f2bf(((jj >> 6) <= (ii >> 6)) ? wsp[i] : 0.f); }
        if (F.vcu == 0 && F.wave == 0) {
            const float p1 = F.in[3][F.lane] * F.in[4][F.lane], p2 = F.in[5][F.lane] * F.in[6][F.lane];
            const float s1 = wave_sum(p1), s2 = wave_sum(p2);
            if (F.lane == 0) ((float*)(ws + WS_MISC))[0] = expf(s1) - expf(s2) + LAMBDA_INIT;
        }
    }
}
#define XB_TMO      128
#define XB_XCNT(j)  (256  + 64 * (j))
#define XB_XSUB(j)  (1280 + 64 * (j))
#define XB_XGEN(j)  (2304 + 64 * (j))
#define XB_TOP      3328
#define XB_TOPGEN   3392
#define XCD_BAR_WORDS 3456
#define XB_SPIN_CAP (1u << 22)

__device__ __forceinline__ unsigned xb_ld(unsigned* p)              { return __hip_atomic_load(p, __ATOMIC_RELAXED, __HIP_MEMORY_SCOPE_AGENT); }
__device__ __forceinline__ unsigned xb_add(unsigned* p, unsigned v) { return __hip_atomic_fetch_add(p, v, __ATOMIC_RELAXED, __HIP_MEMORY_SCOPE_AGENT); }
__device__ __forceinline__ unsigned xb_xcc_id() { return (unsigned)__builtin_amdgcn_s_getreg((3 << 11) | 20) & 0xFu; }
#define XB_SPIN(cond, bar) do { unsigned _sp = 0; while (cond) { __builtin_amdgcn_s_sleep(1); \
    if ((++_sp & 255u) == 0u) { if (xb_ld(&(bar)[XB_TMO])) break; if (_sp > XB_SPIN_CAP) { atomicAdd(&(bar)[XB_TMO], 1u); break; } } } } while (0)

struct XcdBarrier {
    unsigned* bar; unsigned x;
    volatile LAS unsigned* st;
};

__device__ __forceinline__ XcdBarrier xcd_barrier_post(unsigned* bar, volatile LAS unsigned* st) {
    XcdBarrier b; b.bar = bar; b.x = xb_xcc_id(); b.st = st;
    if (threadIdx.x == 0) (void)xb_add(&bar[XB_XCNT(b.x)], 1u);
    return b;
}
__device__ __forceinline__ void xcd_barrier_complete(unsigned* bar, unsigned x, unsigned& nloc, unsigned& nx) {
    const unsigned G = gridDim.x * gridDim.y * gridDim.z;
    unsigned sum, cnt, mine, sp = 0u;
    for (;;) {
        sum = 0u; cnt = 0u; mine = 0u;
#pragma unroll
        for (unsigned j = 0; j < 16; ++j) { const unsigned c = xb_ld(&bar[XB_XCNT(j)]); sum += c; cnt += (c > 0u) ? 1u : 0u; mine = (j == x) ? c : mine; }
        if (sum == G) break;
        __builtin_amdgcn_s_sleep(1);
        if ((++sp & 255u) == 0u) { if (xb_ld(&bar[XB_TMO])) break; if (sp > XB_SPIN_CAP) { atomicAdd(&bar[XB_TMO], 1u); break; } }
    }
    nloc = mine > 0u ? mine : 1u; nx = cnt > 0u ? cnt : 1u;
}

__device__ __forceinline__ void xcd_barrier(const XcdBarrier& b) {
    asm volatile("s_waitcnt vmcnt(0)" ::: "memory");
    __syncthreads();
    if (threadIdx.x == 0) {
        unsigned* bar = b.bar;
        __builtin_amdgcn_s_waitcnt(0);
        unsigned nloc = b.st[0], nx = b.st[1];
        if (nloc == 0u) { xcd_barrier_complete(bar, b.x, nloc, nx); b.st[0] = nloc; b.st[1] = nx; }
        const unsigned old = xb_add(&bar[XB_XSUB(b.x)], 1u);
        const unsigned gen = old / nloc;
        if (old + 1u == (gen + 1u) * nloc) {
            __builtin_amdgcn_fence(__ATOMIC_RELEASE, "agent");
            asm volatile("s_waitcnt vmcnt(0)" ::: "memory");
            const unsigned og = xb_add(&bar[XB_TOP], 1u);
            const unsigned tg = og / nx;
            if (og + 1u == (tg + 1u) * nx) xb_add(&bar[XB_TOPGEN], 1u);
            else XB_SPIN(xb_ld(&bar[XB_TOPGEN]) == tg, bar);
            __builtin_amdgcn_fence(__ATOMIC_ACQUIRE, "agent");
            xb_add(&bar[XB_XGEN(b.x)], 1u);
            asm volatile("s_waitcnt vmcnt(0)" ::: "memory");
        } else {
            XB_SPIN(xb_ld(&bar[XB_XGEN(b.x)]) == gen, bar);
            __builtin_amdgcn_fence(__ATOMIC_ACQUIRE, "agent");
            asm volatile("s_waitcnt vmcnt(0)" ::: "memory");
        }
    }
    __syncthreads();
}
__device__ __forceinline__ v4u pack8(const f32x4 a, const f32x4 b) { v4u w; w.x = cvtpk(a[0], a[1]); w.y = cvtpk(a[2], a[3]); w.z = cvtpk(b[0], b[1]); w.w = cvtpk(b[2], b[3]); return w; }

struct EpiP1 {
    static constexpr bool PERM = true, AFTER_DRAIN = false;
    unsigned char* ws; const float* bgate; const float* rope;
    __device__ __forceinline__ void operator()(const f32x4 (&acc)[2][2][4][2], const pg8::Unit& u, int wr, int wc, int fr, int fq) const {
        const int row0 = u.pm * 256 + wr * 64 + fr, pn = u.pn, ct = wc * 32 + 8 * fq;
        if (pn < 4) {
            bf16* dst = (bf16*)(ws + (pn < 2 ? WS_Q : WS_K)); const float sc = pn < 2 ? QSCALE : 1.0f; const int cb = (pn & 1) * 256 + ct; const bool hm = pn >= 2;
#pragma unroll
            for (int ai = 0; ai < 2; ++ai)
#pragma unroll
                for (int m = 0; m < 4; ++m) { const int row = row0 + ai * 128 + m * 16, pos = row & (SEQ - 1);
#pragma unroll
                    for (int bj = 0; bj < 2; ++bj) { const int col = cb + bj * 128, i0 = (col & 63) >> 1;
                        const f32x4 r0 = *(const f32x4*)(rope + (size_t)(pos * 32 + i0) * 2), r1 = *(const f32x4*)(rope + (size_t)(pos * 32 + i0 + 2) * 2);
                        const f32x4 a = acc[ai][bj][m][0], b = acc[ai][bj][m][1]; f32x4 oa, ob;
                        oa[0] = (a[0] * r0[0] - a[1] * r0[1]) * sc; oa[1] = (a[0] * r0[1] + a[1] * r0[0]) * sc;
                        oa[2] = (a[2] * r0[2] - a[3] * r0[3]) * sc; oa[3] = (a[2] * r0[3] + a[3] * r0[2]) * sc;
                        ob[0] = (b[0] * r1[0] - b[1] * r1[1]) * sc; ob[1] = (b[0] * r1[1] + b[1] * r1[0]) * sc;
                        ob[2] = (b[2] * r1[2] - b[3] * r1[3]) * sc; ob[3] = (b[2] * r1[3] + b[3] * r1[2]) * sc;
                        const size_t off = hm ? ((size_t)(((row >> 13) * 4 + (col >> 7)) * SEQ + pos) * 128 + (col & 127)) : ((size_t)row * HW + col);
                        *(v4u*)(dst + off) = pack8(oa, ob); } }
        } else if (pn < 10) {
            bf16* dst = (bf16*)(ws + (pn < 6 ? WS_V : (pn < 8 ? WS_SU : WS_SV))); const bool act = pn >= 6; const int cb = (pn & 1) * 256 + ct;
#pragma unroll
            for (int ai = 0; ai < 2; ++ai)
#pragma unroll
                for (int m = 0; m < 4; ++m) { const int row = row0 + ai * 128 + m * 16;
#pragma unroll
                    for (int bj = 0; bj < 2; ++bj) { const int col = cb + bj * 128; f32x4 a = acc[ai][bj][m][0], b = acc[ai][bj][m][1];
                        if (act) {
#pragma unroll
                            for (int e = 0; e < 4; ++e) { a[e] = gelu1(a[e]); b[e] = gelu1(b[e]); } }
                        const size_t off = (pn < 6) ? ((size_t)(((row >> 13) * 4 + (col >> 7)) * SEQ + (row & (SEQ - 1))) * 128 + (col & 127)) : ((size_t)row * HW + col);
                        *(v4u*)(dst + off) = pack8(a, b); } }
        } else {
            const int cb = (pn - 10) * 256 + ct;
#pragma unroll
            for (int bj = 0; bj < 2; ++bj) { const int col = cb + bj * 128;
                const f32x4 b0 = *(const f32x4*)(bgate + col), b1 = *(const f32x4*)(bgate + col + 4);
#pragma unroll
                for (int ai = 0; ai < 2; ++ai)
#pragma unroll
                    for (int m = 0; m < 4; ++m) { const int row = row0 + ai * 128 + m * 16; f32x4 a = acc[ai][bj][m][0] + b0, b = acc[ai][bj][m][1] + b1;
#pragma unroll
                        for (int e = 0; e < 4; ++e) { a[e] = __builtin_amdgcn_rcpf(1.0f + __builtin_amdgcn_exp2f(a[e] * -1.4426950408889634f)); b[e] = __builtin_amdgcn_rcpf(1.0f + __builtin_amdgcn_exp2f(b[e] * -1.4426950408889634f)); }
                        unsigned w0 = 0u, w1 = 0u;
#pragma unroll
                        for (int e = 0; e < 4; ++e) { w0 = __builtin_amdgcn_cvt_pk_u8_f32(a[e] * 255.0f, e, w0); w1 = __builtin_amdgcn_cvt_pk_u8_f32(b[e] * 255.0f, e, w1); }
                        *(v2u*)(ws + WS_GATES + (size_t)row * 2048 + col) = (v2u){w0, w1}; } }
        }
    }
};

struct EpiGate {
    static constexpr bool PERM = true, AFTER_DRAIN = false;
    bf16* M; const unsigned char* gates;
    __device__ __forceinline__ void operator()(const f32x4 (&acc)[2][2][4][2], const pg8::Unit& u, int wr, int wc, int fr, int fq) const {
        const int br = u.pn >> 2, pm = u.pm - 128 * br, pn = u.pn & 3;
        const int row0 = pm * 256 + wr * 64 + fr, col0 = pn * 256 + wc * 32 + 8 * fq;
#pragma unroll
        for (int ai = 0; ai < 2; ++ai) {
            v2u g[8]; v4u o[8];
#pragma unroll
            for (int m = 0; m < 4; ++m)
#pragma unroll
                for (int bj = 0; bj < 2; ++bj) g[2 * m + bj] = *(const v2u*)(gates + (size_t)(row0 + ai * 128 + m * 16) * 2048 + br * 1024 + col0 + bj * 128);
            if (br) {
#pragma unroll
                for (int m = 0; m < 4; ++m)
#pragma unroll
                    for (int bj = 0; bj < 2; ++bj) o[2 * m + bj] = *(const v4u*)(M + (size_t)(row0 + ai * 128 + m * 16) * DM + col0 + bj * 128);
            } else {
#pragma unroll
                for (int k = 0; k < 8; ++k) o[k] = (v4u){0u, 0u, 0u, 0u};
            }
#pragma unroll
            for (int m = 0; m < 4; ++m)
#pragma unroll
                for (int bj = 0; bj < 2; ++bj) { const v2u gg = g[2 * m + bj]; const v4u oo = o[2 * m + bj]; f32x4 a = acc[ai][bj][m][0] * (1.0f / 255.0f), b = acc[ai][bj][m][1] * (1.0f / 255.0f);
                    a[0] = a[0] * (float)(gg.x & 0xffu) + bf_lo(oo.x); a[1] = a[1] * (float)((gg.x >> 8) & 0xffu) + bf_hi(oo.x); a[2] = a[2] * (float)((gg.x >> 16) & 0xffu) + bf_lo(oo.y); a[3] = a[3] * (float)(gg.x >> 24) + bf_hi(oo.y);
                    b[0] = b[0] * (float)(gg.y & 0xffu) + bf_lo(oo.z); b[1] = b[1] * (float)((gg.y >> 8) & 0xffu) + bf_hi(oo.z); b[2] = b[2] * (float)((gg.y >> 16) & 0xffu) + bf_lo(oo.w); b[3] = b[3] * (float)(gg.y >> 24) + bf_hi(oo.w);
                    *(v4u*)(M + (size_t)(row0 + ai * 128 + m * 16) * DM + col0 + bj * 128) = pack8(a, b); }
        }
    }
};

struct EpiX1 {
    static constexpr bool PERM = true, AFTER_DRAIN = false;
    const float* x; float* out; bf16* x1b; float* ssq;
    __device__ __forceinline__ void operator()(const f32x4 (&acc)[2][2][4][2], const pg8::Unit& u, int wr, int wc, int fr, int fq) const {
        const int row0 = u.pm * 256 + wr * 64 + fr, col0 = u.pn * 256 + wc * 32 + 8 * fq;
#pragma unroll
        for (int ai = 0; ai < 2; ++ai) {
            f32x4 xa[8], xb[8];
#pragma unroll
            for (int m = 0; m < 4; ++m)
#pragma unroll
                for (int bj = 0; bj < 2; ++bj) { const size_t off = (size_t)(row0 + ai * 128 + m * 16) * DM + col0 + bj * 128; xa[2 * m + bj] = *(const f32x4*)(x + off); xb[2 * m + bj] = *(const f32x4*)(x + off + 4); }
            float ssv[4];
#pragma unroll
            for (int m = 0; m < 4; ++m) { float ss = 0.f;
#pragma unroll
                for (int bj = 0; bj < 2; ++bj) { const size_t off = (size_t)(row0 + ai * 128 + m * 16) * DM + col0 + bj * 128;
                    const f32x4 a = acc[ai][bj][m][0] + xa[2 * m + bj], b = acc[ai][bj][m][1] + xb[2 * m + bj];
                    *(v4u*)(x1b + off) = pack8(a, b);
                    ss += (a[0] * a[0] + a[1] * a[1]) + (a[2] * a[2] + a[3] * a[3]) + (b[0] * b[0] + b[1] * b[1]) + (b[2] * b[2] + b[3] * b[3]); }
                ss += __shfl_xor(ss, 16); ss += __shfl_xor(ss, 32); ssv[m] = ss; }
            if (fq == 0) {
#pragma unroll
                for (int m = 0; m < 4; ++m) ssq[(size_t)(row0 + ai * 128 + m * 16) * 16 + u.pn * 4 + wc] = ssv[m]; }
        }
    }
};

typedef _Float16 h16x2 __attribute__((ext_vector_type(2)));
__device__ __forceinline__ unsigned pkh(float a, float b) { const f32x2 v = {a, b}; const h16x2 h = __builtin_convertvector(v, h16x2); return __builtin_bit_cast(unsigned, h); }
struct EpiScores {
    static constexpr bool PERM = true, AFTER_DRAIN = false;
    unsigned short* S;
    __device__ __forceinline__ void operator()(const f32x4 (&acc)[2][2][4][2], const pg8::Unit& u, int wr, int wc, int fr, int fq) const {
        const int row0 = u.pm * 256 + wr * 64 + fr, col0 = u.pn * 256 + wc * 32 + 8 * fq;
#pragma unroll
        for (int ai = 0; ai < 2; ++ai)
#pragma unroll
            for (int m = 0; m < 4; ++m) { const int row = row0 + ai * 128 + m * 16;
#pragma unroll
                for (int bj = 0; bj < 2; ++bj) { const f32x4 a = acc[ai][bj][m][0], b = acc[ai][bj][m][1];
                    *(v4u*)(S + (size_t)row * 2048 + col0 + bj * 128) = (v4u){pkh(a[0], a[1]), pkh(a[2], a[3]), pkh(b[0], b[1]), pkh(b[2], b[3])}; } }
    }
};

struct BranchOrder {
    pg8::StaticOrder so;
    __device__ __forceinline__ bool next(int i, pg8::Unit& u) const { if (!so.next(i >> 1, u)) return false; const int br = i & 1; u.pm += 128 * br; u.pn += 4 * br; return true; }
    __device__ __forceinline__ void a_ready(const pg8::Unit&) const {}
    __device__ __forceinline__ void done(const pg8::Unit&) const {}
};
namespace att {
constexpr int SLOT = 64 * 256;
constexpr int KRING = 0, VRING = 3 * SLOT;
constexpr int XROW = 132, XBYTES = 128 * XROW * 4;
constexpr int WSF_OFF = 2 * XBYTES;
static_assert(VRING + 3 * SLOT <= WSF_OFF && WSF_OFF + 8 * 256 <= BAR_LDS_OFF, "attention LDS map");
__device__ __forceinline__ int crow(int r, int hi) { return (r & 3) + 8 * (r >> 2) + 4 * hi; }
__device__ __forceinline__ void glds16s(const unsigned char* sbase, unsigned voff, unsigned lds_dst) { unsigned keep;
    asm volatile("s_mov_b32 %0, m0\n\ts_mov_b32 m0, %3\n\ts_nop 2\n\tglobal_load_lds_dwordx4 %1, %2\n\ts_mov_b32 m0, %0" : "=&s"(keep) : "v"(voff), "s"(sbase), "s"(lds_dst) : "memory"); }
__device__ __forceinline__ float max3f(float a, float b, float c) { float r; asm("v_max3_f32 %0, %1, %2, %3" : "=v"(r) : "v"(a), "v"(b), "v"(c)); return r; }
__device__ __forceinline__ float max2f(float a, float b) { float r; asm("v_max_f32_e32 %0, %1, %2" : "=v"(r) : "v"(a), "v"(b)); return r; }
__device__ __forceinline__ s16x4 vtr(LAS const unsigned char* p) {
    typedef short v4i16_t __attribute__((ext_vector_type(4)));
    return __builtin_bit_cast(s16x4, __builtin_amdgcn_ds_read_tr16_b64_v4i16((LAS v4i16_t*)p));
}
__device__ __forceinline__ void halves32(float v, float& lo, float& hh) {
    float a = v, b2 = v;
    asm("s_nop 1\n\tv_permlane32_swap_b32_e32 %0, %1" : "+v"(a), "+v"(b2));
    lo = a; hh = b2;
}
#ifndef ATT_MX
#define ATT_MX 1
#endif
#if ATT_MX
#define MX3_(a, b, c) __builtin_fmaxf(__builtin_fmaxf((a), (b)), (c))
#define MX2_(a, b) __builtin_fmaxf((a), (b))
#define ATT_PAD(C0, C1) do { } while (0)
#else
#define MX3_(a, b, c) max3f((a), (b), (c))
#define MX2_(a, b) max2f((a), (b))
#define ATT_PAD(C0, C1) asm volatile("s_nop 15\n\ts_nop 7" : "+v"(C0), "+v"(C1))
#endif
__device__ __forceinline__ float rowmax(const f32x16& p0, const f32x16& p1) {
    float a = MX3_(p0[0], p0[1], p1[0]), b = MX3_(p0[2], p0[3], p1[1]); a = MX3_(a, p1[2], p1[3]);
#pragma unroll
    for (int r = 4; r < 16; r += 4) { a = MX3_(a, p0[r], p0[r + 1]); b = MX3_(b, p0[r + 2], p0[r + 3]); a = MX3_(a, p1[r], p1[r + 1]); b = MX3_(b, p1[r + 2], p1[r + 3]); }
    const float m = MX2_(a, b);
    float lo, hh; halves32(m, lo, hh);
    return MX2_(lo, hh);
}
#ifndef ATT_THR
#define ATT_THR 8
#endif
#ifndef ATT_AHEAD
#define ATT_AHEAD 6
#endif

template <int VAR> __device__ __forceinline__ void attn_unit(const Frame& F, int b, int h, int qb, bf16* Q, const bf16* K, const bf16* V, float lam, const float* subg) {
    LAS unsigned char* lds = F.lds;
    int tid = F.tid; asm volatile("" : "+v"(tid));
    const int lane = tid & 63, r32 = lane & 31, hi = lane >> 5, wid = F.wave;
    const int c = wid >> 2, wq = wid & 3;
    const size_t rowbase = (size_t)b * SEQ;
    const int q0 = qb * 128 + wq * 32;
    const int NT = 2 * qb + 2;
    const int dkey = lane >> 4, dpos = lane & 15;
    unsigned kvo[2], vvo[2];
#pragma unroll
    for (int i2 = 0; i2 < 2; ++i2) { const int key = 4 * (2 * wid + i2) + dkey;
        kvo[i2] = (unsigned)(key * 256 + ((dpos ^ (key & 15)) << 4));
        vvo[i2] = (unsigned)(key * 256 + ((dpos ^ ((key & 3) << 2)) << 4)); }
    const unsigned char* Kb = (const unsigned char*)(K + (size_t)(b * 4 + h) * SEQ * 128);
    const unsigned char* Vb = (const unsigned char*)(V + (size_t)(b * 4 + h) * SEQ * 128);
    const unsigned lds0 = (unsigned)(uintptr_t)lds;
    const unsigned kdst = lds0 + KRING + 2 * wid * 1024, vdst = lds0 + VRING + 2 * wid * 1024;
#define RFL(x) ((unsigned)__builtin_amdgcn_readfirstlane((int)(x)))
#define DMA_K(t, slot) do { const unsigned char* s_ = Kb + (size_t)(t) * SLOT; glds16s(s_, kvo[0], RFL(kdst + (slot))); glds16s(s_, kvo[1], RFL(kdst + (slot) + 1024)); } while (0)
#define DMA_V(t, slot) do { const unsigned char* s_ = Vb + (size_t)(t) * SLOT; glds16s(s_, vvo[0], RFL(vdst + (slot))); glds16s(s_, vvo[1], RFL(vdst + (slot) + 1024)); } while (0)
    const int kb0 = KRING + r32 * 256 + (((c * 8 + hi) ^ (r32 & 15)) << 4);
    const int grp = lane >> 4, qi = (lane & 15) >> 2, pi = lane & 3;
    const int vb0 = VRING + (4 * (grp >> 1) + qi) * 256 + ((2 * (grp & 1) + (pi >> 1)) << 4) + (pi & 1) * 8 + (qi << 6);
    LAS float* wsf = (LAS float*)(lds + WSF_OFF) + wid * 64;

    DMA_K(0, 0); DMA_V(0, 0); DMA_K(1, SLOT);
    bf16x8 qr[4];
    { const bf16* Qw = Q + (rowbase + q0 + r32) * HW + h * 128 + c * 64 + hi * 8;
#pragma unroll
      for (int s = 0; s < 4; ++s) qr[s] = *(const bf16x8*)(Qw + s * 16); }
    if (NT > 2) DMA_K(2, 2 * SLOT);
    float mhat = 0.f, l_reg = 0.f;
    f32x16 o[4];
#pragma unroll
    for (int d = 0; d < 4; ++d) o[d] = (f32x16){};
    f32x16 negm = (f32x16){}; asm volatile("" : "+v"(negm));
    bool resc = false;
    f32x16 pA0, pA1, pB0, pB1; bf16x8 kf[8]; s16x4 vlo[16], vhi[16]; v4u pw0, pw1, pw2, pw3;
    int sl_prev = 0, sl_cur = 0, sl_next = SLOT;
    if (VAR & 32) { s16x4 z = (s16x4){}; asm volatile("" : "+v"(z));
#pragma unroll
        for (int i = 0; i < 16; ++i) { vlo[i] = z; vhi[i] = z; } }
    if (VAR & 16) { v4u z = (v4u){}; asm volatile("" : "+v"(z)); pw0 = pw1 = pw2 = pw3 = z; }
#define SBAR() __builtin_amdgcn_sched_barrier(0)
#define PIN(x) asm volatile("" : "+v"(x))
#define MFMA(a, b, cc) __builtin_amdgcn_mfma_f32_32x32x16_bf16(a, b, cc, 0, 0, 0)
#define WAIT_BAR(N) asm volatile("s_waitcnt vmcnt(" #N ") lgkmcnt(0)\n\ts_barrier" ::: "memory")
#define ROT() do { sl_prev = sl_cur; sl_cur = sl_next; sl_next = (sl_next == 2 * SLOT) ? 0 : sl_next + SLOT; } while (0)
#define KLOAD2(ka, j) do { kf[2 * (j)] = *(LAS const bf16x8*)(lds + ((ka) ^ ((j) << 5))); kf[2 * (j) + 1] = *(LAS const bf16x8*)(lds + ((ka) ^ ((j) << 5)) + 8192); } while (0)
#define RESC() do { if (resc) { \
        _Pragma("unroll") for (int g = 0; g < 4; ++g) { const f32x4 f = *(LAS const f32x4*)(wsf + 8 * g + 4 * hi); \
            _Pragma("unroll") for (int d = 0; d < 4; ++d) { o[d][4 * g + 0] *= f[0]; o[d][4 * g + 1] *= f[1]; o[d][4 * g + 2] *= f[2]; o[d][4 * g + 3] *= f[3]; } } } } while (0)
#define ENDW(tt) do { if ((tt) + 3 < NT) { WAIT_BAR(4); } else if ((tt) + 2 < NT) { WAIT_BAR(2); } else { WAIT_BAR(0); } } while (0)
    if (NT > 2) { WAIT_BAR(6); } else { WAIT_BAR(4); }
    { const int ka = kb0;
#pragma unroll
      for (int j = 0; j < 4; ++j) KLOAD2(ka, j); }
    pA0 = MFMA(kf[0], qr[0], negm); pA1 = MFMA(kf[1], qr[0], negm); pA0 = MFMA(kf[2], qr[1], pA0); pA1 = MFMA(kf[3], qr[1], pA1);
    pA0 = MFMA(kf[4], qr[2], pA0); pA1 = MFMA(kf[5], qr[2], pA1); pA0 = MFMA(kf[6], qr[3], pA0); pA1 = MFMA(kf[7], qr[3], pA1);
    ATT_PAD(pA0, pA1);
    { const float rm = rowmax(pA0, pA1); mhat = rm;
#pragma unroll
      for (int r = 0; r < 16; ++r) { pA0[r] = __builtin_amdgcn_exp2f(pA0[r] - rm); pA1[r] = __builtin_amdgcn_exp2f(pA1[r] - rm); }
#pragma unroll
      for (int r = 0; r < 16; ++r) negm[r] = -mhat;
      asm volatile("" : "+v"(negm)); }
    WAIT_BAR(0);
    if (NT > 3) DMA_K(3, 0);
    DMA_V(1, SLOT); ROT();
    { const int ka = kb0 + sl_cur;
#pragma unroll
      for (int j = 0; j < 4; ++j) KLOAD2(ka, j); }
    ENDW(0);
#define PKW(P, i) cvtpk(P[i], P[(i) + 1])
#define PAF(k) __builtin_bit_cast(bf16x8, pw##k)
#define VFR(i) (bf16x8){vlo[i][0], vlo[i][1], vlo[i][2], vlo[i][3], vhi[i][0], vhi[i][1], vhi[i][2], vhi[i][3]}
#define VADR(i, half) (lds + ((va_ ^ ((((i) & 15) & 3) << 6)) + (16 * (((i) & 15) >> 2) + 8 * (half)) * 256))
#define VRD(i) do { if (!(VAR & 32) && (i) >= 0 && (i) < 16) { \
        if (VAR & 128) { const bf16x8 w_ = *(LAS const bf16x8*)(lds + (((va_ ^ ((((i) & 15) & 3) << 6)) + (16 * (((i) & 15) >> 2)) * 256) & ~15)); vlo[(i) & 15] = (s16x4){w_[0], w_[1], w_[2], w_[3]}; vhi[(i) & 15] = (s16x4){w_[4], w_[5], w_[6], w_[7]}; } \
        else if (VAR & 256) { vlo[(i) & 15] = *(LAS const s16x4*)VADR(i, 0); vhi[(i) & 15] = *(LAS const s16x4*)VADR(i, 1); } \
        else { vlo[(i) & 15] = vtr(VADR(i, 0)); vhi[(i) & 15] = vtr(VADR(i, 1)); } SBAR(); } } while (0)
#define KRD(G, j) do { if (!(VAR & 64) && (G)) { KLOAD2(ka_, j); SBAR(); } } while (0)
#define GAPA(MF, a0, a1, a2, a3, W0, W1, PW) do { MF; if (!(VAR & 16)) { sacc += a0; sacc2 += a1; sacc += a2; sacc2 += a3; PIN(sacc); PIN(sacc2); W0; W1; } PIN(PW); SBAR(); } while (0)
#define GAPB(j, X, i) do { VRD((j) + ATT_AHEAD); o[(j) & 3] = MFMA(PAF_((j) >> 2), VFR(j), o[(j) & 3]); if (!(VAR & 4)) { X[i] = __builtin_amdgcn_exp2f(X[i]); X[(i) + 1] = __builtin_amdgcn_exp2f(X[(i) + 1]); } PIN(X); SBAR(); } while (0)
#define PAF_(k) ((k) == 0 ? PAF(0) : (k) == 1 ? PAF(1) : (k) == 2 ? PAF(2) : PAF(3))
#define STEP(C0, C1, P0, P1, t, GK, GV, GL, MASK) do { SBAR(); \
    const int va_ = vb0 + sl_prev; const int ka_ = kb0 + sl_next; \
    float sacc = P0[0], sacc2 = P0[1]; \
    GAPA(C0 = MFMA(kf[0], qr[0], negm), P0[2], P0[3], P0[4], P0[5],     pw0[0] = PKW(P0, 0),  pw0[1] = PKW(P0, 2),  pw0); \
    GAPA(C1 = MFMA(kf[1], qr[0], negm), P0[6], P0[7], P0[8], P0[9],     pw0[2] = PKW(P0, 4),  pw0[3] = PKW(P0, 6),  pw0); \
    VRD(ATT_AHEAD - 6); GAPA(C0 = MFMA(kf[2], qr[1], C0),   P0[10], P0[11], P0[12], P0[13], pw1[0] = PKW(P0, 8),  pw1[1] = PKW(P0, 10), pw1); \
    VRD(ATT_AHEAD - 5); GAPA(C1 = MFMA(kf[3], qr[1], C1),   P0[14], P0[15], P1[0], P1[1],   pw1[2] = PKW(P0, 12), pw1[3] = PKW(P0, 14), pw1); \
    VRD(ATT_AHEAD - 4); GAPA(C0 = MFMA(kf[4], qr[2], C0),   P1[2], P1[3], P1[4], P1[5],     pw2[0] = PKW(P1, 0),  pw2[1] = PKW(P1, 2),  pw2); \
    VRD(ATT_AHEAD - 3); GAPA(C1 = MFMA(kf[5], qr[2], C1),   P1[6], P1[7], P1[8], P1[9],     pw2[2] = PKW(P1, 4),  pw2[3] = PKW(P1, 6),  pw2); \
    VRD(ATT_AHEAD - 2); GAPA(C0 = MFMA(kf[6], qr[3], C0),   P1[10], P1[11], P1[12], P1[13], pw3[0] = PKW(P1, 8),  pw3[1] = PKW(P1, 10), pw3); \
    VRD(ATT_AHEAD - 1); GAPA(C1 = MFMA(kf[7], qr[3], C1),   P1[14], P1[15], 0.f, 0.f,       pw3[2] = PKW(P1, 12), pw3[3] = PKW(P1, 14), pw3); \
    l_reg += sacc + sacc2; \
    if (!(VAR & 2)) { if (GK) DMA_K((t) + 3, sl_cur); if (GV) DMA_V((t) + 1, sl_next); }                                    \
    ATT_PAD(C0, C1); \
    if (MASK) { _Pragma("unroll") for (int r = 0; r < 16; ++r) { C0[r] = -INFINITY; C1[r] = -INFINITY; } }                                   \
    { const float rm = (VAR & 8) ? 0.f : rowmax(C0, C1); resc = false;                                                        \
      if (__builtin_expect(__any(rm > (float)ATT_THR), 0)) { const float dl = __builtin_fmaxf(rm, 0.f); mhat += dl;        \
          _Pragma("unroll") for (int r = 0; r < 16; ++r) { C0[r] -= dl; C1[r] -= dl; } \
          _Pragma("unroll") for (int r = 0; r < 16; ++r) negm[r] = -mhat; \
          asm volatile("" : "+v"(negm)); \
          const float f = __builtin_amdgcn_exp2f(-dl); l_reg *= f; if (hi == 0) wsf[r32] = f; resc = true; } } \
    SBAR(); \
    GAPB(0, C0, 0);  GAPB(1, C0, 2);  GAPB(2, C0, 4);  GAPB(3, C0, 6); \
    KRD(GL, 0); GAPB(4, C0, 8);  GAPB(5, C0, 10); KRD(GL, 1); GAPB(6, C0, 12); GAPB(7, C0, 14); \
    KRD(GL, 2); GAPB(8, C1, 0);  GAPB(9, C1, 2);  KRD(GL, 3); GAPB(10, C1, 4); GAPB(11, C1, 6); \
    GAPB(12, C1, 8); GAPB(13, C1, 10); GAPB(14, C1, 12); GAPB(15, C1, 14); \
    } while (0)
#define DRAIN(P0, P1, vs) do { float sacc = P0[0] + P0[1]; \
      _Pragma("unroll") for (int r = 2; r < 16; ++r) sacc += P0[r]; \
      _Pragma("unroll") for (int r = 0; r < 16; ++r) sacc += P1[r]; \
      l_reg += sacc; \
      pw0 = (v4u){PKW(P0, 0), PKW(P0, 2), PKW(P0, 4), PKW(P0, 6)}; pw1 = (v4u){PKW(P0, 8), PKW(P0, 10), PKW(P0, 12), PKW(P0, 14)}; \
      pw2 = (v4u){PKW(P1, 0), PKW(P1, 2), PKW(P1, 4), PKW(P1, 6)}; pw3 = (v4u){PKW(P1, 8), PKW(P1, 10), PKW(P1, 12), PKW(P1, 14)}; \
      const int va_ = vb0 + (vs); \
      _Pragma("unroll") for (int ks = 0; ks < 4; ++ks) { \
          _Pragma("unroll") for (int d = 0; d < 4; ++d) { \
              const s16x4 lo = vtr(lds + ((va_ ^ (d << 6)) + (16 * ks) * 256)); const s16x4 hh = vtr(lds + ((va_ ^ (d << 6)) + (16 * ks + 8) * 256)); \
              const bf16x8 vf = (bf16x8){lo[0], lo[1], lo[2], lo[3], hh[0], hh[1], hh[2], hh[3]}; \
              o[d] = MFMA(PAF_(ks), vf, o[d]); } SBAR(); } } while (0)
    int t = 1;
    for (; t + 5 < NT; t += 2) {
        STEP(pB0, pB1, pA0, pA1, t, true, true, true, false);     WAIT_BAR(4); RESC(); ROT();
        STEP(pA0, pA1, pB0, pB1, t + 1, true, true, true, false); WAIT_BAR(4); RESC(); ROT();
    }
    for (; t + 1 < NT; t += 2) {
        STEP(pB0, pB1, pA0, pA1, t, (t + 3 < NT), (t + 1 < NT), (t + 1 < NT), false);         ENDW(t);     RESC(); ROT();
        STEP(pA0, pA1, pB0, pB1, t + 1, (t + 4 < NT), (t + 2 < NT), (t + 2 < NT), false);     ENDW(t + 1); RESC(); ROT();
    }
    STEP(pB0, pB1, pA0, pA1, NT - 1, false, false, false, (wq < 2)); RESC();
    DRAIN(pB0, pB1, sl_cur);
    const float l_run = l_reg;
    __syncthreads();
#undef STEP
#undef DRAIN
#undef GAPA
#undef GAPB
#undef PAF_
#undef PAF
#undef PKW
#undef VFR
#undef VRD
#undef VADR
#undef KRD
#undef ENDW
#undef RESC
#undef KLOAD2
#undef ROT
#undef WAIT_BAR
#undef MFMA
#undef PIN
#undef SBAR
#undef DMA_K
#undef DMA_V
#undef RFL
    int tide = F.tid; asm volatile("" : "+v"(tide));
    const int lane_e = tide & 63, r32e = lane_e & 31, hie = lane_e >> 5;
    LAS float* wse = (LAS float*)(lds + WSF_OFF) + wid * 64;
    float lt; { float lo_, hh_; halves32(l_run, lo_, hh_); lt = lo_ + hh_; }
    CFENCE();
    if (hie == 0) wse[32 + r32e] = lt;
    CFENCE(); LDS_WAIT();
    {
        const float csc = c ? lam : 1.0f;
        LAS float* Xc = (LAS float*)(lds + c * XBYTES) + (wq * 32) * XROW + r32e;
#pragma unroll
        for (int g = 0; g < 4; ++g) { const f32x4 f = *(LAS const f32x4*)(wse + 32 + 8 * g + 4 * hie);
#pragma unroll
            for (int e = 0; e < 4; ++e) { const float sc = csc * __builtin_amdgcn_rcpf(f[e]); const int q = 8 * g + 4 * hie + e;
#pragma unroll
                for (int d = 0; d < 4; ++d) Xc[q * XROW + 32 * d] = o[d][4 * g + e] * sc; } }
    }
    __syncthreads();
    {
        const int row = tide >> 2, sg = tide & 3;
        const LAS float* x0 = (const LAS float*)lds + row * XROW + sg * 32;
        const LAS float* x1 = (const LAS float*)(lds + XBYTES) + row * XROW + sg * 32;
        f32x4 dv[8]; float ss = 0.f;
#pragma unroll
        for (int j = 0; j < 8; ++j) { dv[j] = *(const LAS f32x4*)(x0 + 4 * j) - *(const LAS f32x4*)(x1 + 4 * j); ss += (dv[j][0] * dv[j][0] + dv[j][1] * dv[j][1]) + (dv[j][2] * dv[j][2] + dv[j][3] * dv[j][3]); }
        ss += __builtin_bit_cast(float, __builtin_amdgcn_mov_dpp(__builtin_bit_cast(int, ss), 0xB1, 0xF, 0xF, true)); ss += __builtin_bit_cast(float, __builtin_amdgcn_mov_dpp(__builtin_bit_cast(int, ss), 0x4E, 0xF, 0xF, true));
        const float rs = (1.0f - LAMBDA_INIT) * __builtin_amdgcn_rsqf(ss * (1.0f / 128.0f) + EPS);
        bf16* yr = Q + (rowbase + qb * 128 + row) * HW + h * 128 + sg * 32;
        const float* sgp = subg + sg * 32;
#pragma unroll
        for (int j = 0; j < 4; ++j) { const f32x4 ga = *(const f32x4*)(sgp + 8 * j), gb = *(const f32x4*)(sgp + 8 * j + 4);
            v4u w; w.x = cvtpk(dv[2 * j][0] * rs * ga[0], dv[2 * j][1] * rs * ga[1]); w.y = cvtpk(dv[2 * j][2] * rs * ga[2], dv[2 * j][3] * rs * ga[3]);
            w.z = cvtpk(dv[2 * j + 1][0] * rs * gb[0], dv[2 * j + 1][1] * rs * gb[1]); w.w = cvtpk(dv[2 * j + 1][2] * rs * gb[2], dv[2 * j + 1][3] * rs * gb[3]);
            if (!(VAR & 1)) *(v4u*)(yr + 8 * j) = w; }
    }
    __syncthreads();
}
}

namespace sgu {
constexpr int VROW = 320, VN_BYTES = 128 * VROW;
constexpr int STAT_OFF = VN_BYTES;
__device__ __forceinline__ float dppx(float v, int ctrl_sel) {
    const int iv = __builtin_bit_cast(int, v);
    return __builtin_bit_cast(float, ctrl_sel == 0 ? __builtin_amdgcn_mov_dpp(iv, 0xB1, 0xF, 0xF, true) : ctrl_sel == 1 ? __builtin_amdgcn_mov_dpp(iv, 0x4E, 0xF, 0xF, true)
                                   : ctrl_sel == 2 ? __builtin_amdgcn_mov_dpp(iv, 0x141, 0xF, 0xF, true) : __builtin_amdgcn_mov_dpp(iv, 0x140, 0xF, 0xF, true));
}
__device__ __forceinline__ float wsum(float v) {
    v += dppx(v, 0); v += dppx(v, 1); v += dppx(v, 2); v += dppx(v, 3);
    const int iv = __builtin_bit_cast(int, v);
    return (__builtin_bit_cast(float, __builtin_amdgcn_readlane(iv, 0)) + __builtin_bit_cast(float, __builtin_amdgcn_readlane(iv, 16))) +
           (__builtin_bit_cast(float, __builtin_amdgcn_readlane(iv, 32)) + __builtin_bit_cast(float, __builtin_amdgcn_readlane(iv, 48)));
}
__device__ __forceinline__ void sgu_unit(const Frame& F, int blk, bf16* SU, const bf16* SV, const bf16* WSM, const float* lng, const float* lnb, const float* bs) {
    LAS unsigned char* lds = F.lds;
    int tid = F.tid; asm volatile("" : "+v"(tid));
    const int lane = tid & 63, r32 = lane & 31, hi = lane >> 5, wid = F.wave;
    const size_t R0 = (size_t)blk * 128;
    LAS float* stat = (LAS float*)(lds + STAT_OFF);
    { v4u wv[16];
#pragma unroll
      for (int i = 0; i < 16; ++i) wv[i] = *(const v4u*)(SV + (R0 + wid * 16 + i) * HW + lane * 8);
#pragma unroll
      for (int i = 0; i < 16; ++i) { const v4u w = wv[i];
        const float x[8] = {bf_lo(w.x), bf_hi(w.x), bf_lo(w.y), bf_hi(w.y), bf_lo(w.z), bf_hi(w.z), bf_lo(w.w), bf_hi(w.w)};
        float sm = 0.f;
#pragma unroll
        for (int e = 0; e < 8; ++e) sm += x[e];
        const float mu = wsum(sm) * (1.0f / 512.0f); float qv = 0.f;
#pragma unroll
        for (int e = 0; e < 8; ++e) { const float d = x[e] - mu; qv += d * d; }
        const float rstd = __builtin_amdgcn_rsqf(wsum(qv) * (1.0f / 512.0f) + EPS);
        if (lane == 0) { stat[2 * (wid * 16 + i)] = mu; stat[2 * (wid * 16 + i) + 1] = rstd; } } }
    __syncthreads();
    const int ib = wid & 3, chf = wid >> 2;
    const int grp = lane >> 4, qi = (lane & 15) >> 2, pi = lane & 3;
    const int vbase = (8 * (grp >> 1) + qi) * VROW + (16 * (grp & 1) + 4 * pi) * 2;
    for (int g = 0; g < 4; ++g) {
        { const int j = tid >> 2, sg = tid & 3; const float mu = stat[2 * j], rstd = stat[2 * j + 1];
          const bf16* src = SV + (R0 + j) * HW + g * 128 + sg * 32;
          v4u wv[4];
#pragma unroll
          for (int q = 0; q < 4; ++q) wv[q] = *(const v4u*)(src + q * 8);
#pragma unroll
          for (int q = 0; q < 4; ++q) { const v4u w = wv[q]; const int ch = g * 128 + sg * 32 + q * 8;
              const f32x4 ga = *(const f32x4*)(lng + ch), gb = *(const f32x4*)(lng + ch + 4), ba = *(const f32x4*)(lnb + ch), bb = *(const f32x4*)(lnb + ch + 4);
              v4u o;
              o.x = cvtpk((bf_lo(w.x) - mu) * rstd * ga[0] + ba[0], (bf_hi(w.x) - mu) * rstd * ga[1] + ba[1]);
              o.y = cvtpk((bf_lo(w.y) - mu) * rstd * ga[2] + ba[2], (bf_hi(w.y) - mu) * rstd * ga[3] + ba[3]);
              o.z = cvtpk((bf_lo(w.z) - mu) * rstd * gb[0] + bb[0], (bf_hi(w.z) - mu) * rstd * gb[1] + bb[1]);
              o.w = cvtpk((bf_lo(w.w) - mu) * rstd * gb[2] + bb[2], (bf_hi(w.w) - mu) * rstd * gb[3] + bb[3]);
              *(LAS v4u*)(lds + j * VROW + (sg * 32 + q * 8) * 2) = o; } }
        bf16x8 wf[8];
        { const bf16* Wg = WSM + (size_t)g * 128 * 128 + (size_t)(32 * ib + r32) * 128 + hi * 8;
#pragma unroll
          for (int s = 0; s < 8; ++s) wf[s] = *(const bf16x8*)(Wg + 16 * s); }
        bf16* sup = SU + (R0 + 32 * ib + r32) * HW + g * 128 + chf * 64 + 4 * hi;
        v2u sw[8];
#pragma unroll
        for (int k = 0; k < 8; ++k) sw[k] = *(const v2u*)(sup + (k >> 2) * 32 + (k & 3) * 8);
        const float bi = bs[g * 128 + 32 * ib + r32];
        __syncthreads();
        f32x16 acc[2]; acc[0] = (f32x16){}; acc[1] = (f32x16){};
#pragma unroll
        for (int s = 0; s < 8; ++s) {
#pragma unroll
            for (int cb = 0; cb < 2; ++cb) { const int cblk = 2 * chf + cb;
                const s16x4 lo = att::vtr(lds + vbase + (16 * s) * VROW + cblk * 64);
                const s16x4 hh = att::vtr(lds + vbase + (16 * s + 4) * VROW + cblk * 64);
                const bf16x8 vf = (bf16x8){lo[0], lo[1], lo[2], lo[3], hh[0], hh[1], hh[2], hh[3]};
                acc[cb] = __builtin_amdgcn_mfma_f32_32x32x16_bf16(vf, wf[s], acc[cb], 0, 0, 0); }
        }
#pragma unroll
        for (int k = 0; k < 8; ++k) { const int cb = k >> 2, q = k & 3; const v2u w = sw[k];
            const unsigned o0 = cvtpk(bf_lo(w.x) * (acc[cb][4 * q + 0] + bi), bf_hi(w.x) * (acc[cb][4 * q + 1] + bi));
            const unsigned o1 = cvtpk(bf_lo(w.y) * (acc[cb][4 * q + 2] + bi), bf_hi(w.y) * (acc[cb][4 * q + 3] + bi));
            *(v2u*)(sup + cb * 32 + q * 8) = (v2u){o0, o1}; }
        __syncthreads();
    }
}
}
namespace peer {
__device__ __forceinline__ float dpp_xor1(float v) { return __builtin_bit_cast(float, __builtin_amdgcn_mov_dpp(__builtin_bit_cast(int, v), 0xB1, 0xF, 0xF, true)); }
__device__ __forceinline__ float dpp_xor2(float v) { return __builtin_bit_cast(float, __builtin_amdgcn_mov_dpp(__builtin_bit_cast(int, v), 0x4E, 0xF, 0xF, true)); }
__device__ __forceinline__ void ins16(float (&L)[16], const float x) {
#pragma unroll
    for (int i = 15; i >= 1; --i) L[i] = __builtin_amdgcn_fmed3f(L[i - 1], L[i], x);
    L[0] = __builtin_fmaxf(L[0], x);
}
__device__ __forceinline__ float tagf(float v, unsigned mask, unsigned tag) { return __builtin_bit_cast(float, (__builtin_bit_cast(unsigned, v) & ~mask) | tag); }
__device__ __forceinline__ float sel16(const float (&A)[16], int i) {
    float r = A[0];
#pragma unroll
    for (int k = 1; k < 16; ++k) { const float ak = A[k]; r = (i == k) ? ak : r; }
    return r;
}
__device__ __forceinline__ void topk_phase(const Frame& F) {
    const unsigned short* S = (const unsigned short*)(F.ws + WS_SCORES); const float* ssq = (const float*)(F.ws + WS_SSQ);
    float* GW = (float*)(F.ws + WS_GW);
    const int gw = F.vcu * NWAVES + F.wave, NGW = F.G * NWAVES, lane = F.lane;
    const int q = lane & 3;
    static_assert(T * PK_HEADS / 16 == NEXP, "two table rows per top-k wave-item");
    f32x4 g2v[4];
#pragma unroll
    for (int j = 0; j < 4; ++j) g2v[j] = *(const f32x4*)(F.in[17] + 16 * lane + 4 * j);
    for (int it = gw; it < T * PK_HEADS / 16; it += NGW) {
        const bool isu = it < NEXP / 2; const int e0 = isu ? 2 * it : 2 * it - NEXP;
        f32x4 tr0[4], tr1[4];
        const int th = it * 16 + (lane >> 2), t = th >> 3, h = th & 7;
        const unsigned short* sp = S + (size_t)t * 2048 + h * 256 + q * 64;
        float L[16];
#pragma unroll
        for (int i = 0; i < 16; ++i) L[i] = -INFINITY;
#pragma unroll
        for (int c4 = 0; c4 < 4; ++c4) {
            typedef _Float16 h16x8 __attribute__((ext_vector_type(8)));
            h16x8 hv[2];
#pragma unroll
            for (int j = 0; j < 2; ++j) hv[j] = *(const h16x8*)(sp + 16 * c4 + 8 * j);
#pragma unroll
            for (int j = 0; j < 2; ++j)
#pragma unroll
                for (int e = 0; e < 8; ++e) ins16(L, tagf((float)hv[j][e], 127u, (unsigned)((q & 1) * 64 + 16 * c4 + 8 * j + e)));
        }
        __builtin_amdgcn_sched_barrier(0);
        { const float* src = (isu ? F.in[20] : F.in[21]) + (size_t)e0 * DM + 16 * lane;
#pragma unroll
          for (int j = 0; j < 4; ++j) { tr0[j] = *(const f32x4*)(src + 4 * j); tr1[j] = *(const f32x4*)(src + DM + 4 * j); } }
        __builtin_amdgcn_sched_barrier(0);
        { float P[16];
#pragma unroll
          for (int i = 0; i < 16; ++i) P[i] = dpp_xor1(L[i]);
#pragma unroll
          for (int i = 0; i < 16; ++i) ins16(L, P[i]); }
        float A[16], B[16];
        { const bool lowp = q < 2;
#pragma unroll
          for (int i = 0; i < 16; ++i) { const float o = dpp_xor2(L[i]); A[i] = lowp ? L[i] : o; B[i] = lowp ? o : L[i]; } }
        float W[16];
#pragma unroll
        for (int i = 0; i < 16; ++i) W[i] = -INFINITY;
#pragma unroll
        for (int a = 0; a < 16; ++a) { const float sa = tagf(A[a], 127u, 0u);
#pragma unroll
            for (int b = 0; b < 16; ++b) if ((a + 1) * (b + 1) <= 16) ins16(W, tagf(sa + tagf(B[b], 127u, 0u), 255u, (unsigned)(a * 16 + b))); }
        const f32x4 pq = *(const f32x4*)(ssq + (size_t)t * 16 + 4 * q);
        float pss = (pq[0] + pq[1]) + (pq[2] + pq[3]); pss += dpp_xor1(pss); pss += dpp_xor2(pss);
        const float rstd = 1.0f / sqrtf(pss * (1.0f / DM) + EPS);
        const float z0 = tagf(W[0], 255u, 0u) * rstd; float es = 0.f;
#pragma unroll
        for (int i = 0; i < 16; ++i) es += __expf(tagf(W[i], 255u, 0u) * rstd - z0);
        const float inv = 1.0f / es;
        int eo[4]; float go[4];
#pragma unroll
        for (int j = 0; j < 4; ++j) {
            const float w0 = W[j], w1 = W[4 + j], w2 = W[8 + j], w3 = W[12 + j];
            float w = w0; w = (q == 1) ? w1 : w; w = (q == 2) ? w2 : w; w = (q == 3) ? w3 : w;
            const unsigned bits = __builtin_bit_cast(unsigned, w);
            const int ai = (bits >> 4) & 15, bi = bits & 15;
            const unsigned i1 = __builtin_bit_cast(unsigned, sel16(A, ai)) & 127u, i2 = __builtin_bit_cast(unsigned, sel16(B, bi)) & 127u;
            eo[j] = (int)(i1 * 128u + i2);
            go[j] = __expf(tagf(w, 255u, 0u) * rstd - z0) * inv;
        }
        typedef int i32x4 __attribute__((ext_vector_type(4)));
        *(v2u*)((unsigned*)(F.ws + WS_IDX16) + (size_t)t * 64 + h * 8 + 2 * q) = (v2u){(unsigned)eo[0] | ((unsigned)eo[1] << 16), (unsigned)eo[2] | ((unsigned)eo[3] << 16)};
        *(f32x4*)(GW + (size_t)t * 128 + h * 16 + 4 * q) = (f32x4){go[0], go[1], go[2], go[3]};
        if (isu) {
#pragma unroll
            for (int j = 0; j < 4; ++j) { tr0[j] = tr0[j] * g2v[j]; tr1[j] = tr1[j] * g2v[j]; } }
        table_row_store(F.ws, tr0, isu, e0, lane); table_row_store(F.ws, tr1, isu, e0 + 1, lane);
    }
    {
        unsigned char* X1Q = F.ws + WS_X1Q; float* X1S = (float*)(F.ws + WS_X1S);
        for (int t = gw; t < T; t += NGW) {
            f32x4 v[4]; float am = 0.f;
            { const bf16* xb = (const bf16*)(F.ws + WS_XB) + (size_t)t * DM + 16 * lane;
              const v4u w0 = *(const v4u*)xb, w1 = *(const v4u*)(xb + 8);
              v[0] = (f32x4){bf_lo(w0.x), bf_hi(w0.x), bf_lo(w0.y), bf_hi(w0.y)}; v[1] = (f32x4){bf_lo(w0.z), bf_hi(w0.z), bf_lo(w0.w), bf_hi(w0.w)};
              v[2] = (f32x4){bf_lo(w1.x), bf_hi(w1.x), bf_lo(w1.y), bf_hi(w1.y)}; v[3] = (f32x4){bf_lo(w1.z), bf_hi(w1.z), bf_lo(w1.w), bf_hi(w1.w)}; }
#pragma unroll
            for (int j = 0; j < 4; ++j) am = fmaxf(am, fmaxf(fmaxf(fabsf(v[j][0]), fabsf(v[j][1])), fmaxf(fabsf(v[j][2]), fabsf(v[j][3]))));
            am = fmaxf(am, __shfl_xor(am, 1)); am = fmaxf(am, __shfl_xor(am, 2)); am = fmaxf(am, __shfl_xor(am, 4));
            const float sx = am > 0.f ? 127.0f / am : 0.f;
            unsigned wq[4];
#pragma unroll
            for (int j = 0; j < 4; ++j) wq[j] = ((unsigned)__float2int_rn(v[j][0] * sx) & 0xffu) | (((unsigned)__float2int_rn(v[j][1] * sx) & 0xffu) << 8) | (((unsigned)__float2int_rn(v[j][2] * sx) & 0xffu) << 16) | (((unsigned)__float2int_rn(v[j][3] * sx) & 0xffu) << 24);
            *(v4u*)(X1Q + (size_t)t * DM + 16 * lane) = (v4u){wq[0], wq[1], wq[2], wq[3]};
            if ((lane & 7) == 0) X1S[(size_t)t * 8 + (lane >> 3)] = am * (1.0f / 127.0f);
        }
    }
}

__device__ __forceinline__ void unpack16(float (&f)[16], const v4u w) {
    f32x2 t;
    t = __builtin_amdgcn_cvt_pk_f32_fp8((int)w.x, false); f[0] = t[0]; f[1] = t[1]; t = __builtin_amdgcn_cvt_pk_f32_fp8((int)w.x, true); f[2] = t[0]; f[3] = t[1];
    t = __builtin_amdgcn_cvt_pk_f32_fp8((int)w.y, false); f[4] = t[0]; f[5] = t[1]; t = __builtin_amdgcn_cvt_pk_f32_fp8((int)w.y, true); f[6] = t[0]; f[7] = t[1];
    t = __builtin_amdgcn_cvt_pk_f32_fp8((int)w.z, false); f[8] = t[0]; f[9] = t[1]; t = __builtin_amdgcn_cvt_pk_f32_fp8((int)w.z, true); f[10] = t[0]; f[11] = t[1];
    t = __builtin_amdgcn_cvt_pk_f32_fp8((int)w.w, false); f[12] = t[0]; f[13] = t[1]; t = __builtin_amdgcn_cvt_pk_f32_fp8((int)w.w, true); f[14] = t[0]; f[15] = t[1];
}
__device__ __forceinline__ void unpack8x2(f32x2 (&t)[8], const v4u w) {
    t[0] = __builtin_amdgcn_cvt_pk_f32_fp8((int)w.x, false); t[1] = __builtin_amdgcn_cvt_pk_f32_fp8((int)w.x, true);
    t[2] = __builtin_amdgcn_cvt_pk_f32_fp8((int)w.y, false); t[3] = __builtin_amdgcn_cvt_pk_f32_fp8((int)w.y, true);
    t[4] = __builtin_amdgcn_cvt_pk_f32_fp8((int)w.z, false); t[5] = __builtin_amdgcn_cvt_pk_f32_fp8((int)w.z, true);
    t[6] = __builtin_amdgcn_cvt_pk_f32_fp8((int)w.w, false); t[7] = __builtin_amdgcn_cvt_pk_f32_fp8((int)w.w, true);
}
__device__ __forceinline__ float dot_pk(const v4u w, const f32x2 (&xx)[8]) {
    f32x2 t[8]; unpack8x2(t, w);
    f32x2 a = xx[0] * t[0], b = xx[1] * t[1];
    a = xx[2] * t[2] + a; b = xx[3] * t[3] + b; a = xx[4] * t[4] + a; b = xx[5] * t[5] + b; a = xx[6] * t[6] + a; b = xx[7] * t[7] + b;
    const f32x2 c = a + b; return c[0] + c[1];
}
__device__ __forceinline__ void axpy_pk(f32x2 (&acc)[8], const float cf, const v4u w) {
    f32x2 t[8]; unpack8x2(t, w); const f32x2 cv = (f32x2){cf, cf};
#pragma unroll
    for (int k = 0; k < 8; ++k) acc[k] = cv * t[k] + acc[k];
}
struct Slice { int p0, np, wrank, wcount; };
__device__ __forceinline__ Slice slice_of(const Frame& F) {
    Slice s; const int b = (int)blockIdx.x;
    if (F.G % 8 == 0) { s.p0 = b & 7; s.np = 1; s.wrank = (b >> 3) * NWAVES + F.wave; s.wcount = (F.G >> 3) * NWAVES; }
    else { s.p0 = 0; s.np = 8; s.wrank = b * NWAVES + F.wave; s.wcount = F.G * NWAVES; }
    return s;
}
typedef int i32x4 __attribute__((ext_vector_type(4)));
__device__ __forceinline__ void expert_u_phase(const Frame& F, const int tb, const int te) {
    const unsigned char* UQ = F.ws + WS_UQ; const int* IDX = (const int*)(F.ws + WS_IDX); bf16* PART = (bf16*)(F.ws + WS_PART);
    const unsigned char* X1Q = F.ws + WS_X1Q; const float* X1S = (const float*)(F.ws + WS_X1S);
    const int lane = F.lane, g = lane >> 3, i = lane & 7;
    const Slice sl = slice_of(F);
    for (int p = sl.p0; p < sl.p0 + sl.np; ++p) {
    const int tfirst = tb + sl.wrank;
    if (tfirst >= te) continue;
    const int tlast = tfirst + ((te - 1 - tfirst) / sl.wcount) * sl.wcount;
    const unsigned* ID16 = (const unsigned*)(F.ws + WS_IDX16);
    v4u ev[2]; i32x4 xq;
#pragma unroll
    for (int j = 0; j < 2; ++j) ev[j] = *(const v4u*)(ID16 + (size_t)tfirst * 64 + 8 * g + 4 * j);
    xq = *(const i32x4*)(X1Q + (size_t)tfirst * DM + 128 * p + 16 * i);
    for (int t = tfirst; t <= tlast; t += sl.wcount) {
        v4u w[16];
#pragma unroll
        for (int s = 0; s < 16; ++s) { const unsigned pk = ev[s >> 3][(s >> 1) & 3]; const unsigned e = (s & 1) ? (pk >> 16) : (pk & 0xffffu); w[s] = *(const v4u*)(UQ + (size_t)p * (NEXP * 128) + (size_t)e * 128 + 16 * i); }
        const int tn = (t + sl.wcount <= tlast) ? t + sl.wcount : tlast;
        v4u evn[2];
#pragma unroll
        for (int j = 0; j < 2; ++j) evn[j] = *(const v4u*)(ID16 + (size_t)tn * 64 + 8 * g + 4 * j);
        const i32x4 xqn = *(const i32x4*)(X1Q + (size_t)tn * DM + 128 * p + 16 * i);
        const float dq = X1S[(size_t)t * 8 + p];
        int part[16];
#pragma unroll
        for (int s = 0; s < 16; ++s) { int a = __builtin_amdgcn_sdot4((int)w[s].x, xq[0], 0, false); a = __builtin_amdgcn_sdot4((int)w[s].y, xq[1], a, false);
            a = __builtin_amdgcn_sdot4((int)w[s].z, xq[2], a, false); part[s] = __builtin_amdgcn_sdot4((int)w[s].w, xq[3], a, false); }
        { const bool up = (i & 4) != 0;
#pragma unroll
          for (int k = 0; k < 8; ++k) { const int lo_ = part[k], hi_ = part[k + 8]; const int keep = up ? hi_ : lo_, send = up ? lo_ : hi_; part[k] = keep + __shfl_xor(send, 4); } }
        { const bool up = (i & 2) != 0;
#pragma unroll
          for (int k = 0; k < 4; ++k) { const int lo_ = part[k], hi_ = part[k + 4]; const int keep = up ? hi_ : lo_, send = up ? lo_ : hi_; part[k] = keep + __builtin_amdgcn_mov_dpp(send, 0x4E, 0xF, 0xF, true); } }
        { const bool up = (i & 1) != 0;
#pragma unroll
          for (int k = 0; k < 2; ++k) { const int lo_ = part[k], hi_ = part[k + 2]; const int keep = up ? hi_ : lo_, send = up ? lo_ : hi_; part[k] = keep + __builtin_amdgcn_mov_dpp(send, 0xB1, 0xF, 0xF, true); } }
        *(unsigned*)(PART + ((size_t)p * T + t) * 128 + 16 * g + 2 * i) = cvtpk((float)part[0] * dq, (float)part[1] * dq);
        ev[0] = evn[0]; ev[1] = evn[1];
        xq = xqn;
    }
    }
}
__device__ __forceinline__ void expert_coef_phase(const Frame& F, const int tb, const int te) {
    const bf16* PART = (const bf16*)(F.ws + WS_PART); const float* GW = (const float*)(F.ws + WS_GW);
    const float* ssq = (const float*)(F.ws + WS_SSQ); const f32x2* SUV = (const f32x2*)(F.ws + WS_SUQ);
    bf16* COEF = (bf16*)(F.ws + WS_COEF); const unsigned short* ID16 = (const unsigned short*)(F.ws + WS_IDX16);
    const int gt = F.vcu * (NWAVES * 64) + F.tid, NGT = F.G * NWAVES * 64;
    for (int it8 = tb * 16 + gt; it8 < te * 16; it8 += NGT) {
        const int it = it8 * 8, t = it8 >> 4;
        v4u pp[8];
#pragma unroll
        for (int p = 0; p < 8; ++p) pp[p] = *(const v4u*)(PART + (size_t)p * T * 128 + it);
        const v4u idw = *(const v4u*)(ID16 + it);
        const f32x4 g0 = *(const f32x4*)(GW + it), g1 = *(const f32x4*)(GW + it + 4);
        float q = 0.f;
#pragma unroll
        for (int j = 0; j < 4; ++j) { const f32x4 v = *(const f32x4*)(ssq + (size_t)t * 16 + 4 * j); q += (v[0] + v[1]) + (v[2] + v[3]); }
        const float rstd = __builtin_amdgcn_rsqf(q * (1.0f / DM) + EPS);
        unsigned ids[8] = {idw.x & 0xffffu, idw.x >> 16, idw.y & 0xffffu, idw.y >> 16, idw.z & 0xffffu, idw.z >> 16, idw.w & 0xffffu, idw.w >> 16};
        float su[8], sv[8];
#pragma unroll
        for (int k = 0; k < 8; ++k) { const f32x2 s2 = SUV[ids[k]]; su[k] = s2[0]; sv[k] = s2[1]; }
        float s[8];
#pragma unroll
        for (int k = 0; k < 8; ++k) s[k] = 0.f;
#pragma unroll
        for (int p = 0; p < 8; ++p) { s[0] += bf_lo(pp[p].x); s[1] += bf_hi(pp[p].x); s[2] += bf_lo(pp[p].y); s[3] += bf_hi(pp[p].y); s[4] += bf_lo(pp[p].z); s[5] += bf_hi(pp[p].z); s[6] += bf_lo(pp[p].w); s[7] += bf_hi(pp[p].w); }
        const float gw[8] = {g0[0], g0[1], g0[2], g0[3], g1[0], g1[1], g1[2], g1[3]};
        float c[8];
#pragma unroll
        for (int k = 0; k < 8; ++k) c[k] = gelu1(s[k] * rstd * su[k]) * gw[k] * sv[k];
        *(v4u*)(COEF + it) = (v4u){cvtpk(c[0], c[1]), cvtpk(c[2], c[3]), cvtpk(c[4], c[5]), cvtpk(c[6], c[7])};
    }
}
__device__ __forceinline__ float bfly32(float keep_lo, float keep_hi) { asm("s_nop 1\n\tv_permlane32_swap_b32_e32 %0, %1" : "+v"(keep_lo), "+v"(keep_hi)); return keep_lo + keep_hi; }
__device__ __forceinline__ float bfly16(float keep_lo, float keep_hi) { asm("s_nop 1\n\tv_permlane16_swap_b32_e32 %0, %1" : "+v"(keep_lo), "+v"(keep_hi)); return keep_lo + keep_hi; }
__device__ __forceinline__ float dpp_ror8(float v) { return __builtin_bit_cast(float, __builtin_amdgcn_mov_dpp(__builtin_bit_cast(int, v), 0x128, 0xF, 0xF, true)); }
__device__ __forceinline__ float wave_sum_dpp(float v) {
    v += dpp_xor1(v); v += dpp_xor2(v);
    v += __builtin_bit_cast(float, __builtin_amdgcn_mov_dpp(__builtin_bit_cast(int, v), 0x141, 0xF, 0xF, true));
    v += __builtin_bit_cast(float, __builtin_amdgcn_mov_dpp(__builtin_bit_cast(int, v), 0x140, 0xF, 0xF, true));
    const int iv = __builtin_bit_cast(int, v);
    return (__builtin_bit_cast(float, __builtin_amdgcn_readlane(iv, 0)) + __builtin_bit_cast(float, __builtin_amdgcn_readlane(iv, 16))) +
           (__builtin_bit_cast(float, __builtin_amdgcn_readlane(iv, 32)) + __builtin_bit_cast(float, __builtin_amdgcn_readlane(iv, 48)));
}
__device__ __forceinline__ void expert_v_phase(const Frame& F, const int tb, const int te) {
    const unsigned* COEF = (const unsigned*)(F.ws + WS_COEF);
    float* SSQ2 = (float*)(F.ws + WS_SSQ2); const int lane = F.lane, g = lane >> 3, i = lane & 7;
    const Slice sl = slice_of(F);
    for (int p = sl.p0; p < sl.p0 + sl.np; ++p) {
    const int tfirst = tb + sl.wrank;
    if (tfirst >= te) continue;
    const int tlast = tfirst + ((te - 1 - tfirst) / sl.wcount) * sl.wcount;
    const unsigned* ID16 = (const unsigned*)(F.ws + WS_IDX16) + 8 * g;
    const unsigned char* VQs = F.ws + WS_VQ + (size_t)p * (NEXP * 128);
    const unsigned lo16 = 16u * i;
    const bf16* XBp = (const bf16*)(F.ws + WS_XB) + 128 * p + 16 * i + 2 * g;
    bf16* YBp = (bf16*)(F.ws + WS_YB) + 128 * p + 16 * i + 2 * g;
    const unsigned* CFp = COEF + 8 * g;
#define V_IDS(ev, tt) do { ev[0] = *(const v4u*)(ID16 + (size_t)(tt) * 64); ev[1] = *(const v4u*)(ID16 + (size_t)(tt) * 64 + 4); } while (0)
#define V_GATHER(W, cv, xw, ev, tt) do { \
        _Pragma("unroll") for (int s = 0; s < 16; ++s) { const unsigned pk = ev[s >> 3][(s >> 1) & 3]; const unsigned e = (s & 1) ? (pk >> 16) : (pk & 0xffffu); W[s] = *(const v4u*)(VQs + (e * 128u + lo16)); } \
        cv[0] = *(const v4u*)(CFp + (size_t)(tt) * 64); cv[1] = *(const v4u*)(CFp + (size_t)(tt) * 64 + 4); \
        xw = *(const unsigned*)(XBp + (size_t)(tt) * DM); } while (0)
#define V_COMPUTE(W, cv, xw, tt) do { \
        f32x2 acc2[8]; \
        _Pragma("unroll") for (int c = 0; c < 8; ++c) acc2[c] = (f32x2){0.f, 0.f}; \
        _Pragma("unroll") for (int s = 0; s < 16; ++s) { const unsigned pk = cv[s >> 3][(s >> 1) & 3]; axpy_pk(acc2, (s & 1) ? bf_hi(pk) : bf_lo(pk), W[s]); } \
        float acc[16]; \
        _Pragma("unroll") for (int c = 0; c < 8; ++c) { acc[2 * c] = acc2[c][0]; acc[2 * c + 1] = acc2[c][1]; } \
          \
        _Pragma("unroll") for (int k = 0; k < 8; ++k) acc[k] = bfly32(acc[k], acc[k + 8]); \
        _Pragma("unroll") for (int k = 0; k < 4; ++k) acc[k] = bfly16(acc[k], acc[k + 4]); \
        { const bool up = (g & 1) != 0; \
          _Pragma("unroll") for (int k = 0; k < 2; ++k) { const float lo_ = acc[k], hi_ = acc[k + 2]; const float keep = up ? hi_ : lo_, send = up ? lo_ : hi_; acc[k] = keep + dpp_ror8(send); } } \
        const float y0 = bf_lo(xw) + acc[0], y1 = bf_hi(xw) + acc[1]; \
        *(unsigned*)(YBp + (size_t)(tt) * DM) = cvtpk(y0, y1); \
        const float ss = wave_sum_dpp(y0 * y0 + y1 * y1); \
        if (lane == 0) SSQ2[(size_t)(tt) * 8 + p] = ss; } while (0)
#define V_STEP(Wc, cvc, xwc, tc, Wn, cvn, xwn, evn, evnn, tn, tnn) do { \
        V_IDS(evnn, tnn); \
        cvn[0] = *(const v4u*)(CFp + (size_t)(tn) * 64); cvn[1] = *(const v4u*)(CFp + (size_t)(tn) * 64 + 4); \
        xwn = *(const unsigned*)(XBp + (size_t)(tn) * DM); \
        __builtin_amdgcn_sched_barrier(0);                                             \
        f32x2 acc2[8]; \
        _Pragma("unroll") for (int c = 0; c < 8; ++c) acc2[c] = (f32x2){0.f, 0.f}; \
        _Pragma("unroll") for (int s = 0; s < 16; ++s) { \
            if (s < 8) { const unsigned pk = evn[s >> 2][s & 3]; Wn[2 * s] = *(const v4u*)(VQs + ((pk & 0xffffu) * 128u + lo16)); Wn[2 * s + 1] = *(const v4u*)(VQs + ((pk >> 16) * 128u + lo16)); }     \
            { const unsigned pk = cvc[s >> 3][(s >> 1) & 3]; axpy_pk(acc2, (s & 1) ? bf_hi(pk) : bf_lo(pk), Wc[s]); } \
            __builtin_amdgcn_sched_barrier(0); } \
        float acc[16]; \
        _Pragma("unroll") for (int c = 0; c < 8; ++c) { acc[2 * c] = acc2[c][0]; acc[2 * c + 1] = acc2[c][1]; } \
        _Pragma("unroll") for (int k = 0; k < 8; ++k) acc[k] = bfly32(acc[k], acc[k + 8]); \
        _Pragma("unroll") for (int k = 0; k < 4; ++k) acc[k] = bfly16(acc[k], acc[k + 4]); \
        { const bool up = (g & 1) != 0; \
          _Pragma("unroll") for (int k = 0; k < 2; ++k) { const float lo_ = acc[k], hi_ = acc[k + 2]; const float keep = up ? hi_ : lo_, send = up ? lo_ : hi_; acc[k] = keep + dpp_ror8(send); } } \
        const float y0 = bf_lo(xwc) + acc[0], y1 = bf_hi(xwc) + acc[1]; \
        *(unsigned*)(YBp + (size_t)(tc) * DM) = cvtpk(y0, y1); \
        const float ss = wave_sum_dpp(y0 * y0 + y1 * y1); \
        if (lane == 0) SSQ2[(size_t)(tc) * 8 + p] = ss; } while (0)
    v4u evA[2], evB[2], cvA[2], cvB[2], WA[16], WB[16]; unsigned xwA, xwB;
    int t = tfirst;
    V_IDS(evA, t);
    V_GATHER(WA, cvA, xwA, evA, t);
    { const int t1 = (t + sl.wcount <= tlast) ? t + sl.wcount : tlast; V_IDS(evB, t1); }
    for (;;) {
        { const int t1 = (t + sl.wcount <= tlast) ? t + sl.wcount : tlast, t2 = (t1 + sl.wcount <= tlast) ? t1 + sl.wcount : tlast;
          V_STEP(WA, cvA, xwA, t, WB, cvB, xwB, evB, evA, t1, t2); }
        if (t + sl.wcount > tlast) break;
        t += sl.wcount;
        { const int t1 = (t + sl.wcount <= tlast) ? t + sl.wcount : tlast, t2 = (t1 + sl.wcount <= tlast) ? t1 + sl.wcount : tlast;
          V_STEP(WB, cvB, xwB, t, WA, cvA, xwA, evA, evB, t1, t2); }
        if (t + sl.wcount > tlast) break;
        t += sl.wcount;
    }
#undef V_STEP
#undef V_IDS
#undef V_GATHER
#undef V_COMPUTE
    }
}
__device__ __forceinline__ void final_norm_phase(const Frame& F) {
    const float* SSQ2 = (const float*)(F.ws + WS_SSQ2); const float* gf = F.in[22]; float* out = F.out;
    const int gw = F.vcu * NWAVES + F.wave, NGW = F.G * NWAVES, lane = F.lane;
    f32x4 gv[4];
#pragma unroll
    for (int j = 0; j < 4; ++j) gv[j] = *((const f32x4*)gf + lane + 64 * j);
    for (int t = gw; t < T; t += NGW) {
        const f32x4 a = *(const f32x4*)(SSQ2 + (size_t)t * 8), b = *(const f32x4*)(SSQ2 + (size_t)t * 8 + 4);
        const float r = 1.0f / sqrtf(((a[0] + a[1]) + (a[2] + a[3]) + (b[0] + b[1]) + (b[2] + b[3])) * (1.0f / DM) + EPS);
        f32x4* row = (f32x4*)(out + (size_t)t * DM) + lane;
        const v2u* yr = (const v2u*)((const bf16*)(F.ws + WS_YB) + (size_t)t * DM) + lane;
        v2u yv[4];
#pragma unroll
        for (int j = 0; j < 4; ++j) yv[j] = yr[64 * j];
#pragma unroll
        for (int j = 0; j < 4; ++j) { const f32x4 v = {bf_lo(yv[j].x), bf_hi(yv[j].x), bf_lo(yv[j].y), bf_hi(yv[j].y)}; row[64 * j] = v * r * gv[j]; }
    }
}
}
struct Args { const float* in[23]; float* out; unsigned char* ws; };
constexpr int N_PHASES = 8;

template <int K> __device__ __forceinline__ void run_phase(Frame& F) {
    asm volatile("" : "+v"(F.tid), "+v"(F.lane));
    unsigned char* ws = F.ws;
    if constexpr (K == 0) { p0_prologue(F); }
    if constexpr (K == 1) {
        pg8::Gemm g{(const pg8::bf16_t*)(ws + WS_XB), (const pg8::bf16_t*)(ws + WS_W1T), T, N1, DM};
        pg8::StaticOrder S; S.init(T, N1, F.G, (int)blockIdx.x);
        EpiP1 E{ws, F.in[15], (const float*)(ws + WS_ROPE)};
        pg8::gemm_phase<EpiP1, pg8::StaticOrder, true, true>(F.lds, g, S, E);
    }
    if constexpr (K == 2) {
        const float lam = ((const float*)(ws + WS_MISC))[0];
        for (int pi = F.vcu; pi < 512; pi += F.G) {
            const int bh = pi >> 5, s = pi & 31;
            att::attn_unit<0>(F, bh >> 2, bh & 3, 63 - s, (bf16*)(ws + WS_Q), (const bf16*)(ws + WS_K), (const bf16*)(ws + WS_V), lam, F.in[7]);
            att::attn_unit<0>(F, bh >> 2, bh & 3, s, (bf16*)(ws + WS_Q), (const bf16*)(ws + WS_K), (const bf16*)(ws + WS_V), lam, F.in[7]);
        }
#ifndef NO_SGU
        for (int u = F.vcu; u < T / 128; u += F.G)
            sgu::sgu_unit(F, u, (bf16*)(ws + WS_SU), (const bf16*)(ws + WS_SV), (const bf16*)(ws + WS_WSM), F.in[8], F.in[9], F.in[11]);
#endif
    }
#ifdef ATT_PROBE
    if constexpr (K == 11) {
        const float lam = ((const float*)(ws + WS_MISC))[0];
        for (int pi = F.vcu; pi < 512; pi += F.G) {
            const int bh = pi >> 5, s = pi & 31;
            att::attn_unit<ATT_PROBE>(F, bh >> 2, bh & 3, 63 - s, (bf16*)(ws + WS_Q), (const bf16*)(ws + WS_K), (const bf16*)(ws + WS_V), lam, F.in[7]);
            att::attn_unit<ATT_PROBE>(F, bh >> 2, bh & 3, s, (bf16*)(ws + WS_Q), (const bf16*)(ws + WS_K), (const bf16*)(ws + WS_V), lam, F.in[7]);
        }
    }
#endif
    if constexpr (K == 3) {
#ifdef P3_STAGGER
        if (F.vcu & 1) { for (int i_ = 0; i_ < P3_STAGGER; ++i_) __builtin_amdgcn_s_sleep(127); }
#endif
        pg8::Gemm g{(const pg8::bf16_t*)(ws + WS_Q), (const pg8::bf16_t*)(ws + WS_WAB), 2 * T, 2048, 512};
        BranchOrder S; S.so.init(T, DM, F.G, (int)blockIdx.x);
        EpiGate E{(bf16*)(ws + WS_G), (const unsigned char*)(ws + WS_GATES)};
        pg8::gemm_phase<EpiGate, BranchOrder, true, true>(F.lds, g, S, E);
    }
    if constexpr (K == 4) {
        pg8::Gemm g{(const pg8::bf16_t*)(ws + WS_G), (const pg8::bf16_t*)(ws + WS_WO2), T, DM, DM};
        pg8::StaticOrder S; S.init(T, DM, F.G, (int)blockIdx.x);
        EpiX1 E{F.in[0], F.out, (bf16*)(ws + WS_XB), (float*)(ws + WS_SSQ)};
        pg8::gemm_phase<EpiX1, pg8::StaticOrder, true, true>(F.lds, g, S, E);
    }
    if constexpr (K == 5) {
        pg8::Gemm g{(const pg8::bf16_t*)(ws + WS_XB), (const pg8::bf16_t*)(ws + WS_WEF), T, 2048, DM};
        pg8::StaticOrder S; S.init(T, 2048, F.G, (int)blockIdx.x);
        EpiScores E{(unsigned short*)(ws + WS_SCORES)};
        pg8::gemm_phase<EpiScores, pg8::StaticOrder, true, true>(F.lds, g, S, E);
    }
    if constexpr (K == 6) { peer::topk_phase(F); }
    if constexpr (K == 7) { peer::expert_u_phase(F, 0, T); }
    if constexpr (K == 8) { peer::expert_coef_phase(F, 0, T); }
    if constexpr (K == 9) { peer::expert_v_phase(F, 0, T); }
    if constexpr (K == 10) { peer::final_norm_phase(F); }
}

#ifndef PROGRAM
#define PROGRAM P(0) S0 P(1) S P(2) S P(3) S P(4) S P(5) S P(6) S P(7) S P(8) S P(9) S P(10)
#endif

__global__ void __launch_bounds__(NWAVES * 64, 2) mk_fwd(Args args) {
    extern __shared__ __attribute__((aligned(16))) unsigned char lds[];
    cg::grid_group grid = cg::this_grid();
    Frame F;
    F.lds = (LAS unsigned char*)lds;
    F.tid = threadIdx.x; F.lane = F.tid & 63; F.wave = __builtin_amdgcn_readfirstlane(F.tid >> 6);
    F.G = gridDim.x; { const int bx = blockIdx.x; F.vcu = (F.G % 8 == 0) ? (bx % 8) * (F.G / 8) + bx / 8 : bx; }
#pragma unroll
    for (int i = 0; i < 23; ++i) F.in[i] = args.in[i];
    F.out = args.out; F.ws = args.ws;
    volatile LAS unsigned* bst = (volatile LAS unsigned*)(F.lds + BAR_LDS_OFF);
    if (F.tid < 2) bst[F.tid] = 0u;
    __syncthreads();
    const XcdBarrier bar = xcd_barrier_post((unsigned*)(F.ws + WS_CTL) + CW_BAR, bst);
#define P(k) run_phase<k>(F);
#define S0 { __syncthreads(); grid.sync(); }
#define S { xcd_barrier(bar); }
    PROGRAM
#undef P
#undef S
#undef S0
}

#if DBG
struct DumpEnt { unsigned long long off; unsigned n; int type; };
struct DumpArgs { DumpEnt e[10]; int cnt; int pad; unsigned char* ws; float* out; };
__global__ void dbg_dump(DumpArgs a) {
    const unsigned NOUT = (unsigned)T * DM;
    for (unsigned i = blockIdx.x * blockDim.x + threadIdx.x; i < NOUT; i += gridDim.x * blockDim.x) {
        float acc = 0.f;
        for (int k = 0; k < a.cnt; ++k) {
            const DumpEnt en = a.e[k];
            const unsigned char* base = (en.off == ~0ull) ? (const unsigned char*)a.out : a.ws + en.off;
            for (unsigned j = i; j < en.n; j += NOUT) {
                float v;
                if (en.type == 0) v = bf2f(((const bf16*)base)[j]); else if (en.type == 1) v = ((const float*)base)[j]; else v = (float)((const int*)base)[j];
                acc += v;
            }
        }
        a.out[i] = acc;
    }
}
#endif
extern "C" void kernel_launch(void* const* d_in, const int* in_sizes, int n_in, void* d_out, int out_size, void* d_ws, size_t ws_size, hipStream_t stream) {
    static int grid = 0;
    if (grid == 0) {
        if (n_in != 23 || in_sizes[0] != T * DM || out_size != T * DM || ws_size < WS_END) { fprintf(stderr, "kernel_launch: unexpected shapes (n_in %d, in0 %d, out %d, ws %zu)\n", n_in, n_in > 0 ? in_sizes[0] : -1, out_size, ws_size); grid = -1; return; }
        int dev = 0, cus = 0, per_cu = 0;
        if (hipGetDevice(&dev) != hipSuccess || hipDeviceGetAttribute(&cus, hipDeviceAttributeMultiprocessorCount, dev) != hipSuccess) { grid = -1; return; }
        if (hipFuncSetAttribute((const void*)mk_fwd, hipFuncAttributeMaxDynamicSharedMemorySize, LDS_BYTES) != hipSuccess) { fprintf(stderr, "kernel_launch: hipFuncSetAttribute failed\n"); grid = -1; return; }
        if (hipOccupancyMaxActiveBlocksPerMultiprocessor(&per_cu, (const void*)mk_fwd, NWAVES * 64, LDS_BYTES) != hipSuccess || per_cu < 1) { fprintf(stderr, "kernel_launch: occupancy query says %d\n", per_cu); per_cu = 1; }
        (void)hipGetLastError();
        grid = cus;
    }
    if (grid < 0) return;
    if (hipMemsetAsync((char*)d_ws + WS_CTL, 0, CTL_ZERO_BYTES, stream) != hipSuccess) { fprintf(stderr, "kernel_launch: hipMemsetAsync failed\n"); return; }
    Args a{};
    for (int i = 0; i < 23; ++i) a.in[i] = (const float*)d_in[i];
    a.out = (float*)d_out; a.ws = (unsigned char*)d_ws;
    void* kargs[] = {&a};
    hipError_t e = hipLaunchCooperativeKernel((const void*)mk_fwd, dim3(grid), dim3(NWAVES * 64), kargs, LDS_BYTES, stream);
    if (e != hipSuccess) fprintf(stderr, "kernel_launch: cooperative launch failed: %s (grid %d)\n", hipGetErrorString(e), grid);
#if DBG
    const int last_phase = (DBG - 1) % 10;
#endif
#if DBG
    {
        DumpArgs d{}; d.ws = (unsigned char*)d_ws; d.out = (float*)d_out; int c = 0;
        auto add = [&](unsigned long long off, unsigned n, int type) { d.e[c].off = off; d.e[c].n = n; d.e[c].type = type; ++c; };
        const unsigned M1 = 1u << 20;
        switch (last_phase) {
            case 0: if (DBG >= 10) { add(WS_W1T, 4608 * 1024, 0); break; } add(WS_XB, 32 * M1, 0); add(WS_W1T, 4608 * 1024, 0); add(WS_WAB, M1, 0); add(WS_WO2, 2 * M1, 0); add(WS_WEF, 2 * M1, 0);  add(WS_ROPE, 512 * 1024, 1); add(WS_WSM, 65536, 0); add(WS_MISC, 1, 1); break;
            case 1: if (DBG < 10) { add(WS_Q, 16 * M1, 0); add(WS_SU, 16 * M1, 0); add(WS_GATES, 64 * M1, 0); add(WS_K, 16 * M1, 0); add(WS_V, 16 * M1, 0); add(WS_SV, 16 * M1, 0); }
                    else if (DBG < 20) add(WS_GATES, 64 * M1, 0);
                    else if (DBG < 30) { add(WS_Q, 16 * M1, 0); add(WS_K, 16 * M1, 0); }
                    else if (DBG < 40) { add(WS_V, 16 * M1, 0); }
                    else { add(WS_SU, 16 * M1, 0); add(WS_SV, 16 * M1, 0); } break;
            case 2: if (DBG < 10) { add(WS_Q, 16 * M1, 0); add(WS_SU, 16 * M1, 0); } else if (DBG < 20) add(WS_Q, 16 * M1, 0); else add(WS_SU, 16 * M1, 0); break;
            case 3: add(WS_G, 64 * M1, 0); break;
            case 4: add(~0ull, 32 * M1, 1); add(WS_XB, 32 * M1, 0); add(WS_SSQ, 512 * 1024, 1); break;
            case 5: add(WS_SCORES, 64 * M1, 1); break;
            case 6: add(WS_IDX, 4 * M1, 2); add(WS_GW, 4 * M1, 1); break;
            default: break;
        }
        d.cnt = c;
        if (c) hipLaunchKernelGGL(dbg_dump, dim3(2048), dim3(256), 0, stream, d);
    }
#endif
}
```

```cpp
#include <hip/hip_runtime.h>
#include <hip/hip_cooperative_groups.h>
#include <cstdio>
#include <cstdint>
#include <type_traits>
namespace cg = cooperative_groups;

#ifndef DBG
#define DBG 0
#endif
#define ATT_AHEAD 4
namespace pg8 {
#define PG8_LAS __attribute__((address_space(3)))
typedef unsigned short bf16_t;
typedef short bf16x8 __attribute__((ext_vector_type(8)));
typedef float f32x4 __attribute__((ext_vector_type(4)));
typedef unsigned u32x4 __attribute__((ext_vector_type(4)));
constexpr int BM = 256, BK = 64, HALF = 128, HTB = HALF * BK * 2  , STAGE_BYTES = 8 * HTB, NXCD = 8, WGM = 8;

__host__ __device__ __forceinline__ int lds_byte(int r, int c) { const int st = (r >> 4) * 2 + (c >> 5), rr = r & 15, cc = c & 31, ob = rr * 64 + cc * 2; return st * 1024 + (ob ^ (((ob >> 9) & 1) << 5)); }
__host__ __device__ __forceinline__ void stage_rc(int b, int& R, int& C) { const int st = b / 1024, sb = b % 1024, swz = sb ^ (((sb >> 9) & 1) << 5); R = (st >> 1) * 16 + swz / 64; C = (st & 1) * 32 + (swz % 64) / 2; }
__host__ __device__ __forceinline__ int perm32(int rho) { const int n = rho >> 4, i = rho & 15; return 8 * (i >> 2) + 4 * n + (i & 3); }

struct Unit { int pm, pn; };
struct Gemm { const bf16_t* A; const bf16_t* Bt; int M, N, K; };

struct StaticOrder {
    int nM, nN, nwg, G, c;
    __host__ __device__ void init(int M, int N, int G_, int c_) { nM = M / BM; nN = N / BM; nwg = nM * nN; G = G_; c = c_; }
    __host__ __device__ bool next(int i, Unit& u) const {
        const long L = (long)i * G + c; if (L >= nwg) return false;
        int wgid = (int)L; { const int q = nwg / NXCD, r = nwg % NXCD, xcd = wgid % NXCD, off = wgid / NXCD; wgid = (xcd < r ? xcd * (q + 1) : r * (q + 1) + (xcd - r) * q) + off; }
        const int nig = WGM * nN, gid = wgid / nig, fm = gid * WGM, gsz = (nM - fm) < WGM ? (nM - fm) : WGM;
        u.pm = fm + ((wgid % nig) % gsz); u.pn = (wgid % nig) / gsz; return true;
    }
    __device__ __forceinline__ void a_ready(const Unit&) const {}
    __device__ __forceinline__ void done(const Unit&) const {}
};

__device__ __forceinline__ unsigned cvt_pk_bf16(float lo, float hi) { unsigned r; asm volatile("v_cvt_pk_bf16_f32 %0, %1, %2" : "=v"(r) : "v"(lo), "v"(hi)); return r; }
typedef float f32x2 __attribute__((ext_vector_type(2)));
__device__ __forceinline__ f32x2 gelu_pk(f32x2 v) {
    const f32x2 av = __builtin_elementwise_abs(v), d = av * 0.2316418882f + 1.0f;
    f32x2 t; t.x = __builtin_amdgcn_rcpf(d.x); t.y = __builtin_amdgcn_rcpf(d.y);
    f32x2 q = t * 0.5307027145f + (-0.7265760135f); q = q * t + 0.7107068705f; q = q * t + (-0.142248368f); q = q * t + 0.127414796f; q = q * t;
    const f32x2 s = (v * v) * (-0.72134752044f);
    f32x2 e; e.x = __builtin_amdgcn_exp2f(s.x); e.y = __builtin_amdgcn_exp2f(s.y);
    const f32x2 m = v * (q * e), r = v - m;
    f32x2 o; o.x = v.x < 0.f ? m.x : r.x; o.y = v.y < 0.f ? m.y : r.y; return o;
}

typedef int i32x4 __attribute__((ext_vector_type(4)));
template <class Epi, class Sched, bool ALIGN_EPI = false, bool SP2 = false>
__device__ __forceinline__ void gemm_phase(PG8_LAS unsigned char* lds, const Gemm g, const Sched& S, const Epi& E) {
    int tid_ = threadIdx.x; asm volatile("" : "+v"(tid_));
    const int tid = tid_, wid = __builtin_amdgcn_readfirstlane(tid >> 6), lane = tid & 63, wr = wid >> 2, wc = wid & 3, fr = lane & 15, fq = lane >> 4;
    const int K = g.K, nt = K / BK;
    unsigned voffA[2], voffB[2];
#pragma unroll
    for (int i = 0; i < 2; ++i) { int R, C; stage_rc(tid * 16 + i * 8192, R, C); const int Rb = Epi::PERM ? ((R & ~31) + perm32(R & 31)) : R;
        voffA[i] = (unsigned)(R * K + C) * 2u; voffB[i] = (unsigned)(Rb * K + C) * 2u; }
    const size_t kstep = (size_t)(BK * 2);
    const size_t hstep = (size_t)HALF * K * 2;
    const size_t tstep = 2 * hstep;
    const unsigned ldsw = (unsigned)wid * 1024u;
    const int aoff = lds_byte(wr * 64 + fr, fq * 8), boff = lds_byte(wc * 32 + fr, fq * 8);
#define PG8_SA(b, h) (((b) * 2 + (h)) * HTB)
#define PG8_SB(b, h) ((4 + (b) * 2 + (h)) * HTB)
#define PG8_STAGE(bufoff, gbase, voff) do { _Pragma("unroll") for (int _i = 0; _i < 2; ++_i) \
        __builtin_amdgcn_global_load_lds((const unsigned*)((const char*)(gbase) + (voff)[_i]), (PG8_LAS unsigned*)(lds + (bufoff) + ldsw + _i * 8192), 16, 0, 0); } while (0)
#define PG8_LDA(dst, b, h) do { _Pragma("unroll") for (int m = 0; m < 4; ++m) _Pragma("unroll") for (int k = 0; k < 2; ++k) dst[m][k] = *(const PG8_LAS bf16x8*)(lds + PG8_SA(b, h) + aoff + m * 2048 + k * 1024); } while (0)
#define PG8_LDB(dst, b, h) do { _Pragma("unroll") for (int n = 0; n < 2; ++n) _Pragma("unroll") for (int k = 0; k < 2; ++k) dst[n][k] = *(const PG8_LAS bf16x8*)(lds + PG8_SB(b, h) + boff + n * 2048 + k * 1024); } while (0)
#define PG8_MMA(ai, bj, At, Bt) do { __builtin_amdgcn_s_setprio(1); _Pragma("unroll") for (int m = 0; m < 4; ++m) _Pragma("unroll") for (int n = 0; n < 2; ++n) _Pragma("unroll") for (int k = 0; k < 2; ++k) \
        { if constexpr (Epi::I8) acc[ai][bj][m][n] = __builtin_amdgcn_mfma_i32_16x16x64_i8(__builtin_bit_cast(i32x4, Bt[n][k]), __builtin_bit_cast(i32x4, At[m][k]), acc[ai][bj][m][n], 0, 0, 0); \
          else acc[ai][bj][m][n] = __builtin_amdgcn_mfma_f32_16x16x32_bf16(Bt[n][k], At[m][k], acc[ai][bj][m][n], 0, 0, 0); } __builtin_amdgcn_s_setprio(0); } while (0)
#define PG8_WAIT_V(n) asm volatile("s_waitcnt vmcnt(" #n ")" ::: "memory")
#define PG8_WAIT_L(n) asm volatile("s_waitcnt lgkmcnt(" #n ")" ::: "memory")
#define PG8_BAR __builtin_amdgcn_s_barrier()
#define PG8_SCHED __builtin_amdgcn_sched_barrier(0)
    Unit cur, nxt; int ui = 0;
    if (!S.next(0, cur)) return;
    typedef typename std::conditional<Epi::I8, i32x4, f32x4>::type acc_t;
    acc_t acc[2][2][4][2];
#pragma unroll
    for (int a = 0; a < 2; ++a)
#pragma unroll
        for (int b = 0; b < 2; ++b)
#pragma unroll
            for (int m = 0; m < 4; ++m)
#pragma unroll
                for (int n = 0; n < 2; ++n) acc[a][b][m][n] = (acc_t){0, 0, 0, 0};
    bf16x8 At[4][2], B0[2][2], B1[2][2];
    const char* cA = (const char*)g.A + (size_t)cur.pm * tstep; const char* cB = (const char*)g.Bt + (size_t)cur.pn * tstep;
    S.a_ready(cur);
    if constexpr (SP2) {
        PG8_STAGE(PG8_SB(0, 0), cB, voffB); PG8_STAGE(PG8_SB(0, 1), cB + hstep, voffB); PG8_STAGE(PG8_SA(0, 0), cA, voffA); PG8_STAGE(PG8_SA(0, 1), cA + hstep, voffA);
        if (wr == 1) PG8_BAR;
        PG8_WAIT_V(2); PG8_BAR;
        PG8_STAGE(PG8_SB(1, 0), cB + kstep, voffB); PG8_STAGE(PG8_SA(1, 0), cA + kstep, voffA); PG8_STAGE(PG8_SB(1, 1), cB + hstep + kstep, voffB);
        PG8_WAIT_V(6); PG8_BAR;
    } else {
        PG8_STAGE(PG8_SB(0, 0), cB, voffB); PG8_STAGE(PG8_SA(0, 0), cA, voffA); PG8_STAGE(PG8_SB(0, 1), cB + hstep, voffB); PG8_STAGE(PG8_SA(0, 1), cA + hstep, voffA);
        if (wr == 1) PG8_BAR;
        PG8_WAIT_V(4); PG8_BAR;
        PG8_STAGE(PG8_SB(1, 0), cB + kstep, voffB); PG8_STAGE(PG8_SA(1, 0), cA + kstep, voffA); PG8_STAGE(PG8_SB(1, 1), cB + hstep + kstep, voffB);
        PG8_WAIT_V(6); PG8_BAR;
    }
    for (;;) {
        const bool has_next = S.next(ui + 1, nxt);
        const char* nA = has_next ? (const char*)g.A + (size_t)nxt.pm * tstep : cA; const char* nB = has_next ? (const char*)g.Bt + (size_t)nxt.pn * tstep : cB;
        for (int t = 0; t < nt; t += 2) {
            const bool last = (t == nt - 2);
            const char* a1 = cA + (size_t)(t + 1) * kstep;
            const char* a2 = last ? nA : cA + (size_t)(t + 2) * kstep; const char* b2 = last ? nB : cB + (size_t)(t + 2) * kstep;
            const char* a3 = a2 + kstep; const char* b3 = b2 + kstep;
            if (last && has_next) S.a_ready(nxt);
            if constexpr (SP2) {
            PG8_LDB(B0, 0, 0); PG8_LDB(B1, 0, 1); PG8_SCHED; PG8_LDA(At, 0, 0); PG8_STAGE(PG8_SA(1, 1), a1 + hstep, voffA);
            PG8_WAIT_V(8); PG8_WAIT_L(0); PG8_BAR; PG8_MMA(0, 0, At, B0); PG8_MMA(0, 1, At, B1); PG8_BAR; PG8_SCHED;
            PG8_LDA(At, 0, 1); PG8_STAGE(PG8_SB(0, 0), b2, voffB); PG8_STAGE(PG8_SB(0, 1), b2 + hstep, voffB); PG8_STAGE(PG8_SA(0, 0), a2, voffA);
            PG8_WAIT_V(8); PG8_WAIT_L(0); PG8_BAR; PG8_MMA(1, 0, At, B0); PG8_MMA(1, 1, At, B1); PG8_BAR; PG8_SCHED;
            PG8_LDB(B0, 1, 0); PG8_LDB(B1, 1, 1); PG8_SCHED; PG8_LDA(At, 1, 0); PG8_STAGE(PG8_SA(0, 1), a2 + hstep, voffA);
            PG8_WAIT_V(8); PG8_WAIT_L(0); PG8_BAR; PG8_MMA(0, 0, At, B0); PG8_MMA(0, 1, At, B1); PG8_BAR; PG8_SCHED;
            PG8_LDA(At, 1, 1); PG8_STAGE(PG8_SB(1, 0), b3, voffB); PG8_STAGE(PG8_SB(1, 1), b3 + hstep, voffB); PG8_STAGE(PG8_SA(1, 0), a3, voffA);
            PG8_WAIT_V(8); PG8_WAIT_L(0); PG8_BAR; PG8_MMA(1, 0, At, B0); PG8_MMA(1, 1, At, B1); PG8_BAR; PG8_SCHED;
            } else {
            PG8_LDB(B0, 0, 0); PG8_SCHED; PG8_LDA(At, 0, 0); PG8_STAGE(PG8_SA(1, 1), a1 + hstep, voffA);
            PG8_WAIT_L(8); PG8_BAR; PG8_WAIT_L(0); PG8_MMA(0, 0, At, B0); PG8_BAR; PG8_SCHED;
            PG8_LDB(B1, 0, 1); PG8_STAGE(PG8_SB(0, 0), b2, voffB);
            PG8_BAR; PG8_WAIT_L(0); PG8_MMA(0, 1, At, B1); PG8_BAR;
            PG8_LDA(At, 0, 1); PG8_STAGE(PG8_SA(0, 0), a2, voffA);
            PG8_BAR; PG8_WAIT_L(0); PG8_MMA(1, 0, At, B0); PG8_BAR; PG8_SCHED;
            PG8_STAGE(PG8_SB(0, 1), b2 + hstep, voffB);
            PG8_WAIT_V(6); PG8_BAR; PG8_MMA(1, 1, At, B1); PG8_BAR;
            PG8_LDB(B0, 1, 0); PG8_SCHED; PG8_LDA(At, 1, 0); PG8_STAGE(PG8_SA(0, 1), a2 + hstep, voffA);
            PG8_WAIT_L(8); PG8_BAR; PG8_WAIT_L(0); PG8_MMA(0, 0, At, B0); PG8_BAR; PG8_SCHED;
            PG8_LDB(B1, 1, 1); PG8_STAGE(PG8_SB(1, 0), b3, voffB);
            PG8_BAR; PG8_WAIT_L(0); PG8_MMA(0, 1, At, B1); PG8_BAR;
            PG8_LDA(At, 1, 1); PG8_STAGE(PG8_SA(1, 0), a3, voffA);
            PG8_BAR; PG8_WAIT_L(0); PG8_MMA(1, 0, At, B0); PG8_BAR; PG8_SCHED;
            PG8_STAGE(PG8_SB(1, 1), b3 + hstep, voffB);
            PG8_WAIT_V(6); PG8_BAR; PG8_MMA(1, 1, At, B1); PG8_BAR;
            }
        }
        if constexpr (ALIGN_EPI) { if (wr == 0) PG8_BAR; }
        if constexpr (!Epi::AFTER_DRAIN) { E(acc, cur, wr, wc, fr, fq); S.done(cur); }
        if (!has_next) break;
#pragma unroll
        for (int a = 0; a < 2; ++a)
#pragma unroll
            for (int b = 0; b < 2; ++b)
#pragma unroll
                for (int m = 0; m < 4; ++m)
#pragma unroll
                    for (int n = 0; n < 2; ++n) acc[a][b][m][n] = (acc_t){0, 0, 0, 0};
        cur = nxt; cA = nA; cB = nB; ++ui;
        if constexpr (ALIGN_EPI) { if (wr == 1) PG8_BAR; }
    }
    PG8_WAIT_V(0);
    if constexpr (!ALIGN_EPI) { if (wr == 0) PG8_BAR; }
    PG8_BAR;
    if constexpr (Epi::AFTER_DRAIN) { E.fused(acc, cur, wr, wc, fr, fq, lds, wid, lane); S.done(cur); }
#undef PG8_SA
#undef PG8_SB
#undef PG8_STAGE
#undef PG8_LDA
#undef PG8_LDB
#undef PG8_MMA
#undef PG8_WAIT_V
#undef PG8_WAIT_L
#undef PG8_BAR
#undef PG8_SCHED
}
}
constexpr int NB = 4, SEQ = 8192, DM = 1024, T = NB * SEQ;
constexpr int HW = 512;
constexpr int N1 = 4608;
constexpr int NEXP = 16384, PK_TOP = 16, PK_HEADS = 8;
constexpr float EPS = 1e-6f;
constexpr float QSCALE = 0.125f * 1.4426950408889634f;
constexpr float LAMBDA_INIT = 0.2f;

constexpr size_t MiB = 1u << 20;
constexpr size_t WS_CTL = 0, CTL_ZERO_BYTES = 65536;
constexpr int CW_BAR = 1024;
constexpr size_t WS_W1T = 2 * MiB;
constexpr size_t WS_WAB = 11 * MiB;
constexpr size_t WS_WO2 = 13 * MiB;
constexpr size_t WS_WEF = 17 * MiB;
constexpr size_t WS_ROPE = 21 * MiB;
constexpr size_t WS_WSM = 23 * MiB;
constexpr size_t WS_MISC = 23 * MiB + 512 * 1024;
constexpr size_t WS_UQ = 24 * MiB;
constexpr size_t WS_VQ = 40 * MiB;
constexpr size_t WS_SUQ = 56 * MiB;
constexpr size_t WS_XB = 88 * MiB;
constexpr size_t WS_W1Q = 58 * MiB;
constexpr size_t WS_XS = 63 * MiB;
constexpr size_t WS_WSC = 63 * MiB + 256 * 1024;
constexpr int CW_CMAX = 8192;
constexpr size_t WS_Q = 152 * MiB;
constexpr size_t WS_SU = 184 * MiB;
constexpr size_t WS_GATES = 216 * MiB;
constexpr size_t WS_K = 344 * MiB;
constexpr size_t WS_V = 376 * MiB;
constexpr size_t WS_SV = 408 * MiB;
constexpr size_t WS_G = 344 * MiB;
constexpr size_t WS_SCORES = 152 * MiB;
constexpr size_t WS_SSQ = 472 * MiB;
constexpr size_t WS_IDX = 474 * MiB;
constexpr size_t WS_GW = 490 * MiB;
constexpr size_t WS_PART = 152 * MiB;
constexpr size_t WS_COEF = 280 * MiB;
constexpr size_t WS_X1Q = 408 * MiB;
constexpr size_t WS_X1S = 440 * MiB;
constexpr size_t WS_IDX16 = 444 * MiB;
constexpr size_t WS_YB = 216 * MiB;
constexpr size_t WS_SSQ2 = 296 * MiB;
constexpr size_t WS_END = 506 * MiB;
static_assert(WS_SCORES + (size_t)T * 2048 * 4 <= WS_SSQ && WS_G + (size_t)T * 2048 * 2 <= WS_SSQ, "ws map");

constexpr int RING_BYTES = 131072;
constexpr int BAR_LDS_OFF = 147456 - 64;
constexpr int LDS_BYTES = 147456;
constexpr int NWAVES = 8;

#define GAS __attribute__((address_space(1)))
#define LAS __attribute__((address_space(3)))
typedef unsigned short bf16;
typedef unsigned v4u __attribute__((ext_vector_type(4)));
typedef unsigned v2u __attribute__((ext_vector_type(2)));
typedef float f32x4 __attribute__((ext_vector_type(4)));
typedef float f32x2 __attribute__((ext_vector_type(2)));
typedef float f32x16 __attribute__((ext_vector_type(16)));
typedef short bf16x8 __attribute__((ext_vector_type(8)));
typedef short s16x4 __attribute__((ext_vector_type(4)));
#define LDS_WAIT() asm volatile("s_waitcnt lgkmcnt(0)" ::: "memory")
#define VM_WAIT() asm volatile("s_waitcnt vmcnt(0)" ::: "memory")
#define CFENCE() asm volatile("" ::: "memory")
__device__ __forceinline__ unsigned f2bf(float f) { unsigned u = __builtin_bit_cast(unsigned, f); return (u + 0x7fffu + ((u >> 16) & 1u)) >> 16; }
__device__ __forceinline__ unsigned pk2(float lo, float hi) { return f2bf(lo) | (f2bf(hi) << 16); }
typedef __bf16 bf16x2_t __attribute__((ext_vector_type(2)));
__device__ __forceinline__ unsigned cvtpk(float lo, float hi) { const f32x2 v = {lo, hi}; const bf16x2_t b = __builtin_convertvector(v, bf16x2_t); return __builtin_bit_cast(unsigned, b); }
__device__ __forceinline__ float bf_lo(unsigned w) { return __builtin_bit_cast(float, w << 16); }
__device__ __forceinline__ float bf_hi(unsigned w) { return __builtin_bit_cast(float, w & 0xffff0000u); }
__device__ __forceinline__ float bf2f(bf16 b) { return __builtin_bit_cast(float, (unsigned)b << 16); }
__device__ __forceinline__ float wave_sum(float v) {
#pragma unroll
    for (int o = 1; o < 64; o <<= 1) v += __shfl_xor(v, o);
    return v;
}
__device__ __forceinline__ float gelu1(float v) {
    const float av = __builtin_fabsf(v), t = __builtin_amdgcn_rcpf(av * 0.2316418882f + 1.0f);
    float q = t * 0.5307027145f + (-0.7265760135f); q = q * t + 0.7107068705f; q = q * t + (-0.142248368f); q = q * t + 0.127414796f; q = q * t;
    const float e = __builtin_amdgcn_exp2f((v * v) * (-0.72134752044f));
    const float m = v * (q * e);
    return v < 0.f ? m : v - m;
}

struct Frame {
    LAS unsigned char* lds;
    int tid, lane, wave, vcu, G;
    const float* in[23]; float* out; unsigned char* ws;
};

__device__ __forceinline__ int rowmap_fn(int n, int rowmode, int row_off) {
    if (rowmode == 1 && n < 1024) return (n & ~63) | (2 * (n & 31) + ((n >> 5) & 1));
    return row_off + n;
}
__device__ __forceinline__ void p0_transpose_item(const float* W, int N, bf16* WT, int ldt, int koff, int rowmode, int row_off, LAS float* scr, int item, int lane, unsigned* cmax = nullptr) {
    const int nblk = N / 32, kb = item / nblk, nb = item % nblk, k0 = 64 * kb, n0 = 32 * nb;
#pragma unroll 8
    for (int i = 0; i < 32; ++i) { const int kk = 2 * i + (lane >> 5); scr[kk * 33 + (lane & 31)] = W[(size_t)(k0 + kk) * N + n0 + (lane & 31)]; }
    LDS_WAIT(); CFENCE();
    const int c = lane & 7;
#pragma unroll
    for (int j = 0; j < 4; ++j) { const int n = (lane >> 3) + 8 * j; const LAS float* s = scr + (8 * c) * 33 + n;
        v4u o; o.x = pk2(s[0 * 33], s[1 * 33]); o.y = pk2(s[2 * 33], s[3 * 33]); o.z = pk2(s[4 * 33], s[5 * 33]); o.w = pk2(s[6 * 33], s[7 * 33]);
        *(v4u*)(WT + (size_t)rowmap_fn(n0 + n, rowmode, row_off) * ldt + koff + k0 + 8 * c) = o;
        if (cmax) { float am = 0.f;
#pragma unroll
            for (int q = 0; q < 4; ++q) { const unsigned w = q == 0 ? o.x : q == 1 ? o.y : q == 2 ? o.z : o.w; am = fmaxf(am, fmaxf(fabsf(bf_lo(w)), fabsf(bf_hi(w)))); }
            atomicMax(cmax + rowmap_fn(n0 + n, rowmode, row_off), __builtin_bit_cast(unsigned, am)); } }
    LDS_WAIT(); CFENCE();
}

__device__ __forceinline__ void table_row_store(unsigned char* ws, const f32x4 (&v)[4], bool isu, int e, int lane) {
    float am = 0.f;
#pragma unroll
    for (int j = 0; j < 4; ++j) am = fmaxf(am, fmaxf(fmaxf(fabsf(v[j][0]), fabsf(v[j][1])), fmaxf(fabsf(v[j][2]), fabsf(v[j][3]))));
    { int iv = __builtin_bit_cast(int, am);
      iv = max(iv, __builtin_amdgcn_mov_dpp(iv, 0xB1, 0xF, 0xF, true)); iv = max(iv, __builtin_amdgcn_mov_dpp(iv, 0x4E, 0xF, 0xF, true));
      iv = max(iv, __builtin_amdgcn_mov_dpp(iv, 0x141, 0xF, 0xF, true)); iv = max(iv, __builtin_amdgcn_mov_dpp(iv, 0x140, 0xF, 0xF, true));
      iv = max(max(__builtin_amdgcn_readlane(iv, 0), __builtin_amdgcn_readlane(iv, 16)), max(__builtin_amdgcn_readlane(iv, 32), __builtin_amdgcn_readlane(iv, 48)));
      am = __builtin_bit_cast(float, iv); }
    v4u q;
    if (isu) {
        const float sc = am > 0.f ? 127.0f / am : 0.f;
        unsigned wq[4];
#pragma unroll
        for (int j = 0; j < 4; ++j) wq[j] = ((unsigned)__float2int_rn(v[j][0] * sc) & 0xffu) | (((unsigned)__float2int_rn(v[j][1] * sc) & 0xffu) << 8) | (((unsigned)__float2int_rn(v[j][2] * sc) & 0xffu) << 16) | (((unsigned)__float2int_rn(v[j][3] * sc) & 0xffu) << 24);
        q = (v4u){wq[0], wq[1], wq[2], wq[3]};
    } else {
        const float sc = am > 0.f ? 224.0f / am : 0.f;
        { int w = 0; w = __builtin_amdgcn_cvt_pk_fp8_f32(v[0][0] * sc, v[0][1] * sc, w, false); w = __builtin_amdgcn_cvt_pk_fp8_f32(v[0][2] * sc, v[0][3] * sc, w, true); q.x = (unsigned)w; }
        { int w = 0; w = __builtin_amdgcn_cvt_pk_fp8_f32(v[1][0] * sc, v[1][1] * sc, w, false); w = __builtin_amdgcn_cvt_pk_fp8_f32(v[1][2] * sc, v[1][3] * sc, w, true); q.y = (unsigned)w; }
        { int w = 0; w = __builtin_amdgcn_cvt_pk_fp8_f32(v[2][0] * sc, v[2][1] * sc, w, false); w = __builtin_amdgcn_cvt_pk_fp8_f32(v[2][2] * sc, v[2][3] * sc, w, true); q.z = (unsigned)w; }
        { int w = 0; w = __builtin_amdgcn_cvt_pk_fp8_f32(v[3][0] * sc, v[3][1] * sc, w, false); w = __builtin_amdgcn_cvt_pk_fp8_f32(v[3][2] * sc, v[3][3] * sc, w, true); q.w = (unsigned)w; }
    }
    *(v4u*)(ws + (isu ? WS_UQ : WS_VQ) + (size_t)(lane >> 3) * (NEXP * 128) + (size_t)e * 128 + 16 * (lane & 7)) = q;
    if (lane == 0) ((float*)(ws + WS_SUQ))[2 * e + (isu ? 0 : 1)] = am * (isu ? (1.0f / 127.0f) : (1.0f / 224.0f));
}

__device__ __forceinline__ void p0_prologue(Frame& F) {
    unsigned char* ws = F.ws;
    const int gw = F.vcu * NWAVES + F.wave, NGW = F.G * NWAVES;
    const int gt = F.vcu * (NWAVES * 64) + F.tid, NGT = F.G * NWAVES * 64;
    {
        LAS float* scr = (LAS float*)(F.lds + F.wave * 16384);
        bf16* W1T = (bf16*)(ws + WS_W1T); bf16* WAB = (bf16*)(ws + WS_WAB); bf16* WO2 = (bf16*)(ws + WS_WO2);
        constexpr int I_IN = 16 * 80, I_GT = 16 * 64, I_A = 8 * 32, I_B = 8 * 32, I_O = 16 * 32;
        constexpr int NIT = I_IN + I_GT + I_A + I_B + I_O;
        for (int it = gw; it < NIT; it += NGW) {
            int r = it;
            if (r < I_IN) { p0_transpose_item(F.in[2], 2560, W1T, 1024, 0, 1, 0, scr, r, F.lane, (unsigned*)(ws + WS_CTL) + CW_CMAX); continue; } r -= I_IN;
            if (r < I_GT) { p0_transpose_item(F.in[14], 2048, W1T, 1024, 0, 0, 2560, scr, r, F.lane, (unsigned*)(ws + WS_CTL) + CW_CMAX); continue; } r -= I_GT;
            if (r < I_A) { p0_transpose_item(F.in[12], 1024, WAB, 512, 0, 0, 0, scr, r, F.lane); continue; } r -= I_A;
            if (r < I_B) { p0_transpose_item(F.in[13], 1024, WAB, 512, 0, 0, 1024, scr, r, F.lane); continue; } r -= I_B;
            p0_transpose_item(F.in[16], 1024, WO2, 1024, 0, 0, 0, scr, r, F.lane);
        }
    }
    __syncthreads();
    {
        const float* wq = F.in[18]; const float* keys = F.in[19]; const float* g2 = F.in[17];
        bf16* WEF = (bf16*)(ws + WS_WEF);
        const int r32 = F.lane & 31, hi = F.lane >> 5;
        for (int task = gw; task < 16 * 4 * 32; task += NGW) {
            const int hp = task >> 7, k0 = ((task >> 5) & 3) * 32, d0 = (task & 31) * 32;
            const float* ap = keys + (size_t)(hp * 128 + k0 + r32) * 128 + 8 * hi;
            const float* bp = wq + (size_t)(d0 + r32) * 2048 + hp * 128 + 8 * hi;
            f32x16 acc = (f32x16){};
#pragma unroll 1
            for (int half = 0; half < 2; ++half) {
                f32x4 av[8], bv[8];
#pragma unroll
                for (int s = 0; s < 4; ++s) { av[2 * s] = *(const f32x4*)(ap + 16 * (4 * half + s)); av[2 * s + 1] = *(const f32x4*)(ap + 16 * (4 * half + s) + 4);
                    bv[2 * s] = *(const f32x4*)(bp + 16 * (4 * half + s)); bv[2 * s + 1] = *(const f32x4*)(bp + 16 * (4 * half + s) + 4); }
#pragma unroll
                for (int s = 0; s < 4; ++s) {
                    unsigned ah[4], al[4], bh[4], bl[4];
#pragma unroll
                    for (int q = 0; q < 4; ++q) { const f32x4 a4 = av[2 * s + (q >> 1)], b4 = bv[2 * s + (q >> 1)]; const int e = (q & 1) * 2;
                        const unsigned ha = cvtpk(a4[e], a4[e + 1]), hb = cvtpk(b4[e], b4[e + 1]);
                        ah[q] = ha; bh[q] = hb;
                        al[q] = cvtpk(a4[e] - bf_lo(ha), a4[e + 1] - bf_hi(ha)); bl[q] = cvtpk(b4[e] - bf_lo(hb), b4[e + 1] - bf_hi(hb)); }
                    const bf16x8 Ah = __builtin_bit_cast(bf16x8, (v4u){ah[0], ah[1], ah[2], ah[3]}), Al = __builtin_bit_cast(bf16x8, (v4u){al[0], al[1], al[2], al[3]});
                    const bf16x8 Bh = __builtin_bit_cast(bf16x8, (v4u){bh[0], bh[1], bh[2], bh[3]}), Bl = __builtin_bit_cast(bf16x8, (v4u){bl[0], bl[1], bl[2], bl[3]});
                    acc = __builtin_amdgcn_mfma_f32_32x32x16_bf16(Ah, Bh, acc, 0, 0, 0);
                    acc = __builtin_amdgcn_mfma_f32_32x32x16_bf16(Ah, Bl, acc, 0, 0, 0);
                    acc = __builtin_amdgcn_mfma_f32_32x32x16_bf16(Al, Bh, acc, 0, 0, 0);
                }
            }
            const float gd = g2[d0 + r32];
#pragma unroll
            for (int r = 0; r < 16; ++r) { const int k = k0 + (r & 3) + 8 * (r >> 2) + 4 * hi;
                WEF[(size_t)(hp * 128 + k) * 1024 + d0 + r32] = (bf16)f2bf(acc[r] * gd); }
        }
    }
    {
        const float* x = F.in[0]; const float* g1 = F.in[1]; unsigned char* A8 = ws + WS_XB; float* XS = (float*)(ws + WS_XS);
        f32x4 gv[4];
#pragma unroll
        for (int j = 0; j < 4; ++j) gv[j] = *((const f32x4*)g1 + F.lane + 64 * j);
        for (int m = gw; m < T; m += NGW) {
            const f32x4* xr = (const f32x4*)(x + (size_t)m * DM) + F.lane;
            f32x4 v[4]; float s = 0.f, am = 0.f;
#pragma unroll
            for (int j = 0; j < 4; ++j) { v[j] = xr[64 * j]; s += (v[j].x * v[j].x + v[j].y * v[j].y) + (v[j].z * v[j].z + v[j].w * v[j].w); }
            const float rstd = 1.0f / sqrtf(wave_sum(s) * (1.f / DM) + EPS);
#pragma unroll
            for (int j = 0; j < 4; ++j) { v[j] = v[j] * rstd * gv[j]; am = fmaxf(am, fmaxf(fmaxf(fabsf(v[j].x), fabsf(v[j].y)), fmaxf(fabsf(v[j].z), fabsf(v[j].w)))); }
#pragma unroll
            for (int o = 1; o < 64; o <<= 1) am = fmaxf(am, __shfl_xor(am, o));
            const float sc = am > 0.f ? 127.0f / am : 0.f;
            unsigned* o4 = (unsigned*)(A8 + (size_t)m * DM) + F.lane;
#pragma unroll
            for (int j = 0; j < 4; ++j) o4[64 * j] = ((unsigned)__float2int_rn(v[j].x * sc) & 0xffu) | (((unsigned)__float2int_rn(v[j].y * sc) & 0xffu) << 8) | (((unsigned)__float2int_rn(v[j].z * sc) & 0xffu) << 16) | (((unsigned)__float2int_rn(v[j].w * sc) & 0xffu) << 24);
            if (F.lane == 0) XS[m] = am * (1.0f / 127.0f);
        }
    }
    {
        float* rope = (float*)(ws + WS_ROPE);
        for (int i = gt; i < SEQ * 32; i += NGT) {
            const int pos = i >> 5, j = i & 31;
            const float inv = 1.0f / powf(10000.0f, (float)(2 * j) * (1.0f / 64.0f));
            const float ang = (float)pos * inv;
            double rv = (double)ang * 0.15915494309189535; rv -= floor(rv);
            const float fr = (float)rv; const float sn = __builtin_amdgcn_sinf(fr), cs = __builtin_amdgcn_cosf(fr);
            *(f32x2*)(rope + 2 * (size_t)i) = (f32x2){cs, sn};
        }
        const float* wsp = F.in[10]; bf16* WSM = (bf16*)(ws + WS_WSM);
        for (int i = gt; i < 4 * 128 * 128; i += NGT) { const int ii = (i >> 7) & 127, jj = i & 127; WSM[i] = (bf16)f2bf(((jj >> 6) <= (ii >> 6)) ? wsp[i] : 0.f); }
        if (F.vcu == 0 && F.wave == 0) {
            const float p1 = F.in[3][F.lane] * F.in[4][F.lane], p2 = F.in[5][F.lane] * F.in[6][F.lane];
            const float s1 = wave_sum(p1), s2 = wave_sum(p2);
            if (F.lane == 0) ((float*)(ws + WS_MISC))[0] = expf(s1) - expf(s2) + LAMBDA_INIT;
        }
    }
}

__device__ __forceinline__ void p0b_quant_weights(Frame& F) {
    unsigned char* ws = F.ws;
    const int gw = F.vcu * NWAVES + F.wave, NGW = F.G * NWAVES;
    const unsigned* cmax = (const unsigned*)(ws + WS_CTL) + CW_CMAX; float* WSC = (float*)(ws + WS_WSC);
    for (int n = gw; n < N1; n += NGW) {
        const float am = __builtin_bit_cast(float, cmax[n]); const float sc = am > 0.f ? 127.0f / am : 0.f;
        const bf16* src = (const bf16*)(ws + WS_W1T) + (size_t)n * DM + 16 * F.lane;
        const v4u w0 = *(const v4u*)src, w1 = *(const v4u*)(src + 8);
        const float v[16] = {bf_lo(w0.x), bf_hi(w0.x), bf_lo(w0.y), bf_hi(w0.y), bf_lo(w0.z), bf_hi(w0.z), bf_lo(w0.w), bf_hi(w0.w), bf_lo(w1.x), bf_hi(w1.x), bf_lo(w1.y), bf_hi(w1.y), bf_lo(w1.z), bf_hi(w1.z), bf_lo(w1.w), bf_hi(w1.w)};
        unsigned wq[4];
#pragma unroll
        for (int j = 0; j < 4; ++j) wq[j] = ((unsigned)__float2int_rn(v[4 * j] * sc) & 0xffu) | (((unsigned)__float2int_rn(v[4 * j + 1] * sc) & 0xffu) << 8) | (((unsigned)__float2int_rn(v[4 * j + 2] * sc) & 0xffu) << 16) | (((unsigned)__float2int_rn(v[4 * j + 3] * sc) & 0xffu) << 24);
        *(v4u*)(ws + WS_W1Q + (size_t)n * DM + 16 * F.lane) = (v4u){wq[0], wq[1], wq[2], wq[3]};
        if (F.lane == 0) WSC[n] = am * (1.0f / 127.0f);
    }
}
#define XB_TMO      128
#define XB_XCNT(j)  (256  + 64 * (j))
#define XB_XSUB(j)  (1280 + 64 * (j))
#define XB_XGEN(j)  (2304 + 64 * (j))
#define XB_TOP      3328
#define XB_TOPGEN   3392
#define XCD_BAR_WORDS 3456
#define XB_SPIN_CAP (1u << 22)

__device__ __forceinline__ unsigned xb_ld(unsigned* p)              { return __hip_atomic_load(p, __ATOMIC_RELAXED, __HIP_MEMORY_SCOPE_AGENT); }
__device__ __forceinline__ unsigned xb_add(unsigned* p, unsigned v) { return __hip_atomic_fetch_add(p, v, __ATOMIC_RELAXED, __HIP_MEMORY_SCOPE_AGENT); }
__device__ __forceinline__ unsigned xb_xcc_id() { return (unsigned)__builtin_amdgcn_s_getreg((3 << 11) | 20) & 0xFu; }
#define XB_SPIN(cond, bar) do { unsigned _sp = 0; while (cond) { __builtin_amdgcn_s_sleep(1); \
    if ((++_sp & 255u) == 0u) { if (xb_ld(&(bar)[XB_TMO])) break; if (_sp > XB_SPIN_CAP) { atomicAdd(&(bar)[XB_TMO], 1u); break; } } } } while (0)

struct XcdBarrier {
    unsigned* bar; unsigned x;
    volatile LAS unsigned* st;
};

__device__ __forceinline__ XcdBarrier xcd_barrier_post(unsigned* bar, volatile LAS unsigned* st) {
    XcdBarrier b; b.bar = bar; b.x = xb_xcc_id(); b.st = st;
    if (threadIdx.x == 0) (void)xb_add(&bar[XB_XCNT(b.x)], 1u);
    return b;
}
__device__ __forceinline__ void xcd_barrier_complete(unsigned* bar, unsigned x, unsigned& nloc, unsigned& nx) {
    const unsigned G = gridDim.x * gridDim.y * gridDim.z;
    unsigned sum, cnt, mine, sp = 0u;
    for (;;) {
        sum = 0u; cnt = 0u; mine = 0u;
#pragma unroll
        for (unsigned j = 0; j < 16; ++j) { const unsigned c = xb_ld(&bar[XB_XCNT(j)]); sum += c; cnt += (c > 0u) ? 1u : 0u; mine = (j == x) ? c : mine; }
        if (sum == G) break;
        __builtin_amdgcn_s_sleep(1);
        if ((++sp & 255u) == 0u) { if (xb_ld(&bar[XB_TMO])) break; if (sp > XB_SPIN_CAP) { atomicAdd(&bar[XB_TMO], 1u); break; } }
    }
    nloc = mine > 0u ? mine : 1u; nx = cnt > 0u ? cnt : 1u;
}

__device__ __forceinline__ void xcd_barrier(const XcdBarrier& b) {
    asm volatile("s_waitcnt vmcnt(0)" ::: "memory");
    __syncthreads();
    if (threadIdx.x == 0) {
        unsigned* bar = b.bar;
        __builtin_amdgcn_s_waitcnt(0);
        unsigned nloc = b.st[0], nx = b.st[1];
        if (nloc == 0u) { xcd_barrier_complete(bar, b.x, nloc, nx); b.st[0] = nloc; b.st[1] = nx; }
        const unsigned old = xb_add(&bar[XB_XSUB(b.x)], 1u);
        const unsigned gen = old / nloc;
        if (old + 1u == (gen + 1u) * nloc) {
            __builtin_amdgcn_fence(__ATOMIC_RELEASE, "agent");
            asm volatile("s_waitcnt vmcnt(0)" ::: "memory");
            const unsigned og = xb_add(&bar[XB_TOP], 1u);
            const unsigned tg = og / nx;
            if (og + 1u == (tg + 1u) * nx) xb_add(&bar[XB_TOPGEN], 1u);
            else XB_SPIN(xb_ld(&bar[XB_TOPGEN]) == tg, bar);
            __builtin_amdgcn_fence(__ATOMIC_ACQUIRE, "agent");
            xb_add(&bar[XB_XGEN(b.x)], 1u);
            asm volatile("s_waitcnt vmcnt(0)" ::: "memory");
        } else {
            XB_SPIN(xb_ld(&bar[XB_XGEN(b.x)]) == gen, bar);
            __builtin_amdgcn_fence(__ATOMIC_ACQUIRE, "agent");
            asm volatile("s_waitcnt vmcnt(0)" ::: "memory");
        }
    }
    __syncthreads();
}
__device__ __forceinline__ v4u pack8(const f32x4 a, const f32x4 b) { v4u w; w.x = cvtpk(a[0], a[1]); w.y = cvtpk(a[2], a[3]); w.z = cvtpk(b[0], b[1]); w.w = cvtpk(b[2], b[3]); return w; }

struct EpiP1 {
    static constexpr bool PERM = true, AFTER_DRAIN = false, I8 = true;
    unsigned char* ws; const float* bgate; const float* rope; const float* xs; const float* wsc;
    __device__ __forceinline__ void operator()(const pg8::i32x4 (&acci)[2][2][4][2], const pg8::Unit& u, int wr, int wc, int fr, int fq) const {
        const int row0 = u.pm * 256 + wr * 64 + fr, pn = u.pn, ct = wc * 32 + 8 * fq;
        float rs[8]; f32x4 cs[2][2];
#pragma unroll
        for (int k = 0; k < 8; ++k) rs[k] = xs[row0 + (k >> 2) * 128 + (k & 3) * 16];
#pragma unroll
        for (int bj = 0; bj < 2; ++bj) { cs[bj][0] = *(const f32x4*)(wsc + pn * 256 + bj * 128 + ct); cs[bj][1] = *(const f32x4*)(wsc + pn * 256 + bj * 128 + ct + 4); }
        f32x4 acc[2][2][4][2];
#pragma unroll
        for (int ai = 0; ai < 2; ++ai)
#pragma unroll
            for (int bj = 0; bj < 2; ++bj)
#pragma unroll
                for (int m = 0; m < 4; ++m)
#pragma unroll
                    for (int n = 0; n < 2; ++n) { const pg8::i32x4 v = acci[ai][bj][m][n]; const float r = rs[4 * ai + m];
                        acc[ai][bj][m][n] = (f32x4){(float)v[0] * r * cs[bj][n][0], (float)v[1] * r * cs[bj][n][1], (float)v[2] * r * cs[bj][n][2], (float)v[3] * r * cs[bj][n][3]}; }
        if (pn < 4) {
            bf16* dst = (bf16*)(ws + (pn < 2 ? WS_Q : WS_K)); const float sc = pn < 2 ? QSCALE : 1.0f; const int cb = (pn & 1) * 256 + ct; const bool hm = pn >= 2;
#pragma unroll
            for (int ai = 0; ai < 2; ++ai)
#pragma unroll
                for (int m = 0; m < 4; ++m) { const int row = row0 + ai * 128 + m * 16, pos = row & (SEQ - 1);
#pragma unroll
                    for (int bj = 0; bj < 2; ++bj) { const int col = cb + bj * 128, i0 = (col & 63) >> 1;
                        const f32x4 r0 = *(const f32x4*)(rope + (size_t)(pos * 32 + i0) * 2), r1 = *(const f32x4*)(rope + (size_t)(pos * 32 + i0 + 2) * 2);
                        const f32x4 a = acc[ai][bj][m][0], b = acc[ai][bj][m][1]; f32x4 oa, ob;
                        oa[0] = (a[0] * r0[0] - a[1] * r0[1]) * sc; oa[1] = (a[0] * r0[1] + a[1] * r0[0]) * sc;
                        oa[2] = (a[2] * r0[2] - a[3] * r0[3]) * sc; oa[3] = (a[2] * r0[3] + a[3] * r0[2]) * sc;
                        ob[0] = (b[0] * r1[0] - b[1] * r1[1]) * sc; ob[1] = (b[0] * r1[1] + b[1] * r1[0]) * sc;
                        ob[2] = (b[2] * r1[2] - b[3] * r1[3]) * sc; ob[3] = (b[2] * r1[3] + b[3] * r1[2]) * sc;
                        const size_t off = hm ? ((size_t)(((row >> 13) * 4 + (col >> 7)) * SEQ + pos) * 128 + (col & 127)) : ((size_t)row * HW + col);
                        *(v4u*)(dst + off) = pack8(oa, ob); } }
        } else if (pn < 10) {
            bf16* dst = (bf16*)(ws + (pn < 6 ? WS_V : (pn < 8 ? WS_SU : WS_SV))); const bool act = pn >= 6; const int cb = (pn & 1) * 256 + ct;
#pragma unroll
            for (int ai = 0; ai < 2; ++ai)
#pragma unroll
                for (int m = 0; m < 4; ++m) { const int row = row0 + ai * 128 + m * 16;
#pragma unroll
                    for (int bj = 0; bj < 2; ++bj) { const int col = cb + bj * 128; f32x4 a = acc[ai][bj][m][0], b = acc[ai][bj][m][1];
                        if (act) {
#pragma unroll
                            for (int e = 0; e < 4; ++e) { a[e] = gelu1(a[e]); b[e] = gelu1(b[e]); } }
                        const size_t off = (pn < 6) ? ((size_t)(((row >> 13) * 4 + (col >> 7)) * SEQ + (row & (SEQ - 1))) * 128 + (col & 127)) : ((size_t)row * HW + col);
                        *(v4u*)(dst + off) = pack8(a, b); } }
        } else {
            const int cb = (pn - 10) * 256 + ct;
#pragma unroll
            for (int bj = 0; bj < 2; ++bj) { const int col = cb + bj * 128;
                const f32x4 b0 = *(const f32x4*)(bgate + col), b1 = *(const f32x4*)(bgate + col + 4);
#pragma unroll
                for (int ai = 0; ai < 2; ++ai)
#pragma unroll
                    for (int m = 0; m < 4; ++m) { const int row = row0 + ai * 128 + m * 16; f32x4 a = acc[ai][bj][m][0] + b0, b = acc[ai][bj][m][1] + b1;
#pragma unroll
                        for (int e = 0; e < 4; ++e) { a[e] = __builtin_amdgcn_rcpf(1.0f + __builtin_amdgcn_exp2f(a[e] * -1.4426950408889634f)); b[e] = __builtin_amdgcn_rcpf(1.0f + __builtin_amdgcn_exp2f(b[e] * -1.4426950408889634f)); }
                        unsigned w0 = 0u, w1 = 0u;
#pragma unroll
                        for (int e = 0; e < 4; ++e) { w0 = __builtin_amdgcn_cvt_pk_u8_f32(a[e] * 255.0f, e, w0); w1 = __builtin_amdgcn_cvt_pk_u8_f32(b[e] * 255.0f, e, w1); }
                        *(v2u*)(ws + WS_GATES + (size_t)row * 2048 + col) = (v2u){w0, w1}; } }
        }
    }
};

struct EpiGate {
    static constexpr bool PERM = true, AFTER_DRAIN = false, I8 = false;
    bf16* M; const unsigned char* gates;
    __device__ __forceinline__ void operator()(const f32x4 (&acc)[2][2][4][2], const pg8::Unit& u, int wr, int wc, int fr, int fq) const {
        const int br = u.pn >> 2, pm = u.pm - 128 * br, pn = u.pn & 3;
        const int row0 = pm * 256 + wr * 64 + fr, col0 = pn * 256 + wc * 32 + 8 * fq;
#pragma unroll
        for (int ai = 0; ai < 2; ++ai) {
            v2u g[8]; v4u o[8];
#pragma unroll
            for (int m = 0; m < 4; ++m)
#pragma unroll
                for (int bj = 0; bj < 2; ++bj) g[2 * m + bj] = *(const v2u*)(gates + (size_t)(row0 + ai * 128 + m * 16) * 2048 + br * 1024 + col0 + bj * 128);
            if (br) {
#pragma unroll
                for (int m = 0; m < 4; ++m)
#pragma unroll
                    for (int bj = 0; bj < 2; ++bj) o[2 * m + bj] = *(const v4u*)(M + (size_t)(row0 + ai * 128 + m * 16) * DM + col0 + bj * 128);
            } else {
#pragma unroll
                for (int k = 0; k < 8; ++k) o[k] = (v4u){0u, 0u, 0u, 0u};
            }
#pragma unroll
            for (int m = 0; m < 4; ++m)
#pragma unroll
                for (int bj = 0; bj < 2; ++bj) { const v2u gg = g[2 * m + bj]; const v4u oo = o[2 * m + bj]; f32x4 a = acc[ai][bj][m][0] * (1.0f / 255.0f), b = acc[ai][bj][m][1] * (1.0f / 255.0f);
                    a[0] = a[0] * (float)(gg.x & 0xffu) + bf_lo(oo.x); a[1] = a[1] * (float)((gg.x >> 8) & 0xffu) + bf_hi(oo.x); a[2] = a[2] * (float)((gg.x >> 16) & 0xffu) + bf_lo(oo.y); a[3] = a[3] * (float)(gg.x >> 24) + bf_hi(oo.y);
                    b[0] = b[0] * (float)(gg.y & 0xffu) + bf_lo(oo.z); b[1] = b[1] * (float)((gg.y >> 8) & 0xffu) + bf_hi(oo.z); b[2] = b[2] * (float)((gg.y >> 16) & 0xffu) + bf_lo(oo.w); b[3] = b[3] * (float)(gg.y >> 24) + bf_hi(oo.w);
                    *(v4u*)(M + (size_t)(row0 + ai * 128 + m * 16) * DM + col0 + bj * 128) = pack8(a, b); }
        }
    }
};

struct EpiX1 {
    static constexpr bool PERM = true, AFTER_DRAIN = false, I8 = false;
    const float* x; float* out; bf16* x1b; float* ssq;
    __device__ __forceinline__ void operator()(const f32x4 (&acc)[2][2][4][2], const pg8::Unit& u, int wr, int wc, int fr, int fq) const {
        const int row0 = u.pm * 256 + wr * 64 + fr, col0 = u.pn * 256 + wc * 32 + 8 * fq;
#pragma unroll
        for (int ai = 0; ai < 2; ++ai) {
            f32x4 xa[8], xb[8];
#pragma unroll
            for (int m = 0; m < 4; ++m)
#pragma unroll
                for (int bj = 0; bj < 2; ++bj) { const size_t off = (size_t)(row0 + ai * 128 + m * 16) * DM + col0 + bj * 128; xa[2 * m + bj] = *(const f32x4*)(x + off); xb[2 * m + bj] = *(const f32x4*)(x + off + 4); }
            float ssv[4];
#pragma unroll
            for (int m = 0; m < 4; ++m) { float ss = 0.f;
#pragma unroll
                for (int bj = 0; bj < 2; ++bj) { const size_t off = (size_t)(row0 + ai * 128 + m * 16) * DM + col0 + bj * 128;
                    const f32x4 a = acc[ai][bj][m][0] + xa[2 * m + bj], b = acc[ai][bj][m][1] + xb[2 * m + bj];
                    *(v4u*)(x1b + off) = pack8(a, b);
                    ss += (a[0] * a[0] + a[1] * a[1]) + (a[2] * a[2] + a[3] * a[3]) + (b[0] * b[0] + b[1] * b[1]) + (b[2] * b[2] + b[3] * b[3]); }
                ss += __shfl_xor(ss, 16); ss += __shfl_xor(ss, 32); ssv[m] = ss; }
            if (fq == 0) {
#pragma unroll
                for (int m = 0; m < 4; ++m) ssq[(size_t)(row0 + ai * 128 + m * 16) * 16 + u.pn * 4 + wc] = ssv[m]; }
        }
    }
};

typedef _Float16 h16x2 __attribute__((ext_vector_type(2)));
__device__ __forceinline__ unsigned pkh(float a, float b) { const f32x2 v = {a, b}; const h16x2 h = __builtin_convertvector(v, h16x2); return __builtin_bit_cast(unsigned, h); }
struct EpiScores {
    static constexpr bool PERM = true, AFTER_DRAIN = false, I8 = false;
    unsigned short* S;
    __device__ __forceinline__ void operator()(const f32x4 (&acc)[2][2][4][2], const pg8::Unit& u, int wr, int wc, int fr, int fq) const {
        const int row0 = u.pm * 256 + wr * 64 + fr, col0 = u.pn * 256 + wc * 32 + 8 * fq;
#pragma unroll
        for (int ai = 0; ai < 2; ++ai)
#pragma unroll
            for (int m = 0; m < 4; ++m) { const int row = row0 + ai * 128 + m * 16;
#pragma unroll
                for (int bj = 0; bj < 2; ++bj) { const f32x4 a = acc[ai][bj][m][0], b = acc[ai][bj][m][1];
                    *(v4u*)(S + (size_t)row * 2048 + col0 + bj * 128) = (v4u){pkh(a[0], a[1]), pkh(a[2], a[3]), pkh(b[0], b[1]), pkh(b[2], b[3])}; } }
    }
};

struct BranchOrder {
    pg8::StaticOrder so;
    __device__ __forceinline__ bool next(int i, pg8::Unit& u) const { if (!so.next(i >> 1, u)) return false; const int br = i & 1; u.pm += 128 * br; u.pn += 4 * br; return true; }
    __device__ __forceinline__ void a_ready(const pg8::Unit&) const {}
    __device__ __forceinline__ void done(const pg8::Unit&) const {}
};
namespace att {
constexpr int SLOT = 64 * 256;
constexpr int KRING = 0, VRING = 3 * SLOT;
constexpr int XROW = 132, XBYTES = 128 * XROW * 4;
constexpr int WSF_OFF = 2 * XBYTES;
static_assert(VRING + 3 * SLOT <= WSF_OFF && WSF_OFF + 8 * 256 <= BAR_LDS_OFF, "attention LDS map");
__device__ __forceinline__ int crow(int r, int hi) { return (r & 3) + 8 * (r >> 2) + 4 * hi; }
__device__ __forceinline__ void glds16s(const unsigned char* sbase, unsigned voff, unsigned lds_dst) { unsigned keep;
    asm volatile("s_mov_b32 %0, m0\n\ts_mov_b32 m0, %3\n\ts_nop 2\n\tglobal_load_lds_dwordx4 %1, %2\n\ts_mov_b32 m0, %0" : "=&s"(keep) : "v"(voff), "s"(sbase), "s"(lds_dst) : "memory"); }
__device__ __forceinline__ float max3f(float a, float b, float c) { float r; asm("v_max3_f32 %0, %1, %2, %3" : "=v"(r) : "v"(a), "v"(b), "v"(c)); return r; }
__device__ __forceinline__ float max2f(float a, float b) { float r; asm("v_max_f32_e32 %0, %1, %2" : "=v"(r) : "v"(a), "v"(b)); return r; }
__device__ __forceinline__ s16x4 vtr(LAS const unsigned char* p) {
    typedef short v4i16_t __attribute__((ext_vector_type(4)));
    return __builtin_bit_cast(s16x4, __builtin_amdgcn_ds_read_tr16_b64_v4i16((LAS v4i16_t*)p));
}
__device__ __forceinline__ void halves32(float v, float& lo, float& hh) {
    float a = v, b2 = v;
    asm("s_nop 1\n\tv_permlane32_swap_b32_e32 %0, %1" : "+v"(a), "+v"(b2));
    lo = a; hh = b2;
}
#ifndef ATT_MX
#define ATT_MX 1
#endif
#if ATT_MX
#define MX3_(a, b, c) __builtin_fmaxf(__builtin_fmaxf((a), (b)), (c))
#define MX2_(a, b) __builtin_fmaxf((a), (b))
#define ATT_PAD(C0, C1) do { } while (0)
#else
#define MX3_(a, b, c) max3f((a), (b), (c))
#define MX2_(a, b) max2f((a), (b))
#define ATT_PAD(C0, C1) asm volatile("s_nop 15\n\ts_nop 7" : "+v"(C0), "+v"(C1))
#endif
__device__ __forceinline__ float rowmax(const f32x16& p0, const f32x16& p1) {
    float a = MX3_(p0[0], p0[1], p1[0]), b = MX3_(p0[2], p0[3], p1[1]); a = MX3_(a, p1[2], p1[3]);
#pragma unroll
    for (int r = 4; r < 16; r += 4) { a = MX3_(a, p0[r], p0[r + 1]); b = MX3_(b, p0[r + 2], p0[r + 3]); a = MX3_(a, p1[r], p1[r + 1]); b = MX3_(b, p1[r + 2], p1[r + 3]); }
    const float m = MX2_(a, b);
    float lo, hh; halves32(m, lo, hh);
    return MX2_(lo, hh);
}
#ifndef ATT_THR
#define ATT_THR 8
#endif
#ifndef ATT_AHEAD
#define ATT_AHEAD 6
#endif

template <int VAR> __device__ __forceinline__ void attn_unit(const Frame& F, int b, int h, int qb, bf16* Q, const bf16* K, const bf16* V, float lam, const float* subg) {
    LAS unsigned char* lds = F.lds;
    int tid = F.tid; asm volatile("" : "+v"(tid));
    const int lane = tid & 63, r32 = lane & 31, hi = lane >> 5, wid = F.wave;
    const int c = wid >> 2, wq = wid & 3;
    const size_t rowbase = (size_t)b * SEQ;
    const int q0 = qb * 128 + wq * 32;
    const int NT = 2 * qb + 2;
    const int dkey = lane >> 4, dpos = lane & 15;
    unsigned kvo[2], vvo[2];
#pragma unroll
    for (int i2 = 0; i2 < 2; ++i2) { const int key = 4 * (2 * wid + i2) + dkey;
        kvo[i2] = (unsigned)(key * 256 + ((dpos ^ (key & 15)) << 4));
        vvo[i2] = (unsigned)(key * 256 + ((dpos ^ ((key & 3) << 2)) << 4)); }
    const unsigned char* Kb = (const unsigned char*)(K + (size_t)(b * 4 + h) * SEQ * 128);
    const unsigned char* Vb = (const unsigned char*)(V + (size_t)(b * 4 + h) * SEQ * 128);
    const unsigned lds0 = (unsigned)(uintptr_t)lds;
    const unsigned kdst = lds0 + KRING + 2 * wid * 1024, vdst = lds0 + VRING + 2 * wid * 1024;
#define RFL(x) ((unsigned)__builtin_amdgcn_readfirstlane((int)(x)))
#define DMA_K(t, slot) do { const unsigned char* s_ = Kb + (size_t)(t) * SLOT; glds16s(s_, kvo[0], RFL(kdst + (slot))); glds16s(s_, kvo[1], RFL(kdst + (slot) + 1024)); } while (0)
#define DMA_V(t, slot) do { const unsigned char* s_ = Vb + (size_t)(t) * SLOT; glds16s(s_, vvo[0], RFL(vdst + (slot))); glds16s(s_, vvo[1], RFL(vdst + (slot) + 1024)); } while (0)
    const int kb0 = KRING + r32 * 256 + (((c * 8 + hi) ^ (r32 & 15)) << 4);
    const int grp = lane >> 4, qi = (lane & 15) >> 2, pi = lane & 3;
    const int vb0 = VRING + (4 * (grp >> 1) + qi) * 256 + ((2 * (grp & 1) + (pi >> 1)) << 4) + (pi & 1) * 8 + (qi << 6);
    LAS float* wsf = (LAS float*)(lds + WSF_OFF) + wid * 64;

    DMA_K(0, 0); DMA_V(0, 0); DMA_K(1, SLOT);
    bf16x8 qr[4];
    { const bf16* Qw = Q + (rowbase + q0 + r32) * HW + h * 128 + c * 64 + hi * 8;
#pragma unroll
      for (int s = 0; s < 4; ++s) qr[s] = *(const bf16x8*)(Qw + s * 16); }
    if (NT > 2) DMA_K(2, 2 * SLOT);
    float mhat = 0.f, l_reg = 0.f;
    f32x16 o[4];
#pragma unroll
    for (int d = 0; d < 4; ++d) o[d] = (f32x16){};
    f32x16 negm = (f32x16){}; asm volatile("" : "+v"(negm));
    bool resc = false;
    f32x16 pA0, pA1, pB0, pB1; bf16x8 kf[8]; s16x4 vlo[16], vhi[16]; v4u pw0, pw1, pw2, pw3;
    int sl_prev = 0, sl_cur = 0, sl_next = SLOT;
    if (VAR & 32) { s16x4 z = (s16x4){}; asm volatile("" : "+v"(z));
#pragma unroll
        for (int i = 0; i < 16; ++i) { vlo[i] = z; vhi[i] = z; } }
    if (VAR & 16) { v4u z = (v4u){}; asm volatile("" : "+v"(z)); pw0 = pw1 = pw2 = pw3 = z; }
#define SBAR() __builtin_amdgcn_sched_barrier(0)
#define PIN(x) asm volatile("" : "+v"(x))
#define MFMA(a, b, cc) __builtin_amdgcn_mfma_f32_32x32x16_bf16(a, b, cc, 0, 0, 0)
#define WAIT_BAR(N) asm volatile("s_waitcnt vmcnt(" #N ") lgkmcnt(0)\n\ts_barrier" ::: "memory")
#define ROT() do { sl_prev = sl_cur; sl_cur = sl_next; sl_next = (sl_next == 2 * SLOT) ? 0 : sl_next + SLOT; } while (0)
#define KLOAD2(ka, j) do { kf[2 * (j)] = *(LAS const bf16x8*)(lds + ((ka) ^ ((j) << 5))); kf[2 * (j) + 1] = *(LAS const bf16x8*)(lds + ((ka) ^ ((j) << 5)) + 8192); } while (0)
#define RESC() do { if (resc) { \
        _Pragma("unroll") for (int g = 0; g < 4; ++g) { const f32x4 f = *(LAS const f32x4*)(wsf + 8 * g + 4 * hi); \
            _Pragma("unroll") for (int d = 0; d < 4; ++d) { o[d][4 * g + 0] *= f[0]; o[d][4 * g + 1] *= f[1]; o[d][4 * g + 2] *= f[2]; o[d][4 * g + 3] *= f[3]; } } } } while (0)
#define ENDW(tt) do { if ((tt) + 3 < NT) { WAIT_BAR(4); } else if ((tt) + 2 < NT) { WAIT_BAR(2); } else { WAIT_BAR(0); } } while (0)
    if (NT > 2) { WAIT_BAR(10); } else { WAIT_BAR(8); }
    { const int ka = kb0;
#pragma unroll
      for (int j = 0; j < 4; ++j) KLOAD2(ka, j); }
    pA0 = MFMA(kf[0], qr[0], negm); pA1 = MFMA(kf[1], qr[0], negm); pA0 = MFMA(kf[2], qr[1], pA0); pA1 = MFMA(kf[3], qr[1], pA1);
    pA0 = MFMA(kf[4], qr[2], pA0); pA1 = MFMA(kf[5], qr[2], pA1); pA0 = MFMA(kf[6], qr[3], pA0); pA1 = MFMA(kf[7], qr[3], pA1);
    ATT_PAD(pA0, pA1);
    { const float rm = rowmax(pA0, pA1); mhat = rm;
#pragma unroll
      for (int r = 0; r < 16; ++r) { pA0[r] = __builtin_amdgcn_exp2f(pA0[r] - rm); pA1[r] = __builtin_amdgcn_exp2f(pA1[r] - rm); }
#pragma unroll
      for (int r = 0; r < 16; ++r) negm[r] = -mhat;
      asm volatile("" : "+v"(negm)); }
    WAIT_BAR(0);
    if (NT > 3) DMA_K(3, 0);
    DMA_V(1, SLOT); ROT();
    { const int ka = kb0 + sl_cur;
#pragma unroll
      for (int j = 0; j < 4; ++j) KLOAD2(ka, j); }
    ENDW(0);
#define PKW(P, i) cvtpk(P[i], P[(i) + 1])
#define PAF(k) __builtin_bit_cast(bf16x8, pw##k)
#define VFR(i) (bf16x8){vlo[i][0], vlo[i][1], vlo[i][2], vlo[i][3], vhi[i][0], vhi[i][1], vhi[i][2], vhi[i][3]}
#define VADR(i, half) (lds + ((va_ ^ ((((i) & 15) & 3) << 6)) + (16 * (((i) & 15) >> 2) + 8 * (half)) * 256))
#define VRD(i) do { if (!(VAR & 32) && (i) >= 0 && (i) < 16) { \
        if (VAR & 128) { const bf16x8 w_ = *(LAS const bf16x8*)(lds + (((va_ ^ ((((i) & 15) & 3) << 6)) + (16 * (((i) & 15) >> 2)) * 256) & ~15)); vlo[(i) & 15] = (s16x4){w_[0], w_[1], w_[2], w_[3]}; vhi[(i) & 15] = (s16x4){w_[4], w_[5], w_[6], w_[7]}; } \
        else if (VAR & 256) { vlo[(i) & 15] = *(LAS const s16x4*)VADR(i, 0); vhi[(i) & 15] = *(LAS const s16x4*)VADR(i, 1); } \
        else { vlo[(i) & 15] = vtr(VADR(i, 0)); vhi[(i) & 15] = vtr(VADR(i, 1)); } SBAR(); } } while (0)
#define KRD(G, j) do { if (!(VAR & 64) && (G)) { KLOAD2(ka_, j); SBAR(); } } while (0)
#define GAPA(MF, a0, a1, a2, a3, W0, W1, PW) do { MF; if (!(VAR & 16)) { sacc += a0; sacc2 += a1; sacc += a2; sacc2 += a3; PIN(sacc); PIN(sacc2); W0; W1; } PIN(PW); SBAR(); } while (0)
#define GAPB(j, X, i) do { VRD((j) + ATT_AHEAD); o[(j) & 3] = MFMA(PAF_((j) >> 2), VFR(j), o[(j) & 3]); if (!(VAR & 4)) { X[i] = __builtin_amdgcn_exp2f(X[i]); X[(i) + 1] = __builtin_amdgcn_exp2f(X[(i) + 1]); } PIN(X); SBAR(); } while (0)
#define PAF_(k) ((k) == 0 ? PAF(0) : (k) == 1 ? PAF(1) : (k) == 2 ? PAF(2) : PAF(3))
#define STEP(C0, C1, P0, P1, t, GK, GV, GL, MASK) do { SBAR(); \
    const int va_ = vb0 + sl_prev; const int ka_ = kb0 + sl_next; \
    float sacc = P0[0], sacc2 = P0[1]; \
    GAPA(C0 = MFMA(kf[0], qr[0], negm), P0[2], P0[3], P0[4], P0[5],     pw0[0] = PKW(P0, 0),  pw0[1] = PKW(P0, 2),  pw0); \
    GAPA(C1 = MFMA(kf[1], qr[0], negm), P0[6], P0[7], P0[8], P0[9],     pw0[2] = PKW(P0, 4),  pw0[3] = PKW(P0, 6),  pw0); \
    VRD(ATT_AHEAD - 6); GAPA(C0 = MFMA(kf[2], qr[1], C0),   P0[10], P0[11], P0[12], P0[13], pw1[0] = PKW(P0, 8),  pw1[1] = PKW(P0, 10), pw1); \
    VRD(ATT_AHEAD - 5); GAPA(C1 = MFMA(kf[3], qr[1], C1),   P0[14], P0[15], P1[0], P1[1],   pw1[2] = PKW(P0, 12), pw1[3] = PKW(P0, 14), pw1); \
    VRD(ATT_AHEAD - 4); GAPA(C0 = MFMA(kf[4], qr[2], C0),   P1[2], P1[3], P1[4], P1[5],     pw2[0] = PKW(P1, 0),  pw2[1] = PKW(P1, 2),  pw2); \
    VRD(ATT_AHEAD - 3); GAPA(C1 = MFMA(kf[5], qr[2], C1),   P1[6], P1[7], P1[8], P1[9],     pw2[2] = PKW(P1, 4),  pw2[3] = PKW(P1, 6),  pw2); \
    VRD(ATT_AHEAD - 2); GAPA(C0 = MFMA(kf[6], qr[3], C0),   P1[10], P1[11], P1[12], P1[13], pw3[0] = PKW(P1, 8),  pw3[1] = PKW(P1, 10), pw3); \
    VRD(ATT_AHEAD - 1); GAPA(C1 = MFMA(kf[7], qr[3], C1),   P1[14], P1[15], 0.f, 0.f,       pw3[2] = PKW(P1, 12), pw3[3] = PKW(P1, 14), pw3); \
    l_reg += sacc + sacc2; \
    if (!(VAR & 2)) { if (GK) DMA_K((t) + 3, sl_cur); if (GV) DMA_V((t) + 1, sl_next); }                                    \
    ATT_PAD(C0, C1); \
    if (MASK) { _Pragma("unroll") for (int r = 0; r < 16; ++r) { C0[r] = -INFINITY; C1[r] = -INFINITY; } }                                   \
    { const float rm = (VAR & 8) ? 0.f : rowmax(C0, C1); resc = false;                                                        \
      if (__builtin_expect(__any(rm > (float)ATT_THR), 0)) { const float dl = __builtin_fmaxf(rm, 0.f); mhat += dl;        \
          _Pragma("unroll") for (int r = 0; r < 16; ++r) { C0[r] -= dl; C1[r] -= dl; } \
          _Pragma("unroll") for (int r = 0; r < 16; ++r) negm[r] = -mhat; \
          asm volatile("" : "+v"(negm)); \
          const float f = __builtin_amdgcn_exp2f(-dl); l_reg *= f; if (hi == 0) wsf[r32] = f; resc = true; } } \
    SBAR(); \
    GAPB(0, C0, 0);  GAPB(1, C0, 2);  GAPB(2, C0, 4);  GAPB(3, C0, 6); \
    KRD(GL, 0); GAPB(4, C0, 8);  GAPB(5, C0, 10); KRD(GL, 1); GAPB(6, C0, 12); GAPB(7, C0, 14); \
    KRD(GL, 2); GAPB(8, C1, 0);  GAPB(9, C1, 2);  KRD(GL, 3); GAPB(10, C1, 4); GAPB(11, C1, 6); \
    GAPB(12, C1, 8); GAPB(13, C1, 10); GAPB(14, C1, 12); GAPB(15, C1, 14); \
    } while (0)
#define DRAIN(P0, P1, vs) do { float sacc = P0[0] + P0[1]; \
      _Pragma("unroll") for (int r = 2; r < 16; ++r) sacc += P0[r]; \
      _Pragma("unroll") for (int r = 0; r < 16; ++r) sacc += P1[r]; \
      l_reg += sacc; \
      pw0 = (v4u){PKW(P0, 0), PKW(P0, 2), PKW(P0, 4), PKW(P0, 6)}; pw1 = (v4u){PKW(P0, 8), PKW(P0, 10), PKW(P0, 12), PKW(P0, 14)}; \
      pw2 = (v4u){PKW(P1, 0), PKW(P1, 2), PKW(P1, 4), PKW(P1, 6)}; pw3 = (v4u){PKW(P1, 8), PKW(P1, 10), PKW(P1, 12), PKW(P1, 14)}; \
      const int va_ = vb0 + (vs); \
      _Pragma("unroll") for (int ks = 0; ks < 4; ++ks) { \
          _Pragma("unroll") for (int d = 0; d < 4; ++d) { \
              const s16x4 lo = vtr(lds + ((va_ ^ (d << 6)) + (16 * ks) * 256)); const s16x4 hh = vtr(lds + ((va_ ^ (d << 6)) + (16 * ks + 8) * 256)); \
              const bf16x8 vf = (bf16x8){lo[0], lo[1], lo[2], lo[3], hh[0], hh[1], hh[2], hh[3]}; \
              o[d] = MFMA(PAF_(ks), vf, o[d]); } SBAR(); } } while (0)
    int t = 1;
    for (; t + 5 < NT; t += 2) {
        STEP(pB0, pB1, pA0, pA1, t, true, true, true, false);     WAIT_BAR(4); RESC(); ROT();
        STEP(pA0, pA1, pB0, pB1, t + 1, true, true, true, false); WAIT_BAR(4); RESC(); ROT();
    }
    for (; t + 1 < NT; t += 2) {
        STEP(pB0, pB1, pA0, pA1, t, (t + 3 < NT), (t + 1 < NT), (t + 1 < NT), false);         ENDW(t);     RESC(); ROT();
        STEP(pA0, pA1, pB0, pB1, t + 1, (t + 4 < NT), (t + 2 < NT), (t + 2 < NT), false);     ENDW(t + 1); RESC(); ROT();
    }
    STEP(pB0, pB1, pA0, pA1, NT - 1, false, false, false, (wq < 2)); RESC();
    DRAIN(pB0, pB1, sl_cur);
    const float l_run = l_reg;
    __syncthreads();
#undef STEP
#undef DRAIN
#undef GAPA
#undef GAPB
#undef PAF_
#undef PAF
#undef PKW
#undef VFR
#undef VRD
#undef VADR
#undef KRD
#undef ENDW
#undef RESC
#undef KLOAD2
#undef ROT
#undef WAIT_BAR
#undef MFMA
#undef PIN
#undef SBAR
#undef DMA_K
#undef DMA_V
#undef RFL
    int tide = F.tid; asm volatile("" : "+v"(tide));
    const int lane_e = tide & 63, r32e = lane_e & 31, hie = lane_e >> 5;
    LAS float* wse = (LAS float*)(lds + WSF_OFF) + wid * 64;
    float lt; { float lo_, hh_; halves32(l_run, lo_, hh_); lt = lo_ + hh_; }
    CFENCE();
    if (hie == 0) wse[32 + r32e] = lt;
    CFENCE(); LDS_WAIT();
    {
        const float csc = c ? lam : 1.0f;
        LAS float* Xc = (LAS float*)(lds + c * XBYTES) + (wq * 32) * XROW + r32e;
#pragma unroll
        for (int g = 0; g < 4; ++g) { const f32x4 f = *(LAS const f32x4*)(wse + 32 + 8 * g + 4 * hie);
#pragma unroll
            for (int e = 0; e < 4; ++e) { const float sc = csc * __builtin_amdgcn_rcpf(f[e]); const int q = 8 * g + 4 * hie + e;
#pragma unroll
                for (int d = 0; d < 4; ++d) Xc[q * XROW + 32 * d] = o[d][4 * g + e] * sc; } }
    }
    __syncthreads();
    {
        const int row = tide >> 2, sg = tide & 3;
        const LAS float* x0 = (const LAS float*)lds + row * XROW + sg * 32;
        const LAS float* x1 = (const LAS float*)(lds + XBYTES) + row * XROW + sg * 32;
        f32x4 dv[8]; float ss = 0.f;
#pragma unroll
        for (int j = 0; j < 8; ++j) { dv[j] = *(const LAS f32x4*)(x0 + 4 * j) - *(const LAS f32x4*)(x1 + 4 * j); ss += (dv[j][0] * dv[j][0] + dv[j][1] * dv[j][1]) + (dv[j][2] * dv[j][2] + dv[j][3] * dv[j][3]); }
        ss += __builtin_bit_cast(float, __builtin_amdgcn_mov_dpp(__builtin_bit_cast(int, ss), 0xB1, 0xF, 0xF, true)); ss += __builtin_bit_cast(float, __builtin_amdgcn_mov_dpp(__builtin_bit_cast(int, ss), 0x4E, 0xF, 0xF, true));
        const float rs = (1.0f - LAMBDA_INIT) * __builtin_amdgcn_rsqf(ss * (1.0f / 128.0f) + EPS);
        bf16* yr = Q + (rowbase + qb * 128 + row) * HW + h * 128 + sg * 32;
        const float* sgp = subg + sg * 32;
#pragma unroll
        for (int j = 0; j < 4; ++j) { const f32x4 ga = *(const f32x4*)(sgp + 8 * j), gb = *(const f32x4*)(sgp + 8 * j + 4);
            v4u w; w.x = cvtpk(dv[2 * j][0] * rs * ga[0], dv[2 * j][1] * rs * ga[1]); w.y = cvtpk(dv[2 * j][2] * rs * ga[2], dv[2 * j][3] * rs * ga[3]);
            w.z = cvtpk(dv[2 * j + 1][0] * rs * gb[0], dv[2 * j + 1][1] * rs * gb[1]); w.w = cvtpk(dv[2 * j + 1][2] * rs * gb[2], dv[2 * j + 1][3] * rs * gb[3]);
            if (!(VAR & 1)) *(v4u*)(yr + 8 * j) = w; }
    }
    __syncthreads();
}
}

namespace sgu {
constexpr int VROW = 320, VN_BYTES = 128 * VROW;
constexpr int STAT_OFF = VN_BYTES;
__device__ __forceinline__ float dppx(float v, int ctrl_sel) {
    const int iv = __builtin_bit_cast(int, v);
    return __builtin_bit_cast(float, ctrl_sel == 0 ? __builtin_amdgcn_mov_dpp(iv, 0xB1, 0xF, 0xF, true) : ctrl_sel == 1 ? __builtin_amdgcn_mov_dpp(iv, 0x4E, 0xF, 0xF, true)
                                   : ctrl_sel == 2 ? __builtin_amdgcn_mov_dpp(iv, 0x141, 0xF, 0xF, true) : __builtin_amdgcn_mov_dpp(iv, 0x140, 0xF, 0xF, true));
}
__device__ __forceinline__ float wsum(float v) {
    v += dppx(v, 0); v += dppx(v, 1); v += dppx(v, 2); v += dppx(v, 3);
    const int iv = __builtin_bit_cast(int, v);
    return (__builtin_bit_cast(float, __builtin_amdgcn_readlane(iv, 0)) + __builtin_bit_cast(float, __builtin_amdgcn_readlane(iv, 16))) +
           (__builtin_bit_cast(float, __builtin_amdgcn_readlane(iv, 32)) + __builtin_bit_cast(float, __builtin_amdgcn_readlane(iv, 48)));
}
__device__ __forceinline__ void sgu_unit(const Frame& F, int blk, bf16* SU, const bf16* SV, const bf16* WSM, const float* lng, const float* lnb, const float* bs) {
    LAS unsigned char* lds = F.lds;
    int tid = F.tid; asm volatile("" : "+v"(tid));
    const int lane = tid & 63, r32 = lane & 31, hi = lane >> 5, wid = F.wave;
    const size_t R0 = (size_t)blk * 128;
    LAS float* stat = (LAS float*)(lds + STAT_OFF);
    { v4u wv[16];
#pragma unroll
      for (int i = 0; i < 16; ++i) wv[i] = *(const v4u*)(SV + (R0 + wid * 16 + i) * HW + lane * 8);
#pragma unroll
      for (int i = 0; i < 16; ++i) { const v4u w = wv[i];
        const float x[8] = {bf_lo(w.x), bf_hi(w.x), bf_lo(w.y), bf_hi(w.y), bf_lo(w.z), bf_hi(w.z), bf_lo(w.w), bf_hi(w.w)};
        float sm = 0.f;
#pragma unroll
        for (int e = 0; e < 8; ++e) sm += x[e];
        const float mu = wsum(sm) * (1.0f / 512.0f); float qv = 0.f;
#pragma unroll
        for (int e = 0; e < 8; ++e) { const float d = x[e] - mu; qv += d * d; }
        const float rstd = __builtin_amdgcn_rsqf(wsum(qv) * (1.0f / 512.0f) + EPS);
        if (lane == 0) { stat[2 * (wid * 16 + i)] = mu; stat[2 * (wid * 16 + i) + 1] = rstd; } } }
    __syncthreads();
    const int ib = wid & 3, chf = wid >> 2;
    const int grp = lane >> 4, qi = (lane & 15) >> 2, pi = lane & 3;
    const int vbase = (8 * (grp >> 1) + qi) * VROW + (16 * (grp & 1) + 4 * pi) * 2;
    for (int g = 0; g < 4; ++g) {
        { const int j = tid >> 2, sg = tid & 3; const float mu = stat[2 * j], rstd = stat[2 * j + 1];
          const bf16* src = SV + (R0 + j) * HW + g * 128 + sg * 32;
          v4u wv[4];
#pragma unroll
          for (int q = 0; q < 4; ++q) wv[q] = *(const v4u*)(src + q * 8);
#pragma unroll
          for (int q = 0; q < 4; ++q) { const v4u w = wv[q]; const int ch = g * 128 + sg * 32 + q * 8;
              const f32x4 ga = *(const f32x4*)(lng + ch), gb = *(const f32x4*)(lng + ch + 4), ba = *(const f32x4*)(lnb + ch), bb = *(const f32x4*)(lnb + ch + 4);
              v4u o;
              o.x = cvtpk((bf_lo(w.x) - mu) * rstd * ga[0] + ba[0], (bf_hi(w.x) - mu) * rstd * ga[1] + ba[1]);
              o.y = cvtpk((bf_lo(w.y) - mu) * rstd * ga[2] + ba[2], (bf_hi(w.y) - mu) * rstd * ga[3] + ba[3]);
              o.z = cvtpk((bf_lo(w.z) - mu) * rstd * gb[0] + bb[0], (bf_hi(w.z) - mu) * rstd * gb[1] + bb[1]);
              o.w = cvtpk((bf_lo(w.w) - mu) * rstd * gb[2] + bb[2], (bf_hi(w.w) - mu) * rstd * gb[3] + bb[3]);
              *(LAS v4u*)(lds + j * VROW + (sg * 32 + q * 8) * 2) = o; } }
        bf16x8 wf[8];
        { const bf16* Wg = WSM + (size_t)g * 128 * 128 + (size_t)(32 * ib + r32) * 128 + hi * 8;
#pragma unroll
          for (int s = 0; s < 8; ++s) wf[s] = *(const bf16x8*)(Wg + 16 * s); }
        bf16* sup = SU + (R0 + 32 * ib + r32) * HW + g * 128 + chf * 64 + 4 * hi;
        v2u sw[8];
#pragma unroll
        for (int k = 0; k < 8; ++k) sw[k] = *(const v2u*)(sup + (k >> 2) * 32 + (k & 3) * 8);
        const float bi = bs[g * 128 + 32 * ib + r32];
        __syncthreads();
        f32x16 acc[2]; acc[0] = (f32x16){}; acc[1] = (f32x16){};
#pragma unroll
        for (int s = 0; s < 8; ++s) {
#pragma unroll
            for (int cb = 0; cb < 2; ++cb) { const int cblk = 2 * chf + cb;
                const s16x4 lo = att::vtr(lds + vbase + (16 * s) * VROW + cblk * 64);
                const s16x4 hh = att::vtr(lds + vbase + (16 * s + 4) * VROW + cblk * 64);
                const bf16x8 vf = (bf16x8){lo[0], lo[1], lo[2], lo[3], hh[0], hh[1], hh[2], hh[3]};
                acc[cb] = __builtin_amdgcn_mfma_f32_32x32x16_bf16(vf, wf[s], acc[cb], 0, 0, 0); }
        }
#pragma unroll
        for (int k = 0; k < 8; ++k) { const int cb = k >> 2, q = k & 3; const v2u w = sw[k];
            const unsigned o0 = cvtpk(bf_lo(w.x) * (acc[cb][4 * q + 0] + bi), bf_hi(w.x) * (acc[cb][4 * q + 1] + bi));
            const unsigned o1 = cvtpk(bf_lo(w.y) * (acc[cb][4 * q + 2] + bi), bf_hi(w.y) * (acc[cb][4 * q + 3] + bi));
            *(v2u*)(sup + cb * 32 + q * 8) = (v2u){o0, o1}; }
        __syncthreads();
    }
}
}
namespace peer {
__device__ __forceinline__ float dpp_xor1(float v) { return __builtin_bit_cast(float, __builtin_amdgcn_mov_dpp(__builtin_bit_cast(int, v), 0xB1, 0xF, 0xF, true)); }
__device__ __forceinline__ float dpp_xor2(float v) { return __builtin_bit_cast(float, __builtin_amdgcn_mov_dpp(__builtin_bit_cast(int, v), 0x4E, 0xF, 0xF, true)); }
__device__ __forceinline__ void ins16(float (&L)[16], const float x) {
#pragma unroll
    for (int i = 15; i >= 1; --i) L[i] = __builtin_amdgcn_fmed3f(L[i - 1], L[i], x);
    L[0] = __builtin_fmaxf(L[0], x);
}
__device__ __forceinline__ float tagf(float v, unsigned mask, unsigned tag) { return __builtin_bit_cast(float, (__builtin_bit_cast(unsigned, v) & ~mask) | tag); }
__device__ __forceinline__ float sel16(const float (&A)[16], int i) {
    float r = A[0];
#pragma unroll
    for (int k = 1; k < 16; ++k) { const float ak = A[k]; r = (i == k) ? ak : r; }
    return r;
}
__device__ __forceinline__ void topk_phase(const Frame& F) {
    const unsigned short* S = (const unsigned short*)(F.ws + WS_SCORES); const float* ssq = (const float*)(F.ws + WS_SSQ);
    float* GW = (float*)(F.ws + WS_GW);
    const int gw = F.vcu * NWAVES + F.wave, NGW = F.G * NWAVES, lane = F.lane;
    const int q = lane & 3;
    static_assert(T * PK_HEADS / 16 == NEXP, "two table rows per top-k wave-item");
    f32x4 g2v[4];
#pragma unroll
    for (int j = 0; j < 4; ++j) g2v[j] = *(const f32x4*)(F.in[17] + 16 * lane + 4 * j);
    for (int it = gw; it < T * PK_HEADS / 16; it += NGW) {
        const bool isu = it < NEXP / 2; const int e0 = isu ? 2 * it : 2 * it - NEXP;
        f32x4 tr0[4], tr1[4];
        const int th = it * 16 + (lane >> 2), t = th >> 3, h = th & 7;
        const unsigned short* sp = S + (size_t)t * 2048 + h * 256 + q * 64;
        float L[16];
#pragma unroll
        for (int i = 0; i < 16; ++i) L[i] = -INFINITY;
#pragma unroll
        for (int c4 = 0; c4 < 4; ++c4) {
            typedef _Float16 h16x8 __attribute__((ext_vector_type(8)));
            h16x8 hv[2];
#pragma unroll
            for (int j = 0; j < 2; ++j) hv[j] = *(const h16x8*)(sp + 16 * c4 + 8 * j);
#pragma unroll
            for (int j = 0; j < 2; ++j)
#pragma unroll
                for (int e = 0; e < 8; ++e) ins16(L, tagf((float)hv[j][e], 127u, (unsigned)((q & 1) * 64 + 16 * c4 + 8 * j + e)));
        }
        __builtin_amdgcn_sched_barrier(0);
        { const float* src = (isu ? F.in[20] : F.in[21]) + (size_t)e0 * DM + 16 * lane;
#pragma unroll
          for (int j = 0; j < 4; ++j) { tr0[j] = *(const f32x4*)(src + 4 * j); tr1[j] = *(const f32x4*)(src + DM + 4 * j); } }
        __builtin_amdgcn_sched_barrier(0);
        { float P[16];
#pragma unroll
          for (int i = 0; i < 16; ++i) P[i] = dpp_xor1(L[i]);
#pragma unroll
          for (int i = 0; i < 16; ++i) ins16(L, P[i]); }
        float A[16], B[16];
        { const bool lowp = q < 2;
#pragma unroll
          for (int i = 0; i < 16; ++i) { const float o = dpp_xor2(L[i]); A[i] = lowp ? L[i] : o; B[i] = lowp ? o : L[i]; } }
        float W[16];
#pragma unroll
        for (int i = 0; i < 16; ++i) W[i] = -INFINITY;
#pragma unroll
        for (int a = 0; a < 16; ++a) { const float sa = tagf(A[a], 127u, 0u);
#pragma unroll
            for (int b = 0; b < 16; ++b) if ((a + 1) * (b + 1) <= 16) ins16(W, tagf(sa + tagf(B[b], 127u, 0u), 255u, (unsigned)(a * 16 + b))); }
        const f32x4 pq = *(const f32x4*)(ssq + (size_t)t * 16 + 4 * q);
        float pss = (pq[0] + pq[1]) + (pq[2] + pq[3]); pss += dpp_xor1(pss); pss += dpp_xor2(pss);
        const float rstd = 1.0f / sqrtf(pss * (1.0f / DM) + EPS);
        const float z0 = tagf(W[0], 255u, 0u) * rstd; float es = 0.f;
#pragma unroll
        for (int i = 0; i < 16; ++i) es += __expf(tagf(W[i], 255u, 0u) * rstd - z0);
        const float inv = 1.0f / es;
        int eo[4]; float go[4];
#pragma unroll
        for (int j = 0; j < 4; ++j) {
            const float w0 = W[j], w1 = W[4 + j], w2 = W[8 + j], w3 = W[12 + j];
            float w = w0; w = (q == 1) ? w1 : w; w = (q == 2) ? w2 : w; w = (q == 3) ? w3 : w;
            const unsigned bits = __builtin_bit_cast(unsigned, w);
            const int ai = (bits >> 4) & 15, bi = bits & 15;
            const unsigned i1 = __builtin_bit_cast(unsigned, sel16(A, ai)) & 127u, i2 = __builtin_bit_cast(unsigned, sel16(B, bi)) & 127u;
            eo[j] = (int)(i1 * 128u + i2);
            go[j] = __expf(tagf(w, 255u, 0u) * rstd - z0) * inv;
        }
        typedef int i32x4 __attribute__((ext_vector_type(4)));
        *(v2u*)((unsigned*)(F.ws + WS_IDX16) + (size_t)t * 64 + h * 8 + 2 * q) = (v2u){(unsigned)eo[0] | ((unsigned)eo[1] << 16), (unsigned)eo[2] | ((unsigned)eo[3] << 16)};
        *(f32x4*)(GW + (size_t)t * 128 + h * 16 + 4 * q) = (f32x4){go[0], go[1], go[2], go[3]};
        if (isu) {
#pragma unroll
            for (int j = 0; j < 4; ++j) { tr0[j] = tr0[j] * g2v[j]; tr1[j] = tr1[j] * g2v[j]; } }
        table_row_store(F.ws, tr0, isu, e0, lane); table_row_store(F.ws, tr1, isu, e0 + 1, lane);
    }
    {
        unsigned char* X1Q = F.ws + WS_X1Q; float* X1S = (float*)(F.ws + WS_X1S);
        for (int t = gw; t < T; t += NGW) {
            f32x4 v[4]; float am = 0.f;
            { const bf16* xb = (const bf16*)(F.ws + WS_XB) + (size_t)t * DM + 16 * lane;
              const v4u w0 = *(const v4u*)xb, w1 = *(const v4u*)(xb + 8);
              v[0] = (f32x4){bf_lo(w0.x), bf_hi(w0.x), bf_lo(w0.y), bf_hi(w0.y)}; v[1] = (f32x4){bf_lo(w0.z), bf_hi(w0.z), bf_lo(w0.w), bf_hi(w0.w)};
              v[2] = (f32x4){bf_lo(w1.x), bf_hi(w1.x), bf_lo(w1.y), bf_hi(w1.y)}; v[3] = (f32x4){bf_lo(w1.z), bf_hi(w1.z), bf_lo(w1.w), bf_hi(w1.w)}; }
#pragma unroll
            for (int j = 0; j < 4; ++j) am = fmaxf(am, fmaxf(fmaxf(fabsf(v[j][0]), fabsf(v[j][1])), fmaxf(fabsf(v[j][2]), fabsf(v[j][3]))));
            am = fmaxf(am, __shfl_xor(am, 1)); am = fmaxf(am, __shfl_xor(am, 2)); am = fmaxf(am, __shfl_xor(am, 4));
            const float sx = am > 0.f ? 127.0f / am : 0.f;
            unsigned wq[4];
#pragma unroll
            for (int j = 0; j < 4; ++j) wq[j] = ((unsigned)__float2int_rn(v[j][0] * sx) & 0xffu) | (((unsigned)__float2int_rn(v[j][1] * sx) & 0xffu) << 8) | (((unsigned)__float2int_rn(v[j][2] * sx) & 0xffu) << 16) | (((unsigned)__float2int_rn(v[j][3] * sx) & 0xffu) << 24);
            *(v4u*)(X1Q + (size_t)t * DM + 16 * lane) = (v4u){wq[0], wq[1], wq[2], wq[3]};
            if ((lane & 7) == 0) X1S[(size_t)t * 8 + (lane >> 3)] = am * (1.0f / 127.0f);
        }
    }
}

__device__ __forceinline__ void unpack16(float (&f)[16], const v4u w) {
    f32x2 t;
    t = __builtin_amdgcn_cvt_pk_f32_fp8((int)w.x, false); f[0] = t[0]; f[1] = t[1]; t = __builtin_amdgcn_cvt_pk_f32_fp8((int)w.x, true); f[2] = t[0]; f[3] = t[1];
    t = __builtin_amdgcn_cvt_pk_f32_fp8((int)w.y, false); f[4] = t[0]; f[5] = t[1]; t = __builtin_amdgcn_cvt_pk_f32_fp8((int)w.y, true); f[6] = t[0]; f[7] = t[1];
    t = __builtin_amdgcn_cvt_pk_f32_fp8((int)w.z, false); f[8] = t[0]; f[9] = t[1]; t = __builtin_amdgcn_cvt_pk_f32_fp8((int)w.z, true); f[10] = t[0]; f[11] = t[1];
    t = __builtin_amdgcn_cvt_pk_f32_fp8((int)w.w, false); f[12] = t[0]; f[13] = t[1]; t = __builtin_amdgcn_cvt_pk_f32_fp8((int)w.w, true); f[14] = t[0]; f[15] = t[1];
}
__device__ __forceinline__ void unpack8x2(f32x2 (&t)[8], const v4u w) {
    t[0] = __builtin_amdgcn_cvt_pk_f32_fp8((int)w.x, false); t[1] = __builtin_amdgcn_cvt_pk_f32_fp8((int)w.x, true);
    t[2] = __builtin_amdgcn_cvt_pk_f32_fp8((int)w.y, false); t[3] = __builtin_amdgcn_cvt_pk_f32_fp8((int)w.y, true);
    t[4] = __builtin_amdgcn_cvt_pk_f32_fp8((int)w.z, false); t[5] = __builtin_amdgcn_cvt_pk_f32_fp8((int)w.z, true);
    t[6] = __builtin_amdgcn_cvt_pk_f32_fp8((int)w.w, false); t[7] = __builtin_amdgcn_cvt_pk_f32_fp8((int)w.w, true);
}
__device__ __forceinline__ float dot_pk(const v4u w, const f32x2 (&xx)[8]) {
    f32x2 t[8]; unpack8x2(t, w);
    f32x2 a = xx[0] * t[0], b = xx[1] * t[1];
    a = xx[2] * t[2] + a; b = xx[3] * t[3] + b; a = xx[4] * t[4] + a; b = xx[5] * t[5] + b; a = xx[6] * t[6] + a; b = xx[7] * t[7] + b;
    const f32x2 c = a + b; return c[0] + c[1];
}
__device__ __forceinline__ void axpy_pk(f32x2 (&acc)[8], const float cf, const v4u w) {
    f32x2 t[8]; unpack8x2(t, w); const f32x2 cv = (f32x2){cf, cf};
#pragma unroll
    for (int k = 0; k < 8; ++k) acc[k] = cv * t[k] + acc[k];
}
struct Slice { int p0, np, wrank, wcount; };
__device__ __forceinline__ Slice slice_of(const Frame& F) {
    Slice s; const int b = (int)blockIdx.x;
    if (F.G % 8 == 0) { s.p0 = b & 7; s.np = 1; s.wrank = (b >> 3) * NWAVES + F.wave; s.wcount = (F.G >> 3) * NWAVES; }
    else { s.p0 = 0; s.np = 8; s.wrank = b * NWAVES + F.wave; s.wcount = F.G * NWAVES; }
    return s;
}
typedef int i32x4 __attribute__((ext_vector_type(4)));
__device__ __forceinline__ void expert_u_phase(const Frame& F, const int tb, const int te) {
    const unsigned char* UQ = F.ws + WS_UQ; const int* IDX = (const int*)(F.ws + WS_IDX); bf16* PART = (bf16*)(F.ws + WS_PART);
    const unsigned char* X1Q = F.ws + WS_X1Q; const float* X1S = (const float*)(F.ws + WS_X1S);
    const int lane = F.lane, g = lane >> 3, i = lane & 7;
    const Slice sl = slice_of(F);
    for (int p = sl.p0; p < sl.p0 + sl.np; ++p) {
    const int tfirst = tb + sl.wrank;
    if (tfirst >= te) continue;
    const int tlast = tfirst + ((te - 1 - tfirst) / sl.wcount) * sl.wcount;
    const unsigned* ID16 = (const unsigned*)(F.ws + WS_IDX16);
    v4u ev[2]; i32x4 xq;
#pragma unroll
    for (int j = 0; j < 2; ++j) ev[j] = *(const v4u*)(ID16 + (size_t)tfirst * 64 + 8 * g + 4 * j);
    xq = *(const i32x4*)(X1Q + (size_t)tfirst * DM + 128 * p + 16 * i);
    for (int t = tfirst; t <= tlast; t += sl.wcount) {
        v4u w[16];
#pragma unroll
        for (int s = 0; s < 16; ++s) { const unsigned pk = ev[s >> 3][(s >> 1) & 3]; const unsigned e = (s & 1) ? (pk >> 16) : (pk & 0xffffu); w[s] = *(const v4u*)(UQ + (size_t)p * (NEXP * 128) + (size_t)e * 128 + 16 * i); }
        const int tn = (t + sl.wcount <= tlast) ? t + sl.wcount : tlast;
        v4u evn[2];
#pragma unroll
        for (int j = 0; j < 2; ++j) evn[j] = *(const v4u*)(ID16 + (size_t)tn * 64 + 8 * g + 4 * j);
        const i32x4 xqn = *(const i32x4*)(X1Q + (size_t)tn * DM + 128 * p + 16 * i);
        const float dq = X1S[(size_t)t * 8 + p];
        int part[16];
#pragma unroll
        for (int s = 0; s < 16; ++s) { int a = __builtin_amdgcn_sdot4((int)w[s].x, xq[0], 0, false); a = __builtin_amdgcn_sdot4((int)w[s].y, xq[1], a, false);
            a = __builtin_amdgcn_sdot4((int)w[s].z, xq[2], a, false); part[s] = __builtin_amdgcn_sdot4((int)w[s].w, xq[3], a, false); }
        { const bool up = (i & 4) != 0;
#pragma unroll
          for (int k = 0; k < 8; ++k) { const int lo_ = part[k], hi_ = part[k + 8]; const int keep = up ? hi_ : lo_, send = up ? lo_ : hi_; part[k] = keep + __shfl_xor(send, 4); } }
        { const bool up = (i & 2) != 0;
#pragma unroll
          for (int k = 0; k < 4; ++k) { const int lo_ = part[k], hi_ = part[k + 4]; const int keep = up ? hi_ : lo_, send = up ? lo_ : hi_; part[k] = keep + __builtin_amdgcn_mov_dpp(send, 0x4E, 0xF, 0xF, true); } }
        { const bool up = (i & 1) != 0;
#pragma unroll
          for (int k = 0; k < 2; ++k) { const int lo_ = part[k], hi_ = part[k + 2]; const int keep = up ? hi_ : lo_, send = up ? lo_ : hi_; part[k] = keep + __builtin_amdgcn_mov_dpp(send, 0xB1, 0xF, 0xF, true); } }
        *(unsigned*)(PART + ((size_t)p * T + t) * 128 + 16 * g + 2 * i) = cvtpk((float)part[0] * dq, (float)part[1] * dq);
        ev[0] = evn[0]; ev[1] = evn[1];
        xq = xqn;
    }
    }
}
__device__ __forceinline__ void expert_coef_phase(const Frame& F, const int tb, const int te) {
    const bf16* PART = (const bf16*)(F.ws + WS_PART); const float* GW = (const float*)(F.ws + WS_GW);
    const float* ssq = (const float*)(F.ws + WS_SSQ); const f32x2* SUV = (const f32x2*)(F.ws + WS_SUQ);
    bf16* COEF = (bf16*)(F.ws + WS_COEF); const unsigned short* ID16 = (const unsigned short*)(F.ws + WS_IDX16);
    const int gt = F.vcu * (NWAVES * 64) + F.tid, NGT = F.G * NWAVES * 64;
    for (int it8 = tb * 16 + gt; it8 < te * 16; it8 += NGT) {
        const int it = it8 * 8, t = it8 >> 4;
        v4u pp[8];
#pragma unroll
        for (int p = 0; p < 8; ++p) pp[p] = *(const v4u*)(PART + (size_t)p * T * 128 + it);
        const v4u idw = *(const v4u*)(ID16 + it);
        const f32x4 g0 = *(const f32x4*)(GW + it), g1 = *(const f32x4*)(GW + it + 4);
        float q = 0.f;
#pragma unroll
        for (int j = 0; j < 4; ++j) { const f32x4 v = *(const f32x4*)(ssq + (size_t)t * 16 + 4 * j); q += (v[0] + v[1]) + (v[2] + v[3]); }
        const float rstd = __builtin_amdgcn_rsqf(q * (1.0f / DM) + EPS);
        unsigned ids[8] = {idw.x & 0xffffu, idw.x >> 16, idw.y & 0xffffu, idw.y >> 16, idw.z & 0xffffu, idw.z >> 16, idw.w & 0xffffu, idw.w >> 16};
        float su[8], sv[8];
#pragma unroll
        for (int k = 0; k < 8; ++k) { const f32x2 s2 = SUV[ids[k]]; su[k] = s2[0]; sv[k] = s2[1]; }
        float s[8];
#pragma unroll
        for (int k = 0; k < 8; ++k) s[k] = 0.f;
#pragma unroll
        for (int p = 0; p < 8; ++p) { s[0] += bf_lo(pp[p].x); s[1] += bf_hi(pp[p].x); s[2] += bf_lo(pp[p].y); s[3] += bf_hi(pp[p].y); s[4] += bf_lo(pp[p].z); s[5] += bf_hi(pp[p].z); s[6] += bf_lo(pp[p].w); s[7] += bf_hi(pp[p].w); }
        const float gw[8] = {g0[0], g0[1], g0[2], g0[3], g1[0], g1[1], g1[2], g1[3]};
        float c[8];
#pragma unroll
        for (int k = 0; k < 8; ++k) c[k] = gelu1(s[k] * rstd * su[k]) * gw[k] * sv[k];
        *(v4u*)(COEF + it) = (v4u){cvtpk(c[0], c[1]), cvtpk(c[2], c[3]), cvtpk(c[4], c[5]), cvtpk(c[6], c[7])};
    }
}
__device__ __forceinline__ float bfly32(float keep_lo, float keep_hi) { asm("s_nop 1\n\tv_permlane32_swap_b32_e32 %0, %1" : "+v"(keep_lo), "+v"(keep_hi)); return keep_lo + keep_hi; }
__device__ __forceinline__ float bfly16(float keep_lo, float keep_hi) { asm("s_nop 1\n\tv_permlane16_swap_b32_e32 %0, %1" : "+v"(keep_lo), "+v"(keep_hi)); return keep_lo + keep_hi; }
__device__ __forceinline__ float dpp_ror8(float v) { return __builtin_bit_cast(float, __builtin_amdgcn_mov_dpp(__builtin_bit_cast(int, v), 0x128, 0xF, 0xF, true)); }
__device__ __forceinline__ float wave_sum_dpp(float v) {
    v += dpp_xor1(v); v += dpp_xor2(v);
    v += __builtin_bit_cast(float, __builtin_amdgcn_mov_dpp(__builtin_bit_cast(int, v), 0x141, 0xF, 0xF, true));
    v += __builtin_bit_cast(float, __builtin_amdgcn_mov_dpp(__builtin_bit_cast(int, v), 0x140, 0xF, 0xF, true));
    const int iv = __builtin_bit_cast(int, v);
    return (__builtin_bit_cast(float, __builtin_amdgcn_readlane(iv, 0)) + __builtin_bit_cast(float, __builtin_amdgcn_readlane(iv, 16))) +
           (__builtin_bit_cast(float, __builtin_amdgcn_readlane(iv, 32)) + __builtin_bit_cast(float, __builtin_amdgcn_readlane(iv, 48)));
}
__device__ __forceinline__ void expert_v_phase(const Frame& F, const int tb, const int te) {
    const unsigned* COEF = (const unsigned*)(F.ws + WS_COEF);
    float* SSQ2 = (float*)(F.ws + WS_SSQ2); const int lane = F.lane, g = lane >> 3, i = lane & 7;
    const Slice sl = slice_of(F);
    for (int p = sl.p0; p < sl.p0 + sl.np; ++p) {
    const int tfirst = tb + sl.wrank;
    if (tfirst >= te) continue;
    const int tlast = tfirst + ((te - 1 - tfirst) / sl.wcount) * sl.wcount;
    const unsigned* ID16 = (const unsigned*)(F.ws + WS_IDX16) + 8 * g;
    const unsigned char* VQs = F.ws + WS_VQ + (size_t)p * (NEXP * 128);
    const unsigned lo16 = 16u * i;
    const bf16* XBp = (const bf16*)(F.ws + WS_XB) + 128 * p + 16 * i + 2 * g;
    bf16* YBp = (bf16*)(F.ws + WS_YB) + 128 * p + 16 * i + 2 * g;
    const unsigned* CFp = COEF + 8 * g;
#define V_IDS(ev, tt) do { ev[0] = *(const v4u*)(ID16 + (size_t)(tt) * 64); ev[1] = *(const v4u*)(ID16 + (size_t)(tt) * 64 + 4); } while (0)
#define V_GATHER(W, cv, xw, ev, tt) do { \
        _Pragma("unroll") for (int s = 0; s < 16; ++s) { const unsigned pk = ev[s >> 3][(s >> 1) & 3]; const unsigned e = (s & 1) ? (pk >> 16) : (pk & 0xffffu); W[s] = *(const v4u*)(VQs + (e * 128u + lo16)); } \
        cv[0] = *(const v4u*)(CFp + (size_t)(tt) * 64); cv[1] = *(const v4u*)(CFp + (size_t)(tt) * 64 + 4); \
        xw = *(const unsigned*)(XBp + (size_t)(tt) * DM); } while (0)
#define V_COMPUTE(W, cv, xw, tt) do { \
        f32x2 acc2[8]; \
        _Pragma("unroll") for (int c = 0; c < 8; ++c) acc2[c] = (f32x2){0.f, 0.f}; \
        _Pragma("unroll") for (int s = 0; s < 16; ++s) { const unsigned pk = cv[s >> 3][(s >> 1) & 3]; axpy_pk(acc2, (s & 1) ? bf_hi(pk) : bf_lo(pk), W[s]); } \
        float acc[16]; \
        _Pragma("unroll") for (int c = 0; c < 8; ++c) { acc[2 * c] = acc2[c][0]; acc[2 * c + 1] = acc2[c][1]; } \
          \
        _Pragma("unroll") for (int k = 0; k < 8; ++k) acc[k] = bfly32(acc[k], acc[k + 8]); \
        _Pragma("unroll") for (int k = 0; k < 4; ++k) acc[k] = bfly16(acc[k], acc[k + 4]); \
        { const bool up = (g & 1) != 0; \
          _Pragma("unroll") for (int k = 0; k < 2; ++k) { const float lo_ = acc[k], hi_ = acc[k + 2]; const float keep = up ? hi_ : lo_, send = up ? lo_ : hi_; acc[k] = keep + dpp_ror8(send); } } \
        const float y0 = bf_lo(xw) + acc[0], y1 = bf_hi(xw) + acc[1]; \
        *(unsigned*)(YBp + (size_t)(tt) * DM) = cvtpk(y0, y1); \
        const float ss = wave_sum_dpp(y0 * y0 + y1 * y1); \
        if (lane == 0) SSQ2[(size_t)(tt) * 8 + p] = ss; } while (0)
#define V_STEP(Wc, cvc, xwc, tc, Wn, cvn, xwn, evn, evnn, tn, tnn) do { \
        V_IDS(evnn, tnn); \
        cvn[0] = *(const v4u*)(CFp + (size_t)(tn) * 64); cvn[1] = *(const v4u*)(CFp + (size_t)(tn) * 64 + 4); \
        xwn = *(const unsigned*)(XBp + (size_t)(tn) * DM); \
        __builtin_amdgcn_sched_barrier(0);                                             \
        f32x2 acc2[8]; \
        _Pragma("unroll") for (int c = 0; c < 8; ++c) acc2[c] = (f32x2){0.f, 0.f}; \
        _Pragma("unroll") for (int s = 0; s < 16; ++s) { \
            if (s < 8) { const unsigned pk = evn[s >> 2][s & 3]; Wn[2 * s] = *(const v4u*)(VQs + ((pk & 0xffffu) * 128u + lo16)); Wn[2 * s + 1] = *(const v4u*)(VQs + ((pk >> 16) * 128u + lo16)); }     \
            { const unsigned pk = cvc[s >> 3][(s >> 1) & 3]; axpy_pk(acc2, (s & 1) ? bf_hi(pk) : bf_lo(pk), Wc[s]); } \
            __builtin_amdgcn_sched_barrier(0); } \
        float acc[16]; \
        _Pragma("unroll") for (int c = 0; c < 8; ++c) { acc[2 * c] = acc2[c][0]; acc[2 * c + 1] = acc2[c][1]; } \
        _Pragma("unroll") for (int k = 0; k < 8; ++k) acc[k] = bfly32(acc[k], acc[k + 8]); \
        _Pragma("unroll") for (int k = 0; k < 4; ++k) acc[k] = bfly16(acc[k], acc[k + 4]); \
        { const bool up = (g & 1) != 0; \
          _Pragma("unroll") for (int k = 0; k < 2; ++k) { const float lo_ = acc[k], hi_ = acc[k + 2]; const float keep = up ? hi_ : lo_, send = up ? lo_ : hi_; acc[k] = keep + dpp_ror8(send); } } \
        const float y0 = bf_lo(xwc) + acc[0], y1 = bf_hi(xwc) + acc[1]; \
        *(unsigned*)(YBp + (size_t)(tc) * DM) = cvtpk(y0, y1); \
        const float ss = wave_sum_dpp(y0 * y0 + y1 * y1); \
        if (lane == 0) SSQ2[(size_t)(tc) * 8 + p] = ss; } while (0)
    v4u evA[2], evB[2], cvA[2], cvB[2], WA[16], WB[16]; unsigned xwA, xwB;
    int t = tfirst;
    V_IDS(evA, t);
    V_GATHER(WA, cvA, xwA, evA, t);
    { const int t1 = (t + sl.wcount <= tlast) ? t + sl.wcount : tlast; V_IDS(evB, t1); }
    for (;;) {
        { const int t1 = (t + sl.wcount <= tlast) ? t + sl.wcount : tlast, t2 = (t1 + sl.wcount <= tlast) ? t1 + sl.wcount : tlast;
          V_STEP(WA, cvA, xwA, t, WB, cvB, xwB, evB, evA, t1, t2); }
        if (t + sl.wcount > tlast) break;
        t += sl.wcount;
        { const int t1 = (t + sl.wcount <= tlast) ? t + sl.wcount : tlast, t2 = (t1 + sl.wcount <= tlast) ? t1 + sl.wcount : tlast;
          V_STEP(WB, cvB, xwB, t, WA, cvA, xwA, evA, evB, t1, t2); }
        if (t + sl.wcount > tlast) break;
        t += sl.wcount;
    }
#undef V_STEP
#undef V_IDS
#undef V_GATHER
#undef V_COMPUTE
    }
}
__device__ __forceinline__ void final_norm_phase(const Frame& F) {
    const float* SSQ2 = (const float*)(F.ws + WS_SSQ2); const float* gf = F.in[22]; float* out = F.out;
    const int gw = F.vcu * NWAVES + F.wave, NGW = F.G * NWAVES, lane = F.lane;
    f32x4 gv[4];
#pragma unroll
    for (int j = 0; j < 4; ++j) gv[j] = *((const f32x4*)gf + lane + 64 * j);
    for (int t = gw; t < T; t += NGW) {
        const f32x4 a = *(const f32x4*)(SSQ2 + (size_t)t * 8), b = *(const f32x4*)(SSQ2 + (size_t)t * 8 + 4);
        const float r = 1.0f / sqrtf(((a[0] + a[1]) + (a[2] + a[3]) + (b[0] + b[1]) + (b[2] + b[3])) * (1.0f / DM) + EPS);
        f32x4* row = (f32x4*)(out + (size_t)t * DM) + lane;
        const v2u* yr = (const v2u*)((const bf16*)(F.ws + WS_YB) + (size_t)t * DM) + lane;
        v2u yv[4];
#pragma unroll
        for (int j = 0; j < 4; ++j) yv[j] = yr[64 * j];
#pragma unroll
        for (int j = 0; j < 4; ++j) { const f32x4 v = {bf_lo(yv[j].x), bf_hi(yv[j].x), bf_lo(yv[j].y), bf_hi(yv[j].y)}; row[64 * j] = v * r * gv[j]; }
    }
}
}
struct Args { const float* in[23]; float* out; unsigned char* ws; };
constexpr int N_PHASES = 8;

template <int K> __device__ __forceinline__ void run_phase(Frame& F) {
    asm volatile("" : "+v"(F.tid), "+v"(F.lane));
    unsigned char* ws = F.ws;
    if constexpr (K == 0) { p0_prologue(F); }
    if constexpr (K == 13) { p0b_quant_weights(F); }
    if constexpr (K == 1) {
        pg8::Gemm g{(const pg8::bf16_t*)(ws + WS_XB), (const pg8::bf16_t*)(ws + WS_W1Q), T, N1, DM / 2};
        pg8::StaticOrder S; S.init(T, N1, F.G, (int)blockIdx.x);
        EpiP1 E{ws, F.in[15], (const float*)(ws + WS_ROPE), (const float*)(ws + WS_XS), (const float*)(ws + WS_WSC)};
        pg8::gemm_phase<EpiP1, pg8::StaticOrder, true, true>(F.lds, g, S, E);
    }
    if constexpr (K == 2) {
        const float lam = ((const float*)(ws + WS_MISC))[0];
        for (int pi = F.vcu; pi < 512; pi += F.G) {
            const int bh = pi >> 5, s = pi & 31;
            att::attn_unit<0>(F, bh >> 2, bh & 3, 63 - s, (bf16*)(ws + WS_Q), (const bf16*)(ws + WS_K), (const bf16*)(ws + WS_V), lam, F.in[7]);
            att::attn_unit<0>(F, bh >> 2, bh & 3, s, (bf16*)(ws + WS_Q), (const bf16*)(ws + WS_K), (const bf16*)(ws + WS_V), lam, F.in[7]);
        }
#ifndef NO_SGU
        for (int u = F.vcu; u < T / 128; u += F.G)
            sgu::sgu_unit(F, u, (bf16*)(ws + WS_SU), (const bf16*)(ws + WS_SV), (const bf16*)(ws + WS_WSM), F.in[8], F.in[9], F.in[11]);
#endif
    }
#ifdef ATT_PROBE
    if constexpr (K == 11) {
        const float lam = ((const float*)(ws + WS_MISC))[0];
        for (int pi = F.vcu; pi < 512; pi += F.G) {
            const int bh = pi >> 5, s = pi & 31;
            att::attn_unit<ATT_PROBE>(F, bh >> 2, bh & 3, 63 - s, (bf16*)(ws + WS_Q), (const bf16*)(ws + WS_K), (const bf16*)(ws + WS_V), lam, F.in[7]);
            att::attn_unit<ATT_PROBE>(F, bh >> 2, bh & 3, s, (bf16*)(ws + WS_Q), (const bf16*)(ws + WS_K), (const bf16*)(ws + WS_V), lam, F.in[7]);
        }
    }
#endif
    if constexpr (K == 3) {
#ifdef P3_STAGGER
        if (F.vcu & 1) { for (int i_ = 0; i_ < P3_STAGGER; ++i_) __builtin_amdgcn_s_sleep(127); }
#endif
        pg8::Gemm g{(const pg8::bf16_t*)(ws + WS_Q), (const pg8::bf16_t*)(ws + WS_WAB), 2 * T, 2048, 512};
        BranchOrder S; S.so.init(T, DM, F.G, (int)blockIdx.x);
        EpiGate E{(bf16*)(ws + WS_G), (const unsigned char*)(ws + WS_GATES)};
        pg8::gemm_phase<EpiGate, BranchOrder, true, true>(F.lds, g, S, E);
    }
    if constexpr (K == 4) {
        pg8::Gemm g{(const pg8::bf16_t*)(ws + WS_G), (const pg8::bf16_t*)(ws + WS_WO2), T, DM, DM};
        pg8::StaticOrder S; S.init(T, DM, F.G, (int)blockIdx.x);
        EpiX1 E{F.in[0], F.out, (bf16*)(ws + WS_XB), (float*)(ws + WS_SSQ)};
        pg8::gemm_phase<EpiX1, pg8::StaticOrder, true, true>(F.lds, g, S, E);
    }
    if constexpr (K == 5) {
        pg8::Gemm g{(const pg8::bf16_t*)(ws + WS_XB), (const pg8::bf16_t*)(ws + WS_WEF), T, 2048, DM};
        pg8::StaticOrder S; S.init(T, 2048, F.G, (int)blockIdx.x);
        EpiScores E{(unsigned short*)(ws + WS_SCORES)};
        pg8::gemm_phase<EpiScores, pg8::StaticOrder, true, true>(F.lds, g, S, E);
    }
    if constexpr (K == 6) { peer::topk_phase(F); }
    if constexpr (K == 7) { peer::expert_u_phase(F, 0, T); }
    if constexpr (K == 8) { peer::expert_coef_phase(F, 0, T); }
    if constexpr (K == 9) { peer::expert_v_phase(F, 0, T); }
    if constexpr (K == 10) { peer::final_norm_phase(F); }
}

#ifndef PROGRAM
#define PROGRAM P(0) S0 P(13) S P(1) S P(2) S P(3) S P(4) S P(5) S P(6) S P(7) S P(8) S P(9) S P(10)
#endif

__global__ void __launch_bounds__(NWAVES * 64, 2) mk_fwd(Args args) {
    extern __shared__ __attribute__((aligned(16))) unsigned char lds[];
    cg::grid_group grid = cg::this_grid();
    Frame F;
    F.lds = (LAS unsigned char*)lds;
    F.tid = threadIdx.x; F.lane = F.tid & 63; F.wave = __builtin_amdgcn_readfirstlane(F.tid >> 6);
    F.G = gridDim.x; { const int bx = blockIdx.x; F.vcu = (F.G % 8 == 0) ? (bx % 8) * (F.G / 8) + bx / 8 : bx; }
#pragma unroll
    for (int i = 0; i < 23; ++i) F.in[i] = args.in[i];
    F.out = args.out; F.ws = args.ws;
    volatile LAS unsigned* bst = (volatile LAS unsigned*)(F.lds + BAR_LDS_OFF);
    if (F.tid < 2) bst[F.tid] = 0u;
    __syncthreads();
    const XcdBarrier bar = xcd_barrier_post((unsigned*)(F.ws + WS_CTL) + CW_BAR, bst);
#define P(k) run_phase<k>(F);
#define S0 { __syncthreads(); grid.sync(); }
#define S { xcd_barrier(bar); }
    PROGRAM
#undef P
#undef S
#undef S0
}

#if DBG
struct DumpEnt { unsigned long long off; unsigned n; int type; };
struct DumpArgs { DumpEnt e[10]; int cnt; int pad; unsigned char* ws; float* out; };
__global__ void dbg_dump(DumpArgs a) {
    const unsigned NOUT = (unsigned)T * DM;
    for (unsigned i = blockIdx.x * blockDim.x + threadIdx.x; i < NOUT; i += gridDim.x * blockDim.x) {
        float acc = 0.f;
        for (int k = 0; k < a.cnt; ++k) {
            const DumpEnt en = a.e[k];
            const unsigned char* base = (en.off == ~0ull) ? (const unsigned char*)a.out : a.ws + en.off;
            for (unsigned j = i; j < en.n; j += NOUT) {
                float v;
                if (en.type == 0) v = bf2f(((const bf16*)base)[j]); else if (en.type == 1) v = ((const float*)base)[j]; else v = (float)((const int*)base)[j];
                acc += v;
            }
        }
        a.out[i] = acc;
    }
}
#endif
extern "C" void kernel_launch(void* const* d_in, const int* in_sizes, int n_in, void* d_out, int out_size, void* d_ws, size_t ws_size, hipStream_t stream) {
    static int grid = 0;
    if (grid == 0) {
        if (n_in != 23 || in_sizes[0] != T * DM || out_size != T * DM || ws_size < WS_END) { fprintf(stderr, "kernel_launch: unexpected shapes (n_in %d, in0 %d, out %d, ws %zu)\n", n_in, n_in > 0 ? in_sizes[0] : -1, out_size, ws_size); grid = -1; return; }
        int dev = 0, cus = 0, per_cu = 0;
        if (hipGetDevice(&dev) != hipSuccess || hipDeviceGetAttribute(&cus, hipDeviceAttributeMultiprocessorCount, dev) != hipSuccess) { grid = -1; return; }
        if (hipFuncSetAttribute((const void*)mk_fwd, hipFuncAttributeMaxDynamicSharedMemorySize, LDS_BYTES) != hipSuccess) { fprintf(stderr, "kernel_launch: hipFuncSetAttribute failed\n"); grid = -1; return; }
        if (hipOccupancyMaxActiveBlocksPerMultiprocessor(&per_cu, (const void*)mk_fwd, NWAVES * 64, LDS_BYTES) != hipSuccess || per_cu < 1) { fprintf(stderr, "kernel_launch: occupancy query says %d\n", per_cu); per_cu = 1; }
        (void)hipGetLastError();
        grid = cus;
    }
    if (grid < 0) return;
    if (hipMemsetAsync((char*)d_ws + WS_CTL, 0, CTL_ZERO_BYTES, stream) != hipSuccess) { fprintf(stderr, "kernel_launch: hipMemsetAsync failed\n"); return; }
    Args a{};
    for (int i = 0; i < 23; ++i) a.in[i] = (const float*)d_in[i];
    a.out = (float*)d_out; a.ws = (unsigned char*)d_ws;
    void* kargs[] = {&a};
    hipError_t e = hipLaunchCooperativeKernel((const void*)mk_fwd, dim3(grid), dim3(NWAVES * 64), kargs, LDS_BYTES, stream);
    if (e != hipSuccess) fprintf(stderr, "kernel_launch: cooperative launch failed: %s (grid %d)\n", hipGetErrorString(e), grid);
#if DBG
    const int last_phase = (DBG - 1) % 10;
#endif
#if DBG
    {
        DumpArgs d{}; d.ws = (unsigned char*)d_ws; d.out = (float*)d_out; int c = 0;
        auto add = [&](unsigned long long off, unsigned n, int type) { d.e[c].off = off; d.e[c].n = n; d.e[c].type = type; ++c; };
        const unsigned M1 = 1u << 20;
        switch (last_phase) {
            case 0: if (DBG >= 10) { add(WS_W1T, 4608 * 1024, 0); break; } add(WS_XB, 32 * M1, 0); add(WS_W1T, 4608 * 1024, 0); add(WS_WAB, M1, 0); add(WS_WO2, 2 * M1, 0); add(WS_WEF, 2 * M1, 0);  add(WS_ROPE, 512 * 1024, 1); add(WS_WSM, 65536, 0); add(WS_MISC, 1, 1); break;
            case 1: if (DBG < 10) { add(WS_Q, 16 * M1, 0); add(WS_SU, 16 * M1, 0); add(WS_GATES, 64 * M1, 0); add(WS_K, 16 * M1, 0); add(WS_V, 16 * M1, 0); add(WS_SV, 16 * M1, 0); }
                    else if (DBG < 20) add(WS_GATES, 64 * M1, 0);
                    else if (DBG < 30) { add(WS_Q, 16 * M1, 0); add(WS_K, 16 * M1, 0); }
                    else if (DBG < 40) { add(WS_V, 16 * M1, 0); }
                    else { add(WS_SU, 16 * M1, 0); add(WS_SV, 16 * M1, 0); } break;
            case 2: if (DBG < 10) { add(WS_Q, 16 * M1, 0); add(WS_SU, 16 * M1, 0); } else if (DBG < 20) add(WS_Q, 16 * M1, 0); else add(WS_SU, 16 * M1, 0); break;
            case 3: add(WS_G, 64 * M1, 0); break;
            case 4: add(~0ull, 32 * M1, 1); add(WS_XB, 32 * M1, 0); add(WS_SSQ, 512 * 1024, 1); break;
            case 5: add(WS_SCORES, 64 * M1, 1); break;
            case 6: add(WS_IDX, 4 * M1, 2); add(WS_GW, 4 * M1, 1); break;
            default: break;
        }
        d.cnt = c;
        if (c) hipLaunchKernelGGL(dbg_dump, dim3(2048), dim3(256), 0, stream, d);
    }
#endif
}
```

```cpp
#include <hip/hip_runtime.h>
#include <hip/hip_cooperative_groups.h>
#include <cstdio>
#include <cstdint>
#include <type_traits>
namespace cg = cooperative_groups;

#ifndef DBG
#define DBG 0
#endif
#define ATT_AHEAD 4
namespace pg8 {
#define PG8_LAS __attribute__((address_space(3)))
typedef unsigned short bf16_t;
typedef short bf16x8 __attribute__((ext_vector_type(8)));
typedef float f32x4 __attribute__((ext_vector_type(4)));
typedef unsigned u32x4 __attribute__((ext_vector_type(4)));
constexpr int BM = 256, BK = 64, HALF = 128, HTB = HALF * BK * 2  , STAGE_BYTES = 8 * HTB, NXCD = 8, WGM = 8;

__host__ __device__ __forceinline__ int lds_byte(int r, int c) { const int st = (r >> 4) * 2 + (c >> 5), rr = r & 15, cc = c & 31, ob = rr * 64 + cc * 2; return st * 1024 + (ob ^ (((ob >> 9) & 1) << 5)); }
__host__ __device__ __forceinline__ void stage_rc(int b, int& R, int& C) { const int st = b / 1024, sb = b % 1024, swz = sb ^ (((sb >> 9) & 1) << 5); R = (st >> 1) * 16 + swz / 64; C = (st & 1) * 32 + (swz % 64) / 2; }
__host__ __device__ __forceinline__ int perm32(int rho) { const int n = rho >> 4, i = rho & 15; return 8 * (i >> 2) + 4 * n + (i & 3); }

struct Unit { int pm, pn; };
struct Gemm { const bf16_t* A; const bf16_t* Bt; int M, N, K; };

struct StaticOrder {
    int nM, nN, nwg, G, c;
    __host__ __device__ void init(int M, int N, int G_, int c_) { nM = M / BM; nN = N / BM; nwg = nM * nN; G = G_; c = c_; }
    __host__ __device__ bool next(int i, Unit& u) const {
        const long L = (long)i * G + c; if (L >= nwg) return false;
        int wgid = (int)L; { const int q = nwg / NXCD, r = nwg % NXCD, xcd = wgid % NXCD, off = wgid / NXCD; wgid = (xcd < r ? xcd * (q + 1) : r * (q + 1) + (xcd - r) * q) + off; }
        const int nig = WGM * nN, gid = wgid / nig, fm = gid * WGM, gsz = (nM - fm) < WGM ? (nM - fm) : WGM;
        u.pm = fm + ((wgid % nig) % gsz); u.pn = (wgid % nig) / gsz; return true;
    }
    __device__ __forceinline__ void a_ready(const Unit&) const {}
    __device__ __forceinline__ void done(const Unit&) const {}
};

__device__ __forceinline__ unsigned cvt_pk_bf16(float lo, float hi) { unsigned r; asm volatile("v_cvt_pk_bf16_f32 %0, %1, %2" : "=v"(r) : "v"(lo), "v"(hi)); return r; }
typedef float f32x2 __attribute__((ext_vector_type(2)));
__device__ __forceinline__ f32x2 gelu_pk(f32x2 v) {
    const f32x2 av = __builtin_elementwise_abs(v), d = av * 0.2316418882f + 1.0f;
    f32x2 t; t.x = __builtin_amdgcn_rcpf(d.x); t.y = __builtin_amdgcn_rcpf(d.y);
    f32x2 q = t * 0.5307027145f + (-0.7265760135f); q = q * t + 0.7107068705f; q = q * t + (-0.142248368f); q = q * t + 0.127414796f; q = q * t;
    const f32x2 s = (v * v) * (-0.72134752044f);
    f32x2 e; e.x = __builtin_amdgcn_exp2f(s.x); e.y = __builtin_amdgcn_exp2f(s.y);
    const f32x2 m = v * (q * e), r = v - m;
    f32x2 o; o.x = v.x < 0.f ? m.x : r.x; o.y = v.y < 0.f ? m.y : r.y; return o;
}

typedef int i32x4 __attribute__((ext_vector_type(4)));
template <class Epi, class Sched, bool ALIGN_EPI = false, bool SP2 = false>
__device__ __forceinline__ void gemm_phase(PG8_LAS unsigned char* lds, const Gemm g, const Sched& S, const Epi& E) {
    int tid_ = threadIdx.x; asm volatile("" : "+v"(tid_));
    const int tid = tid_, wid = __builtin_amdgcn_readfirstlane(tid >> 6), lane = tid & 63, wr = wid >> 2, wc = wid & 3, fr = lane & 15, fq = lane >> 4;
    const int K = g.K, nt = K / BK;
    unsigned voffA[2], voffB[2];
#pragma unroll
    for (int i = 0; i < 2; ++i) { int R, C; stage_rc(tid * 16 + i * 8192, R, C); const int Rb = Epi::PERM ? ((R & ~31) + perm32(R & 31)) : R;
        voffA[i] = (unsigned)(R * K + C) * 2u; voffB[i] = (unsigned)(Rb * K + C) * 2u; }
    const size_t kstep = (size_t)(BK * 2);
    const size_t hstep = (size_t)HALF * K * 2;
    const size_t tstep = 2 * hstep;
    const unsigned ldsw = (unsigned)wid * 1024u;
    const int aoff = lds_byte(wr * 64 + fr, fq * 8), boff = lds_byte(wc * 32 + fr, fq * 8);
#define PG8_SA(b, h) (((b) * 2 + (h)) * HTB)
#define PG8_SB(b, h) ((4 + (b) * 2 + (h)) * HTB)
#define PG8_STAGE(bufoff, gbase, voff) do { _Pragma("unroll") for (int _i = 0; _i < 2; ++_i) \
        __builtin_amdgcn_global_load_lds((const unsigned*)((const char*)(gbase) + (voff)[_i]), (PG8_LAS unsigned*)(lds + (bufoff) + ldsw + _i * 8192), 16, 0, 0); } while (0)
#define PG8_LDA(dst, b, h) do { _Pragma("unroll") for (int m = 0; m < 4; ++m) _Pragma("unroll") for (int k = 0; k < 2; ++k) dst[m][k] = *(const PG8_LAS bf16x8*)(lds + PG8_SA(b, h) + aoff + m * 2048 + k * 1024); } while (0)
#define PG8_LDB(dst, b, h) do { _Pragma("unroll") for (int n = 0; n < 2; ++n) _Pragma("unroll") for (int k = 0; k < 2; ++k) dst[n][k] = *(const PG8_LAS bf16x8*)(lds + PG8_SB(b, h) + boff + n * 2048 + k * 1024); } while (0)
#define PG8_MMA(ai, bj, At, Bt) do { __builtin_amdgcn_s_setprio(1); _Pragma("unroll") for (int m = 0; m < 4; ++m) _Pragma("unroll") for (int n = 0; n < 2; ++n) _Pragma("unroll") for (int k = 0; k < 2; ++k) \
        { if constexpr (Epi::I8) acc[ai][bj][m][n] = __builtin_amdgcn_mfma_i32_16x16x64_i8(__builtin_bit_cast(i32x4, Bt[n][k]), __builtin_bit_cast(i32x4, At[m][k]), acc[ai][bj][m][n], 0, 0, 0); \
          else acc[ai][bj][m][n] = __builtin_amdgcn_mfma_f32_16x16x32_bf16(Bt[n][k], At[m][k], acc[ai][bj][m][n], 0, 0, 0); } __builtin_amdgcn_s_setprio(0); } while (0)
#define PG8_WAIT_V(n) asm volatile("s_waitcnt vmcnt(" #n ")" ::: "memory")
#define PG8_WAIT_L(n) asm volatile("s_waitcnt lgkmcnt(" #n ")" ::: "memory")
#define PG8_BAR __builtin_amdgcn_s_barrier()
#define PG8_SCHED __builtin_amdgcn_sched_barrier(0)
    Unit cur, nxt; int ui = 0;
    if (!S.next(0, cur)) return;
    typedef typename std::conditional<Epi::I8, i32x4, f32x4>::type acc_t;
    acc_t acc[2][2][4][2];
#pragma unroll
    for (int a = 0; a < 2; ++a)
#pragma unroll
        for (int b = 0; b < 2; ++b)
#pragma unroll
            for (int m = 0; m < 4; ++m)
#pragma unroll
                for (int n = 0; n < 2; ++n) acc[a][b][m][n] = (acc_t){0, 0, 0, 0};
    bf16x8 At[4][2], B0[2][2], B1[2][2];
    const char* cA = (const char*)g.A + (size_t)cur.pm * tstep; const char* cB = (const char*)g.Bt + (size_t)cur.pn * tstep;
    S.a_ready(cur);
    if constexpr (SP2) {
        PG8_STAGE(PG8_SB(0, 0), cB, voffB); PG8_STAGE(PG8_SB(0, 1), cB + hstep, voffB); PG8_STAGE(PG8_SA(0, 0), cA, voffA); PG8_STAGE(PG8_SA(0, 1), cA + hstep, voffA);
        if (wr == 1) PG8_BAR;
        PG8_WAIT_V(2); PG8_BAR;
        PG8_STAGE(PG8_SB(1, 0), cB + kstep, voffB); PG8_STAGE(PG8_SA(1, 0), cA + kstep, voffA); PG8_STAGE(PG8_SB(1, 1), cB + hstep + kstep, voffB);
        PG8_WAIT_V(6); PG8_BAR;
    } else {
        PG8_STAGE(PG8_SB(0, 0), cB, voffB); PG8_STAGE(PG8_SA(0, 0), cA, voffA); PG8_STAGE(PG8_SB(0, 1), cB + hstep, voffB); PG8_STAGE(PG8_SA(0, 1), cA + hstep, voffA);
        if (wr == 1) PG8_BAR;
        PG8_WAIT_V(4); PG8_BAR;
        PG8_STAGE(PG8_SB(1, 0), cB + kstep, voffB); PG8_STAGE(PG8_SA(1, 0), cA + kstep, voffA); PG8_STAGE(PG8_SB(1, 1), cB + hstep + kstep, voffB);
        PG8_WAIT_V(6); PG8_BAR;
    }
    for (;;) {
        const bool has_next = S.next(ui + 1, nxt);
        const char* nA = has_next ? (const char*)g.A + (size_t)nxt.pm * tstep : cA; const char* nB = has_next ? (const char*)g.Bt + (size_t)nxt.pn * tstep : cB;
        for (int t = 0; t < nt; t += 2) {
            const bool last = (t == nt - 2);
            const char* a1 = cA + (size_t)(t + 1) * kstep;
            const char* a2 = last ? nA : cA + (size_t)(t + 2) * kstep; const char* b2 = last ? nB : cB + (size_t)(t + 2) * kstep;
            const char* a3 = a2 + kstep; const char* b3 = b2 + kstep;
            if (last && has_next) S.a_ready(nxt);
            if constexpr (SP2) {
            PG8_LDB(B0, 0, 0); PG8_LDB(B1, 0, 1); PG8_SCHED; PG8_LDA(At, 0, 0); PG8_STAGE(PG8_SA(1, 1), a1 + hstep, voffA);
            PG8_WAIT_V(8); PG8_WAIT_L(0); PG8_BAR; PG8_MMA(0, 0, At, B0); PG8_MMA(0, 1, At, B1); PG8_BAR; PG8_SCHED;
            PG8_LDA(At, 0, 1); PG8_STAGE(PG8_SB(0, 0), b2, voffB); PG8_STAGE(PG8_SB(0, 1), b2 + hstep, voffB); PG8_STAGE(PG8_SA(0, 0), a2, voffA);
            PG8_WAIT_V(8); PG8_WAIT_L(0); PG8_BAR; PG8_MMA(1, 0, At, B0); PG8_MMA(1, 1, At, B1); PG8_BAR; PG8_SCHED;
            PG8_LDB(B0, 1, 0); PG8_LDB(B1, 1, 1); PG8_SCHED; PG8_LDA(At, 1, 0); PG8_STAGE(PG8_SA(0, 1), a2 + hstep, voffA);
            PG8_WAIT_V(8); PG8_WAIT_L(0); PG8_BAR; PG8_MMA(0, 0, At, B0); PG8_MMA(0, 1, At, B1); PG8_BAR; PG8_SCHED;
            PG8_LDA(At, 1, 1); PG8_STAGE(PG8_SB(1, 0), b3, voffB); PG8_STAGE(PG8_SB(1, 1), b3 + hstep, voffB); PG8_STAGE(PG8_SA(1, 0), a3, voffA);
            PG8_WAIT_V(8); PG8_WAIT_L(0); PG8_BAR; PG8_MMA(1, 0, At, B0); PG8_MMA(1, 1, At, B1); PG8_BAR; PG8_SCHED;
            } else {
            PG8_LDB(B0, 0, 0); PG8_SCHED; PG8_LDA(At, 0, 0); PG8_STAGE(PG8_SA(1, 1), a1 + hstep, voffA);
            PG8_WAIT_L(8); PG8_BAR; PG8_WAIT_L(0); PG8_MMA(0, 0, At, B0); PG8_BAR; PG8_SCHED;
            PG8_LDB(B1, 0, 1); PG8_STAGE(PG8_SB(0, 0), b2, voffB);
            PG8_BAR; PG8_WAIT_L(0); PG8_MMA(0, 1, At, B1); PG8_BAR;
            PG8_LDA(At, 0, 1); PG8_STAGE(PG8_SA(0, 0), a2, voffA);
            PG8_BAR; PG8_WAIT_L(0); PG8_MMA(1, 0, At, B0); PG8_BAR; PG8_SCHED;
            PG8_STAGE(PG8_SB(0, 1), b2 + hstep, voffB);
            PG8_WAIT_V(6); PG8_BAR; PG8_MMA(1, 1, At, B1); PG8_BAR;
            PG8_LDB(B0, 1, 0); PG8_SCHED; PG8_LDA(At, 1, 0); PG8_STAGE(PG8_SA(0, 1), a2 + hstep, voffA);
            PG8_WAIT_L(8); PG8_BAR; PG8_WAIT_L(0); PG8_MMA(0, 0, At, B0); PG8_BAR; PG8_SCHED;
            PG8_LDB(B1, 1, 1); PG8_STAGE(PG8_SB(1, 0), b3, voffB);
            PG8_BAR; PG8_WAIT_L(0); PG8_MMA(0, 1, At, B1); PG8_BAR;
            PG8_LDA(At, 1, 1); PG8_STAGE(PG8_SA(1, 0), a3, voffA);
            PG8_BAR; PG8_WAIT_L(0); PG8_MMA(1, 0, At, B0); PG8_BAR; PG8_SCHED;
            PG8_STAGE(PG8_SB(1, 1), b3 + hstep, voffB);
            PG8_WAIT_V(6); PG8_BAR; PG8_MMA(1, 1, At, B1); PG8_BAR;
            }
        }
        if constexpr (ALIGN_EPI) { if (wr == 0) PG8_BAR; }
        if constexpr (!Epi::AFTER_DRAIN) { E(acc, cur, wr, wc, fr, fq); S.done(cur); }
        if (!has_next) break;
#pragma unroll
        for (int a = 0; a < 2; ++a)
#pragma unroll
            for (int b = 0; b < 2; ++b)
#pragma unroll
                for (int m = 0; m < 4; ++m)
#pragma unroll
                    for (int n = 0; n < 2; ++n) acc[a][b][m][n] = (acc_t){0, 0, 0, 0};
        cur = nxt; cA = nA; cB = nB; ++ui;
        if constexpr (ALIGN_EPI) { if (wr == 1) PG8_BAR; }
    }
    PG8_WAIT_V(0);
    if constexpr (!ALIGN_EPI) { if (wr == 0) PG8_BAR; }
    PG8_BAR;
    if constexpr (Epi::AFTER_DRAIN) { E.fused(acc, cur, wr, wc, fr, fq, lds, wid, lane); S.done(cur); }
#undef PG8_SA
#undef PG8_SB
#undef PG8_STAGE
#undef PG8_LDA
#undef PG8_LDB
#undef PG8_MMA
#undef PG8_WAIT_V
#undef PG8_WAIT_L
#undef PG8_BAR
#undef PG8_SCHED
}
}
constexpr int NB = 4, SEQ = 8192, DM = 1024, T = NB * SEQ;
constexpr int HW = 512;
constexpr int N1 = 4608;
constexpr int NEXP = 16384, PK_TOP = 16, PK_HEADS = 8;
constexpr float EPS = 1e-6f;
constexpr float QSCALE = 0.125f * 1.4426950408889634f;
constexpr float LAMBDA_INIT = 0.2f;

constexpr size_t MiB = 1u << 20;
constexpr size_t WS_CTL = 0, CTL_ZERO_BYTES = 65536;
constexpr int CW_BAR = 1024;
constexpr size_t WS_W1T = 2 * MiB;
constexpr size_t WS_WAB = 11 * MiB;
constexpr size_t WS_WO2 = 13 * MiB;
constexpr size_t WS_WEF = 17 * MiB;
constexpr size_t WS_ROPE = 21 * MiB;
constexpr size_t WS_WSM = 23 * MiB;
constexpr size_t WS_MISC = 23 * MiB + 512 * 1024;
constexpr size_t WS_UQ = 24 * MiB;
constexpr size_t WS_VQ = 40 * MiB;
constexpr size_t WS_SUQ = 56 * MiB;
constexpr size_t WS_XB = 88 * MiB;
constexpr size_t WS_W1Q = 58 * MiB;
constexpr size_t WS_XS = 63 * MiB;
constexpr size_t WS_WSC = 63 * MiB + 256 * 1024;
constexpr int CW_CMAX = 8192;
constexpr size_t WS_Q = 152 * MiB;
constexpr size_t WS_SU = 184 * MiB;
constexpr size_t WS_GATES = 216 * MiB;
constexpr size_t WS_K = 344 * MiB;
constexpr size_t WS_V = 376 * MiB;
constexpr size_t WS_SV = 408 * MiB;
constexpr size_t WS_G = 344 * MiB;
constexpr size_t WS_SCORES = 152 * MiB;
constexpr size_t WS_SSQ = 472 * MiB;
constexpr size_t WS_IDX = 474 * MiB;
constexpr size_t WS_GW = 490 * MiB;
constexpr size_t WS_PART = 152 * MiB;
constexpr size_t WS_COEF = 280 * MiB;
constexpr size_t WS_X1Q = 408 * MiB;
constexpr size_t WS_X1S = 440 * MiB;
constexpr size_t WS_IDX16 = 444 * MiB;
constexpr size_t WS_YB = 216 * MiB;
constexpr size_t WS_SSQ2 = 296 * MiB;
constexpr size_t WS_END = 506 * MiB;
static_assert(WS_SCORES + (size_t)T * 2048 * 4 <= WS_SSQ && WS_G + (size_t)T * 2048 * 2 <= WS_SSQ, "ws map");

constexpr int RING_BYTES = 131072;
constexpr int BAR_LDS_OFF = 147456 - 64;
constexpr int LDS_BYTES = 147456;
constexpr int NWAVES = 8;

#define GAS __attribute__((address_space(1)))
#define LAS __attribute__((address_space(3)))
typedef unsigned short bf16;
typedef unsigned v4u __attribute__((ext_vector_type(4)));
typedef unsigned v2u __attribute__((ext_vector_type(2)));
typedef float f32x4 __attribute__((ext_vector_type(4)));
typedef float f32x2 __attribute__((ext_vector_type(2)));
typedef float f32x16 __attribute__((ext_vector_type(16)));
typedef short bf16x8 __attribute__((ext_vector_type(8)));
typedef short s16x4 __attribute__((ext_vector_type(4)));
#define LDS_WAIT() asm volatile("s_waitcnt lgkmcnt(0)" ::: "memory")
#define VM_WAIT() asm volatile("s_waitcnt vmcnt(0)" ::: "memory")
#define CFENCE() asm volatile("" ::: "memory")
__device__ __forceinline__ unsigned f2bf(float f) { unsigned u = __builtin_bit_cast(unsigned, f); return (u + 0x7fffu + ((u >> 16) & 1u)) >> 16; }
__device__ __forceinline__ unsigned pk2(float lo, float hi) { return f2bf(lo) | (f2bf(hi) << 16); }
typedef __bf16 bf16x2_t __attribute__((ext_vector_type(2)));
__device__ __forceinline__ unsigned cvtpk(float lo, float hi) { const f32x2 v = {lo, hi}; const bf16x2_t b = __builtin_convertvector(v, bf16x2_t); return __builtin_bit_cast(unsigned, b); }
__device__ __forceinline__ float bf_lo(unsigned w) { return __builtin_bit_cast(float, w << 16); }
__device__ __forceinline__ float bf_hi(unsigned w) { return __builtin_bit_cast(float, w & 0xffff0000u); }
__device__ __forceinline__ float bf2f(bf16 b) { return __builtin_bit_cast(float, (unsigned)b << 16); }
__device__ __forceinline__ float wave_sum(float v) {
#pragma unroll
    for (int o = 1; o < 64; o <<= 1) v += __shfl_xor(v, o);
    return v;
}
__device__ __forceinline__ float gelu1(float v) {
    const float av = __builtin_fabsf(v), t = __builtin_amdgcn_rcpf(av * 0.2316418882f + 1.0f);
    float q = t * 0.5307027145f + (-0.7265760135f); q = q * t + 0.7107068705f; q = q * t + (-0.142248368f); q = q * t + 0.127414796f; q = q * t;
    const float e = __builtin_amdgcn_exp2f((v * v) * (-0.72134752044f));
    const float m = v * (q * e);
    return v < 0.f ? m : v - m;
}

struct Frame {
    LAS unsigned char* lds;
    int tid, lane, wave, vcu, G;
    const float* in[23]; float* out; unsigned char* ws;
};

__device__ __forceinline__ int rowmap_fn(int n, int rowmode, int row_off) {
    if (rowmode == 1 && n < 1024) return (n & ~63) | (2 * (n & 31) + ((n >> 5) & 1));
    return row_off + n;
}
__device__ __forceinline__ void p0_transpose_item(const float* W, int N, bf16* WT, int ldt, int koff, int rowmode, int row_off, LAS float* scr, int item, int lane, unsigned* cmax = nullptr) {
    const int nblk = N / 32, kb = item / nblk, nb = item % nblk, k0 = 64 * kb, n0 = 32 * nb;
#pragma unroll 8
    for (int i = 0; i < 32; ++i) { const int kk = 2 * i + (lane >> 5); scr[kk * 33 + (lane & 31)] = W[(size_t)(k0 + kk) * N + n0 + (lane & 31)]; }
    LDS_WAIT(); CFENCE();
    const int c = lane & 7;
#pragma unroll
    for (int j = 0; j < 4; ++j) { const int n = (lane >> 3) + 8 * j; const LAS float* s = scr + (8 * c) * 33 + n;
        v4u o; o.x = pk2(s[0 * 33], s[1 * 33]); o.y = pk2(s[2 * 33], s[3 * 33]); o.z = pk2(s[4 * 33], s[5 * 33]); o.w = pk2(s[6 * 33], s[7 * 33]);
        *(v4u*)(WT + (size_t)rowmap_fn(n0 + n, rowmode, row_off) * ldt + koff + k0 + 8 * c) = o;
        if (cmax) { float am = 0.f;
#pragma unroll
            for (int q = 0; q < 4; ++q) { const unsigned w = q == 0 ? o.x : q == 1 ? o.y : q == 2 ? o.z : o.w; am = fmaxf(am, fmaxf(fabsf(bf_lo(w)), fabsf(bf_hi(w)))); }
            int iv = __builtin_bit_cast(int, am);
            iv = max(iv, __builtin_amdgcn_mov_dpp(iv, 0xB1, 0xF, 0xF, true)); iv = max(iv, __builtin_amdgcn_mov_dpp(iv, 0x4E, 0xF, 0xF, true)); iv = max(iv, __builtin_amdgcn_mov_dpp(iv, 0x141, 0xF, 0xF, true));
            if (c == 0) atomicMax(cmax + rowmap_fn(n0 + n, rowmode, row_off), (unsigned)iv); } }
    LDS_WAIT(); CFENCE();
}

__device__ __forceinline__ void table_row_store(unsigned char* ws, const f32x4 (&v)[4], bool isu, int e, int lane) {
    float am = 0.f;
#pragma unroll
    for (int j = 0; j < 4; ++j) am = fmaxf(am, fmaxf(fmaxf(fabsf(v[j][0]), fabsf(v[j][1])), fmaxf(fabsf(v[j][2]), fabsf(v[j][3]))));
    { int iv = __builtin_bit_cast(int, am);
      iv = max(iv, __builtin_amdgcn_mov_dpp(iv, 0xB1, 0xF, 0xF, true)); iv = max(iv, __builtin_amdgcn_mov_dpp(iv, 0x4E, 0xF, 0xF, true));
      iv = max(iv, __builtin_amdgcn_mov_dpp(iv, 0x141, 0xF, 0xF, true)); iv = max(iv, __builtin_amdgcn_mov_dpp(iv, 0x140, 0xF, 0xF, true));
      iv = max(max(__builtin_amdgcn_readlane(iv, 0), __builtin_amdgcn_readlane(iv, 16)), max(__builtin_amdgcn_readlane(iv, 32), __builtin_amdgcn_readlane(iv, 48)));
      am = __builtin_bit_cast(float, iv); }
    v4u q;
    if (isu) {
        const float sc = am > 0.f ? 127.0f / am : 0.f;
        unsigned wq[4];
#pragma unroll
        for (int j = 0; j < 4; ++j) wq[j] = ((unsigned)__float2int_rn(v[j][0] * sc) & 0xffu) | (((unsigned)__float2int_rn(v[j][1] * sc) & 0xffu) << 8) | (((unsigned)__float2int_rn(v[j][2] * sc) & 0xffu) << 16) | (((unsigned)__float2int_rn(v[j][3] * sc) & 0xffu) << 24);
        q = (v4u){wq[0], wq[1], wq[2], wq[3]};
    } else {
        const float sc = am > 0.f ? 224.0f / am : 0.f;
        { int w = 0; w = __builtin_amdgcn_cvt_pk_fp8_f32(v[0][0] * sc, v[0][1] * sc, w, false); w = __builtin_amdgcn_cvt_pk_fp8_f32(v[0][2] * sc, v[0][3] * sc, w, true); q.x = (unsigned)w; }
        { int w = 0; w = __builtin_amdgcn_cvt_pk_fp8_f32(v[1][0] * sc, v[1][1] * sc, w, false); w = __builtin_amdgcn_cvt_pk_fp8_f32(v[1][2] * sc, v[1][3] * sc, w, true); q.y = (unsigned)w; }
        { int w = 0; w = __builtin_amdgcn_cvt_pk_fp8_f32(v[2][0] * sc, v[2][1] * sc, w, false); w = __builtin_amdgcn_cvt_pk_fp8_f32(v[2][2] * sc, v[2][3] * sc, w, true); q.z = (unsigned)w; }
        { int w = 0; w = __builtin_amdgcn_cvt_pk_fp8_f32(v[3][0] * sc, v[3][1] * sc, w, false); w = __builtin_amdgcn_cvt_pk_fp8_f32(v[3][2] * sc, v[3][3] * sc, w, true); q.w = (unsigned)w; }
    }
    *(v4u*)(ws + (isu ? WS_UQ : WS_VQ) + (size_t)(lane >> 3) * (NEXP * 128) + (size_t)e * 128 + 16 * (lane & 7)) = q;
    if (lane == 0) ((float*)(ws + WS_SUQ))[2 * e + (isu ? 0 : 1)] = am * (isu ? (1.0f / 127.0f) : (1.0f / 224.0f));
}

__device__ __forceinline__ void p0_prologue(Frame& F) {
    unsigned char* ws = F.ws;
    const int gw = F.vcu * NWAVES + F.wave, NGW = F.G * NWAVES;
    const int gt = F.vcu * (NWAVES * 64) + F.tid, NGT = F.G * NWAVES * 64;
    {
        LAS float* scr = (LAS float*)(F.lds + F.wave * 16384);
        bf16* W1T = (bf16*)(ws + WS_W1T); bf16* WAB = (bf16*)(ws + WS_WAB); bf16* WO2 = (bf16*)(ws + WS_WO2);
        constexpr int I_IN = 16 * 80, I_GT = 16 * 64, I_A = 8 * 32, I_B = 8 * 32, I_O = 16 * 32;
        constexpr int NIT = I_IN + I_GT + I_A + I_B + I_O;
        for (int it = gw; it < NIT; it += NGW) {
            int r = it;
            if (r < I_IN) { p0_transpose_item(F.in[2], 2560, W1T, 1024, 0, 1, 0, scr, r, F.lane, (unsigned*)(ws + WS_CTL) + CW_CMAX); continue; } r -= I_IN;
            if (r < I_GT) { p0_transpose_item(F.in[14], 2048, W1T, 1024, 0, 0, 2560, scr, r, F.lane, (unsigned*)(ws + WS_CTL) + CW_CMAX); continue; } r -= I_GT;
            if (r < I_A) { p0_transpose_item(F.in[12], 1024, WAB, 512, 0, 0, 0, scr, r, F.lane); continue; } r -= I_A;
            if (r < I_B) { p0_transpose_item(F.in[13], 1024, WAB, 512, 0, 0, 1024, scr, r, F.lane); continue; } r -= I_B;
            p0_transpose_item(F.in[16], 1024, WO2, 1024, 0, 0, 0, scr, r, F.lane);
        }
    }
    __syncthreads();
    {
        const float* wq = F.in[18]; const float* keys = F.in[19]; const float* g2 = F.in[17];
        bf16* WEF = (bf16*)(ws + WS_WEF);
        const int r32 = F.lane & 31, hi = F.lane >> 5;
        for (int task = gw; task < 16 * 4 * 32; task += NGW) {
            const int hp = task >> 7, k0 = ((task >> 5) & 3) * 32, d0 = (task & 31) * 32;
            const float* ap = keys + (size_t)(hp * 128 + k0 + r32) * 128 + 8 * hi;
            const float* bp = wq + (size_t)(d0 + r32) * 2048 + hp * 128 + 8 * hi;
            f32x16 acc = (f32x16){};
#pragma unroll 1
            for (int half = 0; half < 2; ++half) {
                f32x4 av[8], bv[8];
#pragma unroll
                for (int s = 0; s < 4; ++s) { av[2 * s] = *(const f32x4*)(ap + 16 * (4 * half + s)); av[2 * s + 1] = *(const f32x4*)(ap + 16 * (4 * half + s) + 4);
                    bv[2 * s] = *(const f32x4*)(bp + 16 * (4 * half + s)); bv[2 * s + 1] = *(const f32x4*)(bp + 16 * (4 * half + s) + 4); }
#pragma unroll
                for (int s = 0; s < 4; ++s) {
                    unsigned ah[4], al[4], bh[4], bl[4];
#pragma unroll
                    for (int q = 0; q < 4; ++q) { const f32x4 a4 = av[2 * s + (q >> 1)], b4 = bv[2 * s + (q >> 1)]; const int e = (q & 1) * 2;
                        const unsigned ha = cvtpk(a4[e], a4[e + 1]), hb = cvtpk(b4[e], b4[e + 1]);
                        ah[q] = ha; bh[q] = hb;
                        al[q] = cvtpk(a4[e] - bf_lo(ha), a4[e + 1] - bf_hi(ha)); bl[q] = cvtpk(b4[e] - bf_lo(hb), b4[e + 1] - bf_hi(hb)); }
                    const bf16x8 Ah = __builtin_bit_cast(bf16x8, (v4u){ah[0], ah[1], ah[2], ah[3]}), Al = __builtin_bit_cast(bf16x8, (v4u){al[0], al[1], al[2], al[3]});
                    const bf16x8 Bh = __builtin_bit_cast(bf16x8, (v4u){bh[0], bh[1], bh[2], bh[3]}), Bl = __builtin_bit_cast(bf16x8, (v4u){bl[0], bl[1], bl[2], bl[3]});
                    acc = __builtin_amdgcn_mfma_f32_32x32x16_bf16(Ah, Bh, acc, 0, 0, 0);
                    acc = __builtin_amdgcn_mfma_f32_32x32x16_bf16(Ah, Bl, acc, 0, 0, 0);
                    acc = __builtin_amdgcn_mfma_f32_32x32x16_bf16(Al, Bh, acc, 0, 0, 0);
                }
            }
            const float gd = g2[d0 + r32];
#pragma unroll
            for (int r = 0; r < 16; ++r) { const int k = k0 + (r & 3) + 8 * (r >> 2) + 4 * hi;
                WEF[(size_t)(hp * 128 + k) * 1024 + d0 + r32] = (bf16)f2bf(acc[r] * gd); }
        }
    }
    {
        const float* x = F.in[0]; const float* g1 = F.in[1]; unsigned char* A8 = ws + WS_XB; float* XS = (float*)(ws + WS_XS);
        f32x4 gv[4];
#pragma unroll
        for (int j = 0; j < 4; ++j) gv[j] = *((const f32x4*)g1 + F.lane + 64 * j);
        for (int m = gw; m < T; m += NGW) {
            const f32x4* xr = (const f32x4*)(x + (size_t)m * DM) + F.lane;
            f32x4 v[4]; float s = 0.f, am = 0.f;
#pragma unroll
            for (int j = 0; j < 4; ++j) { v[j] = xr[64 * j]; s += (v[j].x * v[j].x + v[j].y * v[j].y) + (v[j].z * v[j].z + v[j].w * v[j].w); }
            const float rstd = 1.0f / sqrtf(wave_sum(s) * (1.f / DM) + EPS);
#pragma unroll
            for (int j = 0; j < 4; ++j) { v[j] = v[j] * rstd * gv[j]; am = fmaxf(am, fmaxf(fmaxf(fabsf(v[j].x), fabsf(v[j].y)), fmaxf(fabsf(v[j].z), fabsf(v[j].w)))); }
            { int iv = __builtin_bit_cast(int, am);
              iv = max(iv, __builtin_amdgcn_mov_dpp(iv, 0xB1, 0xF, 0xF, true)); iv = max(iv, __builtin_amdgcn_mov_dpp(iv, 0x4E, 0xF, 0xF, true));
              iv = max(iv, __builtin_amdgcn_mov_dpp(iv, 0x141, 0xF, 0xF, true)); iv = max(iv, __builtin_amdgcn_mov_dpp(iv, 0x140, 0xF, 0xF, true));
              iv = max(max(__builtin_amdgcn_readlane(iv, 0), __builtin_amdgcn_readlane(iv, 16)), max(__builtin_amdgcn_readlane(iv, 32), __builtin_amdgcn_readlane(iv, 48)));
              am = __builtin_bit_cast(float, iv); }
            const float sc = am > 0.f ? 127.0f / am : 0.f;
            unsigned* o4 = (unsigned*)(A8 + (size_t)m * DM) + F.lane;
#pragma unroll
            for (int j = 0; j < 4; ++j) o4[64 * j] = ((unsigned)__float2int_rn(v[j].x * sc) & 0xffu) | (((unsigned)__float2int_rn(v[j].y * sc) & 0xffu) << 8) | (((unsigned)__float2int_rn(v[j].z * sc) & 0xffu) << 16) | (((unsigned)__float2int_rn(v[j].w * sc) & 0xffu) << 24);
            if (F.lane == 0) XS[m] = am * (1.0f / 127.0f);
        }
    }
    {
        float* rope = (float*)(ws + WS_ROPE);
        for (int i = gt; i < SEQ * 32; i += NGT) {
            const int pos = i >> 5, j = i & 31;
            const float inv = 1.0f / powf(10000.0f, (float)(2 * j) * (1.0f / 64.0f));
            const float ang = (float)pos * inv;
            double rv = (double)ang * 0.15915494309189535; rv -= floor(rv);
            const float fr = (float)rv; const float sn = __builtin_amdgcn_sinf(fr), cs = __builtin_amdgcn_cosf(fr);
            *(f32x2*)(rope + 2 * (size_t)i) = (f32x2){cs, sn};
        }
        const float* wsp = F.in[10]; bf16* WSM = (bf16*)(ws + WS_WSM);
        for (int i = gt; i < 4 * 128 * 128; i += NGT) { const int ii = (i >> 7) & 127, jj = i & 127; WSM[i] = (bf16)f2bf(((jj >> 6) <= (ii >> 6)) ? wsp[i] : 0.f); }
        if (F.vcu == 0 && F.wave == 0) {
            const float p1 = F.in[3][F.lane] * F.in[4][F.lane], p2 = F.in[5][F.lane] * F.in[6][F.lane];
            const float s1 = wave_sum(p1), s2 = wave_sum(p2);
            if (F.lane == 0) ((float*)(ws + WS_MISC))[0] = expf(s1) - expf(s2) + LAMBDA_INIT;
        }
    }
}

__device__ __forceinline__ void p0b_quant_weights(Frame& F) {
    unsigned char* ws = F.ws;
    const int gw = F.vcu * NWAVES + F.wave, NGW = F.G * NWAVES;
    const unsigned* cmax = (const unsigned*)(ws + WS_CTL) + CW_CMAX; float* WSC = (float*)(ws + WS_WSC);
    for (int n = gw; n < N1; n += NGW) {
        const float am = __builtin_bit_cast(float, cmax[n]); const float sc = am > 0.f ? 127.0f / am : 0.f;
        const bf16* src = (const bf16*)(ws + WS_W1T) + (size_t)n * DM + 16 * F.lane;
        const v4u w0 = *(const v4u*)src, w1 = *(const v4u*)(src + 8);
        const float v[16] = {bf_lo(w0.x), bf_hi(w0.x), bf_lo(w0.y), bf_hi(w0.y), bf_lo(w0.z), bf_hi(w0.z), bf_lo(w0.w), bf_hi(w0.w), bf_lo(w1.x), bf_hi(w1.x), bf_lo(w1.y), bf_hi(w1.y), bf_lo(w1.z), bf_hi(w1.z), bf_lo(w1.w), bf_hi(w1.w)};
        unsigned wq[4];
#pragma unroll
        for (int j = 0; j < 4; ++j) wq[j] = ((unsigned)__float2int_rn(v[4 * j] * sc) & 0xffu) | (((unsigned)__float2int_rn(v[4 * j + 1] * sc) & 0xffu) << 8) | (((unsigned)__float2int_rn(v[4 * j + 2] * sc) & 0xffu) << 16) | (((unsigned)__float2int_rn(v[4 * j + 3] * sc) & 0xffu) << 24);
        *(v4u*)(ws + WS_W1Q + (size_t)n * DM + 16 * F.lane) = (v4u){wq[0], wq[1], wq[2], wq[3]};
        if (F.lane == 0) WSC[n] = am * (1.0f / 127.0f);
    }
}
#define XB_TMO      128
#define XB_XCNT(j)  (256  + 64 * (j))
#define XB_XSUB(j)  (1280 + 64 * (j))
#define XB_XGEN(j)  (2304 + 64 * (j))
#define XB_TOP      3328
#define XB_TOPGEN   3392
#define XCD_BAR_WORDS 3456
#define XB_SPIN_CAP (1u << 22)

__device__ __forceinline__ unsigned xb_ld(unsigned* p)              { return __hip_atomic_load(p, __ATOMIC_RELAXED, __HIP_MEMORY_SCOPE_AGENT); }
__device__ __forceinline__ unsigned xb_add(unsigned* p, unsigned v) { return __hip_atomic_fetch_add(p, v, __ATOMIC_RELAXED, __HIP_MEMORY_SCOPE_AGENT); }
__device__ __forceinline__ unsigned xb_xcc_id() { return (unsigned)__builtin_amdgcn_s_getreg((3 << 11) | 20) & 0xFu; }
#define XB_SPIN(cond, bar) do { unsigned _sp = 0; while (cond) { __builtin_amdgcn_s_sleep(1); \
    if ((++_sp & 255u) == 0u) { if (xb_ld(&(bar)[XB_TMO])) break; if (_sp > XB_SPIN_CAP) { atomicAdd(&(bar)[XB_TMO], 1u); break; } } } } while (0)

struct XcdBarrier {
    unsigned* bar; unsigned x;
    volatile LAS unsigned* st;
};

__device__ __forceinline__ XcdBarrier xcd_barrier_post(unsigned* bar, volatile LAS unsigned* st) {
    XcdBarrier b; b.bar = bar; b.x = xb_xcc_id(); b.st = st;
    if (threadIdx.x == 0) (void)xb_add(&bar[XB_XCNT(b.x)], 1u);
    return b;
}
__device__ __forceinline__ void xcd_barrier_complete(unsigned* bar, unsigned x, unsigned& nloc, unsigned& nx) {
    const unsigned G = gridDim.x * gridDim.y * gridDim.z;
    unsigned sum, cnt, mine, sp = 0u;
    for (;;) {
        sum = 0u; cnt = 0u; mine = 0u;
#pragma unroll
        for (unsigned j = 0; j < 16; ++j) { const unsigned c = xb_ld(&bar[XB_XCNT(j)]); sum += c; cnt += (c > 0u) ? 1u : 0u; mine = (j == x) ? c : mine; }
        if (sum == G) break;
        __builtin_amdgcn_s_sleep(1);
        if ((++sp & 255u) == 0u) { if (xb_ld(&bar[XB_TMO])) break; if (sp > XB_SPIN_CAP) { atomicAdd(&bar[XB_TMO], 1u); break; } }
    }
    nloc = mine > 0u ? mine : 1u; nx = cnt > 0u ? cnt : 1u;
}

__device__ __forceinline__ void xcd_barrier(const XcdBarrier& b) {
    asm volatile("s_waitcnt vmcnt(0)" ::: "memory");
    __syncthreads();
    if (threadIdx.x == 0) {
        unsigned* bar = b.bar;
        __builtin_amdgcn_s_waitcnt(0);
        unsigned nloc = b.st[0], nx = b.st[1];
        if (nloc == 0u) { xcd_barrier_complete(bar, b.x, nloc, nx); b.st[0] = nloc; b.st[1] = nx; }
        const unsigned old = xb_add(&bar[XB_XSUB(b.x)], 1u);
        const unsigned gen = old / nloc;
        if (old + 1u == (gen + 1u) * nloc) {
            __builtin_amdgcn_fence(__ATOMIC_RELEASE, "agent");
            asm volatile("s_waitcnt vmcnt(0)" ::: "memory");
            const unsigned og = xb_add(&bar[XB_TOP], 1u);
            const unsigned tg = og / nx;
            if (og + 1u == (tg + 1u) * nx) xb_add(&bar[XB_TOPGEN], 1u);
            else XB_SPIN(xb_ld(&bar[XB_TOPGEN]) == tg, bar);
            __builtin_amdgcn_fence(__ATOMIC_ACQUIRE, "agent");
            xb_add(&bar[XB_XGEN(b.x)], 1u);
            asm volatile("s_waitcnt vmcnt(0)" ::: "memory");
        } else {
            XB_SPIN(xb_ld(&bar[XB_XGEN(b.x)]) == gen, bar);
            __builtin_amdgcn_fence(__ATOMIC_ACQUIRE, "agent");
            asm volatile("s_waitcnt vmcnt(0)" ::: "memory");
        }
    }
    __syncthreads();
}
__device__ __forceinline__ v4u pack8(const f32x4 a, const f32x4 b) { v4u w; w.x = cvtpk(a[0], a[1]); w.y = cvtpk(a[2], a[3]); w.z = cvtpk(b[0], b[1]); w.w = cvtpk(b[2], b[3]); return w; }

struct EpiP1 {
    static constexpr bool PERM = true, AFTER_DRAIN = false, I8 = true;
    unsigned char* ws; const float* bgate; const float* rope; const float* xs; const float* wsc;
    __device__ __forceinline__ void operator()(const pg8::i32x4 (&acci)[2][2][4][2], const pg8::Unit& u, int wr, int wc, int fr, int fq) const {
        const int row0 = u.pm * 256 + wr * 64 + fr, pn = u.pn, ct = wc * 32 + 8 * fq;
        float rs[8]; f32x4 cs[2][2];
#pragma unroll
        for (int k = 0; k < 8; ++k) rs[k] = xs[row0 + (k >> 2) * 128 + (k & 3) * 16];
#pragma unroll
        for (int bj = 0; bj < 2; ++bj) { cs[bj][0] = *(const f32x4*)(wsc + pn * 256 + bj * 128 + ct); cs[bj][1] = *(const f32x4*)(wsc + pn * 256 + bj * 128 + ct + 4); }
        f32x4 acc[2][2][4][2];
#pragma unroll
        for (int ai = 0; ai < 2; ++ai)
#pragma unroll
            for (int bj = 0; bj < 2; ++bj)
#pragma unroll
                for (int m = 0; m < 4; ++m)
#pragma unroll
                    for (int n = 0; n < 2; ++n) { const pg8::i32x4 v = acci[ai][bj][m][n]; const float r = rs[4 * ai + m];
                        acc[ai][bj][m][n] = (f32x4){(float)v[0] * r * cs[bj][n][0], (float)v[1] * r * cs[bj][n][1], (float)v[2] * r * cs[bj][n][2], (float)v[3] * r * cs[bj][n][3]}; }
        if (pn < 4) {
            bf16* dst = (bf16*)(ws + (pn < 2 ? WS_Q : WS_K)); const float sc = pn < 2 ? QSCALE : 1.0f; const int cb = (pn & 1) * 256 + ct; const bool hm = pn >= 2;
#pragma unroll
            for (int ai = 0; ai < 2; ++ai)
#pragma unroll
                for (int m = 0; m < 4; ++m) { const int row = row0 + ai * 128 + m * 16, pos = row & (SEQ - 1);
#pragma unroll
                    for (int bj = 0; bj < 2; ++bj) { const int col = cb + bj * 128, i0 = (col & 63) >> 1;
                        const f32x4 r0 = *(const f32x4*)(rope + (size_t)(pos * 32 + i0) * 2), r1 = *(const f32x4*)(rope + (size_t)(pos * 32 + i0 + 2) * 2);
                        const f32x4 a = acc[ai][bj][m][0], b = acc[ai][bj][m][1]; f32x4 oa, ob;
                        oa[0] = (a[0] * r0[0] - a[1] * r0[1]) * sc; oa[1] = (a[0] * r0[1] + a[1] * r0[0]) * sc;
                        oa[2] = (a[2] * r0[2] - a[3] * r0[3]) * sc; oa[3] = (a[2] * r0[3] + a[3] * r0[2]) * sc;
                        ob[0] = (b[0] * r1[0] - b[1] * r1[1]) * sc; ob[1] = (b[0] * r1[1] + b[1] * r1[0]) * sc;
                        ob[2] = (b[2] * r1[2] - b[3] * r1[3]) * sc; ob[3] = (b[2] * r1[3] + b[3] * r1[2]) * sc;
                        const size_t off = hm ? ((size_t)(((row >> 13) * 4 + (col >> 7)) * SEQ + pos) * 128 + (col & 127)) : ((size_t)row * HW + col);
                        *(v4u*)(dst + off) = pack8(oa, ob); } }
        } else if (pn < 10) {
            bf16* dst = (bf16*)(ws + (pn < 6 ? WS_V : (pn < 8 ? WS_SU : WS_SV))); const bool act = pn >= 6; const int cb = (pn & 1) * 256 + ct;
#pragma unroll
            for (int ai = 0; ai < 2; ++ai)
#pragma unroll
                for (int m = 0; m < 4; ++m) { const int row = row0 + ai * 128 + m * 16;
#pragma unroll
                    for (int bj = 0; bj < 2; ++bj) { const int col = cb + bj * 128; f32x4 a = acc[ai][bj][m][0], b = acc[ai][bj][m][1];
                        if (act) {
#pragma unroll
                            for (int e = 0; e < 4; ++e) { a[e] = gelu1(a[e]); b[e] = gelu1(b[e]); } }
                        const size_t off = (pn < 6) ? ((size_t)(((row >> 13) * 4 + (col >> 7)) * SEQ + (row & (SEQ - 1))) * 128 + (col & 127)) : ((size_t)row * HW + col);
                        *(v4u*)(dst + off) = pack8(a, b); } }
        } else {
            const int cb = (pn - 10) * 256 + ct;
#pragma unroll
            for (int bj = 0; bj < 2; ++bj) { const int col = cb + bj * 128;
                const f32x4 b0 = *(const f32x4*)(bgate + col), b1 = *(const f32x4*)(bgate + col + 4);
#pragma unroll
                for (int ai = 0; ai < 2; ++ai)
#pragma unroll
                    for (int m = 0; m < 4; ++m) { const int row = row0 + ai * 128 + m * 16; f32x4 a = acc[ai][bj][m][0] + b0, b = acc[ai][bj][m][1] + b1;
#pragma unroll
                        for (int e = 0; e < 4; ++e) { a[e] = __builtin_amdgcn_rcpf(1.0f + __builtin_amdgcn_exp2f(a[e] * -1.4426950408889634f)); b[e] = __builtin_amdgcn_rcpf(1.0f + __builtin_amdgcn_exp2f(b[e] * -1.4426950408889634f)); }
                        unsigned w0 = 0u, w1 = 0u;
#pragma unroll
                        for (int e = 0; e < 4; ++e) { w0 = __builtin_amdgcn_cvt_pk_u8_f32(a[e] * 255.0f, e, w0); w1 = __builtin_amdgcn_cvt_pk_u8_f32(b[e] * 255.0f, e, w1); }
                        *(v2u*)(ws + WS_GATES + (size_t)row * 2048 + col) = (v2u){w0, w1}; } }
        }
    }
};

struct EpiGate {
    static constexpr bool PERM = true, AFTER_DRAIN = false, I8 = false;
    bf16* M; const unsigned char* gates;
    __device__ __forceinline__ void operator()(const f32x4 (&acc)[2][2][4][2], const pg8::Unit& u, int wr, int wc, int fr, int fq) const {
        const int br = u.pn >> 2, pm = u.pm - 128 * br, pn = u.pn & 3;
        const int row0 = pm * 256 + wr * 64 + fr, col0 = pn * 256 + wc * 32 + 8 * fq;
#pragma unroll
        for (int ai = 0; ai < 2; ++ai) {
            v2u g[8]; v4u o[8];
#pragma unroll
            for (int m = 0; m < 4; ++m)
#pragma unroll
                for (int bj = 0; bj < 2; ++bj) g[2 * m + bj] = *(const v2u*)(gates + (size_t)(row0 + ai * 128 + m * 16) * 2048 + br * 1024 + col0 + bj * 128);
            if (br) {
#pragma unroll
                for (int m = 0; m < 4; ++m)
#pragma unroll
                    for (int bj = 0; bj < 2; ++bj) o[2 * m + bj] = *(const v4u*)(M + (size_t)(row0 + ai * 128 + m * 16) * DM + col0 + bj * 128);
            } else {
#pragma unroll
                for (int k = 0; k < 8; ++k) o[k] = (v4u){0u, 0u, 0u, 0u};
            }
#pragma unroll
            for (int m = 0; m < 4; ++m)
#pragma unroll
                for (int bj = 0; bj < 2; ++bj) { const v2u gg = g[2 * m + bj]; const v4u oo = o[2 * m + bj]; f32x4 a = acc[ai][bj][m][0] * (1.0f / 255.0f), b = acc[ai][bj][m][1] * (1.0f / 255.0f);
                    a[0] = a[0] * (float)(gg.x & 0xffu) + bf_lo(oo.x); a[1] = a[1] * (float)((gg.x >> 8) & 0xffu) + bf_hi(oo.x); a[2] = a[2] * (float)((gg.x >> 16) & 0xffu) + bf_lo(oo.y); a[3] = a[3] * (float)(gg.x >> 24) + bf_hi(oo.y);
                    b[0] = b[0] * (float)(gg.y & 0xffu) + bf_lo(oo.z); b[1] = b[1] * (float)((gg.y >> 8) & 0xffu) + bf_hi(oo.z); b[2] = b[2] * (float)((gg.y >> 16) & 0xffu) + bf_lo(oo.w); b[3] = b[3] * (float)(gg.y >> 24) + bf_hi(oo.w);
                    *(v4u*)(M + (size_t)(row0 + ai * 128 + m * 16) * DM + col0 + bj * 128) = pack8(a, b); }
        }
    }
};

struct EpiX1 {
    static constexpr bool PERM = true, AFTER_DRAIN = false, I8 = false;
    const float* x; float* out; bf16* x1b; float* ssq;
    __device__ __forceinline__ void operator()(const f32x4 (&acc)[2][2][4][2], const pg8::Unit& u, int wr, int wc, int fr, int fq) const {
        const int row0 = u.pm * 256 + wr * 64 + fr, col0 = u.pn * 256 + wc * 32 + 8 * fq;
#pragma unroll
        for (int ai = 0; ai < 2; ++ai) {
            f32x4 xa[8], xb[8];
#pragma unroll
            for (int m = 0; m < 4; ++m)
#pragma unroll
                for (int bj = 0; bj < 2; ++bj) { const size_t off = (size_t)(row0 + ai * 128 + m * 16) * DM + col0 + bj * 128; xa[2 * m + bj] = *(const f32x4*)(x + off); xb[2 * m + bj] = *(const f32x4*)(x + off + 4); }
            float ssv[4];
#pragma unroll
            for (int m = 0; m < 4; ++m) { float ss = 0.f;
#pragma unroll
                for (int bj = 0; bj < 2; ++bj) { const size_t off = (size_t)(row0 + ai * 128 + m * 16) * DM + col0 + bj * 128;
                    const f32x4 a = acc[ai][bj][m][0] + xa[2 * m + bj], b = acc[ai][bj][m][1] + xb[2 * m + bj];
                    *(v4u*)(x1b + off) = pack8(a, b);
                    ss += (a[0] * a[0] + a[1] * a[1]) + (a[2] * a[2] + a[3] * a[3]) + (b[0] * b[0] + b[1] * b[1]) + (b[2] * b[2] + b[3] * b[3]); }
                ss += __shfl_xor(ss, 16); ss += __shfl_xor(ss, 32); ssv[m] = ss; }
            if (fq == 0) {
#pragma unroll
                for (int m = 0; m < 4; ++m) ssq[(size_t)(row0 + ai * 128 + m * 16) * 16 + u.pn * 4 + wc] = ssv[m]; }
        }
    }
};

typedef _Float16 h16x2 __attribute__((ext_vector_type(2)));
__device__ __forceinline__ unsigned pkh(float a, float b) { const f32x2 v = {a, b}; const h16x2 h = __builtin_convertvector(v, h16x2); return __builtin_bit_cast(unsigned, h); }
struct EpiScores {
    static constexpr bool PERM = true, AFTER_DRAIN = false, I8 = false;
    unsigned short* S;
    __device__ __forceinline__ void operator()(const f32x4 (&acc)[2][2][4][2], const pg8::Unit& u, int wr, int wc, int fr, int fq) const {
        const int row0 = u.pm * 256 + wr * 64 + fr, col0 = u.pn * 256 + wc * 32 + 8 * fq;
#pragma unroll
        for (int ai = 0; ai < 2; ++ai)
#pragma unroll
            for (int m = 0; m < 4; ++m) { const int row = row0 + ai * 128 + m * 16;
#pragma unroll
                for (int bj = 0; bj < 2; ++bj) { const f32x4 a = acc[ai][bj][m][0], b = acc[ai][bj][m][1];
                    *(v4u*)(S + (size_t)row * 2048 + col0 + bj * 128) = (v4u){pkh(a[0], a[1]), pkh(a[2], a[3]), pkh(b[0], b[1]), pkh(b[2], b[3])}; } }
    }
};

struct BranchOrder {
    pg8::StaticOrder so;
    __device__ __forceinline__ bool next(int i, pg8::Unit& u) const { if (!so.next(i >> 1, u)) return false; const int br = i & 1; u.pm += 128 * br; u.pn += 4 * br; return true; }
    __device__ __forceinline__ void a_ready(const pg8::Unit&) const {}
    __device__ __forceinline__ void done(const pg8::Unit&) const {}
};
namespace att {
constexpr int SLOT = 64 * 256;
constexpr int KRING = 0, VRING = 3 * SLOT;
constexpr int XROW = 132, XBYTES = 128 * XROW * 4;
constexpr int WSF_OFF = 2 * XBYTES;
static_assert(VRING + 3 * SLOT <= WSF_OFF && WSF_OFF + 8 * 256 <= BAR_LDS_OFF, "attention LDS map");
__device__ __forceinline__ int crow(int r, int hi) { return (r & 3) + 8 * (r >> 2) + 4 * hi; }
__device__ __forceinline__ void glds16s(const unsigned char* sbase, unsigned voff, unsigned lds_dst) { unsigned keep;
    asm volatile("s_mov_b32 %0, m0\n\ts_mov_b32 m0, %3\n\ts_nop 2\n\tglobal_load_lds_dwordx4 %1, %2\n\ts_mov_b32 m0, %0" : "=&s"(keep) : "v"(voff), "s"(sbase), "s"(lds_dst) : "memory"); }
__device__ __forceinline__ float max3f(float a, float b, float c) { float r; asm("v_max3_f32 %0, %1, %2, %3" : "=v"(r) : "v"(a), "v"(b), "v"(c)); return r; }
__device__ __forceinline__ float max2f(float a, float b) { float r; asm("v_max_f32_e32 %0, %1, %2" : "=v"(r) : "v"(a), "v"(b)); return r; }
__device__ __forceinline__ s16x4 vtr(LAS const unsigned char* p) {
    typedef short v4i16_t __attribute__((ext_vector_type(4)));
    return __builtin_bit_cast(s16x4, __builtin_amdgcn_ds_read_tr16_b64_v4i16((LAS v4i16_t*)p));
}
__device__ __forceinline__ void halves32(float v, float& lo, float& hh) {
    float a = v, b2 = v;
    asm("s_nop 1\n\tv_permlane32_swap_b32_e32 %0, %1" : "+v"(a), "+v"(b2));
    lo = a; hh = b2;
}
#ifndef ATT_MX
#define ATT_MX 1
#endif
#if ATT_MX
#define MX3_(a, b, c) __builtin_fmaxf(__builtin_fmaxf((a), (b)), (c))
#define MX2_(a, b) __builtin_fmaxf((a), (b))
#define ATT_PAD(C0, C1) do { } while (0)
#else
#define MX3_(a, b, c) max3f((a), (b), (c))
#define MX2_(a, b) max2f((a), (b))
#define ATT_PAD(C0, C1) asm volatile("s_nop 15\n\ts_nop 7" : "+v"(C0), "+v"(C1))
#endif
__device__ __forceinline__ float rowmax(const f32x16& p0, const f32x16& p1) {
    float a = MX3_(p0[0], p0[1], p1[0]), b = MX3_(p0[2], p0[3], p1[1]); a = MX3_(a, p1[2], p1[3]);
#pragma unroll
    for (int r = 4; r < 16; r += 4) { a = MX3_(a, p0[r], p0[r + 1]); b = MX3_(b, p0[r + 2], p0[r + 3]); a = MX3_(a, p1[r], p1[r + 1]); b = MX3_(b, p1[r + 2], p1[r + 3]); }
    const float m = MX2_(a, b);
    float lo, hh; halves32(m, lo, hh);
    return MX2_(lo, hh);
}
#ifndef ATT_THR
#define ATT_THR 8
#endif
#ifndef ATT_AHEAD
#define ATT_AHEAD 6
#endif

template <int VAR> __device__ __forceinline__ void attn_unit(const Frame& F, int b, int h, int qb, bf16* Q, const bf16* K, const bf16* V, float lam, const float* subg) {
    LAS unsigned char* lds = F.lds;
    int tid = F.tid; asm volatile("" : "+v"(tid));
    const int lane = tid & 63, r32 = lane & 31, hi = lane >> 5, wid = F.wave;
    const int c = wid >> 2, wq = wid & 3;
    const size_t rowbase = (size_t)b * SEQ;
    const int q0 = qb * 128 + wq * 32;
    const int NT = 2 * qb + 2;
    const int dkey = lane >> 4, dpos = lane & 15;
    unsigned kvo[2], vvo[2];
#pragma unroll
    for (int i2 = 0; i2 < 2; ++i2) { const int key = 4 * (2 * wid + i2) + dkey;
        kvo[i2] = (unsigned)(key * 256 + ((dpos ^ (key & 15)) << 4));
        vvo[i2] = (unsigned)(key * 256 + ((dpos ^ ((key & 3) << 2)) << 4)); }
    const unsigned char* Kb = (const unsigned char*)(K + (size_t)(b * 4 + h) * SEQ * 128);
    const unsigned char* Vb = (const unsigned char*)(V + (size_t)(b * 4 + h) * SEQ * 128);
    const unsigned lds0 = (unsigned)(uintptr_t)lds;
    const unsigned kdst = lds0 + KRING + 2 * wid * 1024, vdst = lds0 + VRING + 2 * wid * 1024;
#define RFL(x) ((unsigned)__builtin_amdgcn_readfirstlane((int)(x)))
#define DMA_K(t, slot) do { const unsigned char* s_ = Kb + (size_t)(t) * SLOT; glds16s(s_, kvo[0], RFL(kdst + (slot))); glds16s(s_, kvo[1], RFL(kdst + (slot) + 1024)); } while (0)
#define DMA_V(t, slot) do { const unsigned char* s_ = Vb + (size_t)(t) * SLOT; glds16s(s_, vvo[0], RFL(vdst + (slot))); glds16s(s_, vvo[1], RFL(vdst + (slot) + 1024)); } while (0)
    const int kb0 = KRING + r32 * 256 + (((c * 8 + hi) ^ (r32 & 15)) << 4);
    const int grp = lane >> 4, qi = (lane & 15) >> 2, pi = lane & 3;
    const int vb0 = VRING + (4 * (grp >> 1) + qi) * 256 + ((2 * (grp & 1) + (pi >> 1)) << 4) + (pi & 1) * 8 + (qi << 6);
    LAS float* wsf = (LAS float*)(lds + WSF_OFF) + wid * 64;

    DMA_K(0, 0); DMA_V(0, 0); DMA_K(1, SLOT);
    bf16x8 qr[4];
    { const bf16* Qw = Q + (rowbase + q0 + r32) * HW + h * 128 + c * 64 + hi * 8;
#pragma unroll
      for (int s = 0; s < 4; ++s) qr[s] = *(const bf16x8*)(Qw + s * 16); }
    if (NT > 2) DMA_K(2, 2 * SLOT);
    float mhat = 0.f, l_reg = 0.f;
    f32x16 o[4];
#pragma unroll
    for (int d = 0; d < 4; ++d) o[d] = (f32x16){};
    f32x16 negm = (f32x16){}; asm volatile("" : "+v"(negm));
    bool resc = false;
    f32x16 pA0, pA1, pB0, pB1; bf16x8 kf[8]; s16x4 vlo[16], vhi[16]; v4u pw0, pw1, pw2, pw3;
    int sl_prev = 0, sl_cur = 0, sl_next = SLOT;
    if (VAR & 32) { s16x4 z = (s16x4){}; asm volatile("" : "+v"(z));
#pragma unroll
        for (int i = 0; i < 16; ++i) { vlo[i] = z; vhi[i] = z; } }
    if (VAR & 16) { v4u z = (v4u){}; asm volatile("" : "+v"(z)); pw0 = pw1 = pw2 = pw3 = z; }
#define SBAR() __builtin_amdgcn_sched_barrier(0)
#define PIN(x) asm volatile("" : "+v"(x))
#define MFMA(a, b, cc) __builtin_amdgcn_mfma_f32_32x32x16_bf16(a, b, cc, 0, 0, 0)
#define WAIT_BAR(N) asm volatile("s_waitcnt vmcnt(" #N ") lgkmcnt(0)\n\ts_barrier" ::: "memory")
#define ROT() do { sl_prev = sl_cur; sl_cur = sl_next; sl_next = (sl_next == 2 * SLOT) ? 0 : sl_next + SLOT; } while (0)
#define KLOAD2(ka, j) do { kf[2 * (j)] = *(LAS const bf16x8*)(lds + ((ka) ^ ((j) << 5))); kf[2 * (j) + 1] = *(LAS const bf16x8*)(lds + ((ka) ^ ((j) << 5)) + 8192); } while (0)
#define RESC() do { if (resc) { \
        _Pragma("unroll") for (int g = 0; g < 4; ++g) { const f32x4 f = *(LAS const f32x4*)(wsf + 8 * g + 4 * hi); \
            _Pragma("unroll") for (int d = 0; d < 4; ++d) { o[d][4 * g + 0] *= f[0]; o[d][4 * g + 1] *= f[1]; o[d][4 * g + 2] *= f[2]; o[d][4 * g + 3] *= f[3]; } } } } while (0)
#define ENDW(tt) do { if ((tt) + 3 < NT) { WAIT_BAR(4); } else if ((tt) + 2 < NT) { WAIT_BAR(2); } else { WAIT_BAR(0); } } while (0)
    if (NT > 2) { WAIT_BAR(10); } else { WAIT_BAR(8); }
    { const int ka = kb0;
#pragma unroll
      for (int j = 0; j < 4; ++j) KLOAD2(ka, j); }
    pA0 = MFMA(kf[0], qr[0], negm); pA1 = MFMA(kf[1], qr[0], negm); pA0 = MFMA(kf[2], qr[1], pA0); pA1 = MFMA(kf[3], qr[1], pA1);
    pA0 = MFMA(kf[4], qr[2], pA0); pA1 = MFMA(kf[5], qr[2], pA1); pA0 = MFMA(kf[6], qr[3], pA0); pA1 = MFMA(kf[7], qr[3], pA1);
    ATT_PAD(pA0, pA1);
    { const float rm = rowmax(pA0, pA1); mhat = rm;
#pragma unroll
      for (int r = 0; r < 16; ++r) { pA0[r] = __builtin_amdgcn_exp2f(pA0[r] - rm); pA1[r] = __builtin_amdgcn_exp2f(pA1[r] - rm); }
#pragma unroll
      for (int r = 0; r < 16; ++r) negm[r] = -mhat;
      asm volatile("" : "+v"(negm)); }
    WAIT_BAR(0);
    if (NT > 3) DMA_K(3, 0);
    DMA_V(1, SLOT); ROT();
    { const int ka = kb0 + sl_cur;
#pragma unroll
      for (int j = 0; j < 4; ++j) KLOAD2(ka, j); }
    ENDW(0);
#define PKW(P, i) cvtpk(P[i], P[(i) + 1])
#define PAF(k) __builtin_bit_cast(bf16x8, pw##k)
#define VFR(i) (bf16x8){vlo[i][0], vlo[i][1], vlo[i][2], vlo[i][3], vhi[i][0], vhi[i][1], vhi[i][2], vhi[i][3]}
#define VADR(i, half) (lds + ((va_ ^ ((((i) & 15) & 3) << 6)) + (16 * (((i) & 15) >> 2) + 8 * (half)) * 256))
#define VRD(i) do { if (!(VAR & 32) && (i) >= 0 && (i) < 16) { \
        if (VAR & 128) { const bf16x8 w_ = *(LAS const bf16x8*)(lds + (((va_ ^ ((((i) & 15) & 3) << 6)) + (16 * (((i) & 15) >> 2)) * 256) & ~15)); vlo[(i) & 15] = (s16x4){w_[0], w_[1], w_[2], w_[3]}; vhi[(i) & 15] = (s16x4){w_[4], w_[5], w_[6], w_[7]}; } \
        else if (VAR & 256) { vlo[(i) & 15] = *(LAS const s16x4*)VADR(i, 0); vhi[(i) & 15] = *(LAS const s16x4*)VADR(i, 1); } \
        else { vlo[(i) & 15] = vtr(VADR(i, 0)); vhi[(i) & 15] = vtr(VADR(i, 1)); } SBAR(); } } while (0)
#define KRD(G, j) do { if (!(VAR & 64) && (G)) { KLOAD2(ka_, j); SBAR(); } } while (0)
#define GAPA(MF, a0, a1, a2, a3, W0, W1, PW) do { MF; if (!(VAR & 16)) { sacc += a0; sacc2 += a1; sacc += a2; sacc2 += a3; PIN(sacc); PIN(sacc2); W0; W1; } PIN(PW); SBAR(); } while (0)
#define GAPB(j, X, i) do { VRD((j) + ATT_AHEAD); o[(j) & 3] = MFMA(PAF_((j) >> 2), VFR(j), o[(j) & 3]); if (!(VAR & 4)) { X[i] = __builtin_amdgcn_exp2f(X[i]); X[(i) + 1] = __builtin_amdgcn_exp2f(X[(i) + 1]); } PIN(X); SBAR(); } while (0)
#define PAF_(k) ((k) == 0 ? PAF(0) : (k) == 1 ? PAF(1) : (k) == 2 ? PAF(2) : PAF(3))
#define STEP(C0, C1, P0, P1, t, GK, GV, GL, MASK) do { SBAR(); \
    const int va_ = vb0 + sl_prev; const int ka_ = kb0 + sl_next; \
    float sacc = P0[0], sacc2 = P0[1]; \
    GAPA(C0 = MFMA(kf[0], qr[0], negm), P0[2], P0[3], P0[4], P0[5],     pw0[0] = PKW(P0, 0),  pw0[1] = PKW(P0, 2),  pw0); \
    GAPA(C1 = MFMA(kf[1], qr[0], negm), P0[6], P0[7], P0[8], P0[9],     pw0[2] = PKW(P0, 4),  pw0[3] = PKW(P0, 6),  pw0); \
    VRD(ATT_AHEAD - 6); GAPA(C0 = MFMA(kf[2], qr[1], C0),   P0[10], P0[11], P0[12], P0[13], pw1[0] = PKW(P0, 8),  pw1[1] = PKW(P0, 10), pw1); \
    VRD(ATT_AHEAD - 5); GAPA(C1 = MFMA(kf[3], qr[1], C1),   P0[14], P0[15], P1[0], P1[1],   pw1[2] = PKW(P0, 12), pw1[3] = PKW(P0, 14), pw1); \
    VRD(ATT_AHEAD - 4); GAPA(C0 = MFMA(kf[4], qr[2], C0),   P1[2], P1[3], P1[4], P1[5],     pw2[0] = PKW(P1, 0),  pw2[1] = PKW(P1, 2),  pw2); \
    VRD(ATT_AHEAD - 3); GAPA(C1 = MFMA(kf[5], qr[2], C1),   P1[6], P1[7], P1[8], P1[9],     pw2[2] = PKW(P1, 4),  pw2[3] = PKW(P1, 6),  pw2); \
    VRD(ATT_AHEAD - 2); GAPA(C0 = MFMA(kf[6], qr[3], C0),   P1[10], P1[11], P1[12], P1[13], pw3[0] = PKW(P1, 8),  pw3[1] = PKW(P1, 10), pw3); \
    VRD(ATT_AHEAD - 1); GAPA(C1 = MFMA(kf[7], qr[3], C1),   P1[14], P1[15], 0.f, 0.f,       pw3[2] = PKW(P1, 12), pw3[3] = PKW(P1, 14), pw3); \
    l_reg += sacc + sacc2; \
    if (!(VAR & 2)) { if (GK) DMA_K((t) + 3, sl_cur); if (GV) DMA_V((t) + 1, sl_next); }                                    \
    ATT_PAD(C0, C1); \
    if (MASK) { _Pragma("unroll") for (int r = 0; r < 16; ++r) { C0[r] = -INFINITY; C1[r] = -INFINITY; } }                                   \
    { const float rm = (VAR & 8) ? 0.f : rowmax(C0, C1); resc = false;                                                        \
      if (__builtin_expect(__any(rm > (float)ATT_THR), 0)) { const float dl = __builtin_fmaxf(rm, 0.f); mhat += dl;        \
          _Pragma("unroll") for (int r = 0; r < 16; ++r) { C0[r] -= dl; C1[r] -= dl; } \
          _Pragma("unroll") for (int r = 0; r < 16; ++r) negm[r] = -mhat; \
          asm volatile("" : "+v"(negm)); \
          const float f = __builtin_amdgcn_exp2f(-dl); l_reg *= f; if (hi == 0) wsf[r32] = f; resc = true; } } \
    SBAR(); \
    GAPB(0, C0, 0);  GAPB(1, C0, 2);  GAPB(2, C0, 4);  GAPB(3, C0, 6); \
    KRD(GL, 0); GAPB(4, C0, 8);  GAPB(5, C0, 10); KRD(GL, 1); GAPB(6, C0, 12); GAPB(7, C0, 14); \
    KRD(GL, 2); GAPB(8, C1, 0);  GAPB(9, C1, 2);  KRD(GL, 3); GAPB(10, C1, 4); GAPB(11, C1, 6); \
    GAPB(12, C1, 8); GAPB(13, C1, 10); GAPB(14, C1, 12); GAPB(15, C1, 14); \
    } while (0)
#define DRAIN(P0, P1, vs) do { float sacc = P0[0] + P0[1]; \
      _Pragma("unroll") for (int r = 2; r < 16; ++r) sacc += P0[r]; \
      _Pragma("unroll") for (int r = 0; r < 16; ++r) sacc += P1[r]; \
      l_reg += sacc; \
      pw0 = (v4u){PKW(P0, 0), PKW(P0, 2), PKW(P0, 4), PKW(P0, 6)}; pw1 = (v4u){PKW(P0, 8), PKW(P0, 10), PKW(P0, 12), PKW(P0, 14)}; \
      pw2 = (v4u){PKW(P1, 0), PKW(P1, 2), PKW(P1, 4), PKW(P1, 6)}; pw3 = (v4u){PKW(P1, 8), PKW(P1, 10), PKW(P1, 12), PKW(P1, 14)}; \
      const int va_ = vb0 + (vs); \
      _Pragma("unroll") for (int ks = 0; ks < 4; ++ks) { \
          _Pragma("unroll") for (int d = 0; d < 4; ++d) { \
              const s16x4 lo = vtr(lds + ((va_ ^ (d << 6)) + (16 * ks) * 256)); const s16x4 hh = vtr(lds + ((va_ ^ (d << 6)) + (16 * ks + 8) * 256)); \
              const bf16x8 vf = (bf16x8){lo[0], lo[1], lo[2], lo[3], hh[0], hh[1], hh[2], hh[3]}; \
              o[d] = MFMA(PAF_(ks), vf, o[d]); } SBAR(); } } while (0)
    int t = 1;
    for (; t + 5 < NT; t += 2) {
        STEP(pB0, pB1, pA0, pA1, t, true, true, true, false);     WAIT_BAR(4); RESC(); ROT();
        STEP(pA0, pA1, pB0, pB1, t + 1, true, true, true, false); WAIT_BAR(4); RESC(); ROT();
    }
    for (; t + 1 < NT; t += 2) {
        STEP(pB0, pB1, pA0, pA1, t, (t + 3 < NT), (t + 1 < NT), (t + 1 < NT), false);         ENDW(t);     RESC(); ROT();
        STEP(pA0, pA1, pB0, pB1, t + 1, (t + 4 < NT), (t + 2 < NT), (t + 2 < NT), false);     ENDW(t + 1); RESC(); ROT();
    }
    STEP(pB0, pB1, pA0, pA1, NT - 1, false, false, false, (wq < 2)); RESC();
    DRAIN(pB0, pB1, sl_cur);
    const float l_run = l_reg;
    __syncthreads();
#undef STEP
#undef DRAIN
#undef GAPA
#undef GAPB
#undef PAF_
#undef PAF
#undef PKW
#undef VFR
#undef VRD
#undef VADR
#undef KRD
#undef ENDW
#undef RESC
#undef KLOAD2
#undef ROT
#undef WAIT_BAR
#undef MFMA
#undef PIN
#undef SBAR
#undef DMA_K
#undef DMA_V
#undef RFL
    int tide = F.tid; asm volatile("" : "+v"(tide));
    const int lane_e = tide & 63, r32e = lane_e & 31, hie = lane_e >> 5;
    LAS float* wse = (LAS float*)(lds + WSF_OFF) + wid * 64;
    float lt; { float lo_, hh_; halves32(l_run, lo_, hh_); lt = lo_ + hh_; }
    CFENCE();
    if (hie == 0) wse[32 + r32e] = lt;
    CFENCE(); LDS_WAIT();
    {
        const float csc = c ? lam : 1.0f;
        LAS float* Xc = (LAS float*)(lds + c * XBYTES) + (wq * 32) * XROW + r32e;
#pragma unroll
        for (int g = 0; g < 4; ++g) { const f32x4 f = *(LAS const f32x4*)(wse + 32 + 8 * g + 4 * hie);
#pragma unroll
            for (int e = 0; e < 4; ++e) { const float sc = csc * __builtin_amdgcn_rcpf(f[e]); const int q = 8 * g + 4 * hie + e;
#pragma unroll
                for (int d = 0; d < 4; ++d) Xc[q * XROW + 32 * d] = o[d][4 * g + e] * sc; } }
    }
    __syncthreads();
    {
        const int row = tide >> 2, sg = tide & 3;
        const LAS float* x0 = (const LAS float*)lds + row * XROW + sg * 32;
        const LAS float* x1 = (const LAS float*)(lds + XBYTES) + row * XROW + sg * 32;
        f32x4 dv[8]; float ss = 0.f;
#pragma unroll
        for (int j = 0; j < 8; ++j) { dv[j] = *(const LAS f32x4*)(x0 + 4 * j) - *(const LAS f32x4*)(x1 + 4 * j); ss += (dv[j][0] * dv[j][0] + dv[j][1] * dv[j][1]) + (dv[j][2] * dv[j][2] + dv[j][3] * dv[j][3]); }
        ss += __builtin_bit_cast(float, __builtin_amdgcn_mov_dpp(__builtin_bit_cast(int, ss), 0xB1, 0xF, 0xF, true)); ss += __builtin_bit_cast(float, __builtin_amdgcn_mov_dpp(__builtin_bit_cast(int, ss), 0x4E, 0xF, 0xF, true));
        const float rs = (1.0f - LAMBDA_INIT) * __builtin_amdgcn_rsqf(ss * (1.0f / 128.0f) + EPS);
        bf16* yr = Q + (rowbase + qb * 128 + row) * HW + h * 128 + sg * 32;
        const float* sgp = subg + sg * 32;
#pragma unroll
        for (int j = 0; j < 4; ++j) { const f32x4 ga = *(const f32x4*)(sgp + 8 * j), gb = *(const f32x4*)(sgp + 8 * j + 4);
            v4u w; w.x = cvtpk(dv[2 * j][0] * rs * ga[0], dv[2 * j][1] * rs * ga[1]); w.y = cvtpk(dv[2 * j][2] * rs * ga[2], dv[2 * j][3] * rs * ga[3]);
            w.z = cvtpk(dv[2 * j + 1][0] * rs * gb[0], dv[2 * j + 1][1] * rs * gb[1]); w.w = cvtpk(dv[2 * j + 1][2] * rs * gb[2], dv[2 * j + 1][3] * rs * gb[3]);
            if (!(VAR & 1)) *(v4u*)(yr + 8 * j) = w; }
    }
    __syncthreads();
}
}

namespace sgu {
constexpr int VROW = 320, VN_BYTES = 128 * VROW;
constexpr int STAT_OFF = VN_BYTES;
__device__ __forceinline__ float dppx(float v, int ctrl_sel) {
    const int iv = __builtin_bit_cast(int, v);
    return __builtin_bit_cast(float, ctrl_sel == 0 ? __builtin_amdgcn_mov_dpp(iv, 0xB1, 0xF, 0xF, true) : ctrl_sel == 1 ? __builtin_amdgcn_mov_dpp(iv, 0x4E, 0xF, 0xF, true)
                                   : ctrl_sel == 2 ? __builtin_amdgcn_mov_dpp(iv, 0x141, 0xF, 0xF, true) : __builtin_amdgcn_mov_dpp(iv, 0x140, 0xF, 0xF, true));
}
__device__ __forceinline__ float wsum(float v) {
    v += dppx(v, 0); v += dppx(v, 1); v += dppx(v, 2); v += dppx(v, 3);
    const int iv = __builtin_bit_cast(int, v);
    return (__builtin_bit_cast(float, __builtin_amdgcn_readlane(iv, 0)) + __builtin_bit_cast(float, __builtin_amdgcn_readlane(iv, 16))) +
           (__builtin_bit_cast(float, __builtin_amdgcn_readlane(iv, 32)) + __builtin_bit_cast(float, __builtin_amdgcn_readlane(iv, 48)));
}
__device__ __forceinline__ void sgu_unit(const Frame& F, int blk, bf16* SU, const bf16* SV, const bf16* WSM, const float* lng, const float* lnb, const float* bs) {
    LAS unsigned char* lds = F.lds;
    int tid = F.tid; asm volatile("" : "+v"(tid));
    const int lane = tid & 63, r32 = lane & 31, hi = lane >> 5, wid = F.wave;
    const size_t R0 = (size_t)blk * 128;
    LAS float* stat = (LAS float*)(lds + STAT_OFF);
    { v4u wv[16];
#pragma unroll
      for (int i = 0; i < 16; ++i) wv[i] = *(const v4u*)(SV + (R0 + wid * 16 + i) * HW + lane * 8);
#pragma unroll
      for (int i = 0; i < 16; ++i) { const v4u w = wv[i];
        const float x[8] = {bf_lo(w.x), bf_hi(w.x), bf_lo(w.y), bf_hi(w.y), bf_lo(w.z), bf_hi(w.z), bf_lo(w.w), bf_hi(w.w)};
        float sm = 0.f;
#pragma unroll
        for (int e = 0; e < 8; ++e) sm += x[e];
        const float mu = wsum(sm) * (1.0f / 512.0f); float qv = 0.f;
#pragma unroll
        for (int e = 0; e < 8; ++e) { const float d = x[e] - mu; qv += d * d; }
        const float rstd = __builtin_amdgcn_rsqf(wsum(qv) * (1.0f / 512.0f) + EPS);
        if (lane == 0) { stat[2 * (wid * 16 + i)] = mu; stat[2 * (wid * 16 + i) + 1] = rstd; } } }
    __syncthreads();
    const int ib = wid & 3, chf = wid >> 2;
    const int grp = lane >> 4, qi = (lane & 15) >> 2, pi = lane & 3;
    const int vbase = (8 * (grp >> 1) + qi) * VROW + (16 * (grp & 1) + 4 * pi) * 2;
    for (int g = 0; g < 4; ++g) {
        { const int j = tid >> 2, sg = tid & 3; const float mu = stat[2 * j], rstd = stat[2 * j + 1];
          const bf16* src = SV + (R0 + j) * HW + g * 128 + sg * 32;
          v4u wv[4];
#pragma unroll
          for (int q = 0; q < 4; ++q) wv[q] = *(const v4u*)(src + q * 8);
#pragma unroll
          for (int q = 0; q < 4; ++q) { const v4u w = wv[q]; const int ch = g * 128 + sg * 32 + q * 8;
              const f32x4 ga = *(const f32x4*)(lng + ch), gb = *(const f32x4*)(lng + ch + 4), ba = *(const f32x4*)(lnb + ch), bb = *(const f32x4*)(lnb + ch + 4);
              v4u o;
              o.x = cvtpk((bf_lo(w.x) - mu) * rstd * ga[0] + ba[0], (bf_hi(w.x) - mu) * rstd * ga[1] + ba[1]);
              o.y = cvtpk((bf_lo(w.y) - mu) * rstd * ga[2] + ba[2], (bf_hi(w.y) - mu) * rstd * ga[3] + ba[3]);
              o.z = cvtpk((bf_lo(w.z) - mu) * rstd * gb[0] + bb[0], (bf_hi(w.z) - mu) * rstd * gb[1] + bb[1]);
              o.w = cvtpk((bf_lo(w.w) - mu) * rstd * gb[2] + bb[2], (bf_hi(w.w) - mu) * rstd * gb[3] + bb[3]);
              *(LAS v4u*)(lds + j * VROW + (sg * 32 + q * 8) * 2) = o; } }
        bf16x8 wf[8];
        { const bf16* Wg = WSM + (size_t)g * 128 * 128 + (size_t)(32 * ib + r32) * 128 + hi * 8;
#pragma unroll
          for (int s = 0; s < 8; ++s) wf[s] = *(const bf16x8*)(Wg + 16 * s); }
        bf16* sup = SU + (R0 + 32 * ib + r32) * HW + g * 128 + chf * 64 + 4 * hi;
        v2u sw[8];
#pragma unroll
        for (int k = 0; k < 8; ++k) sw[k] = *(const v2u*)(sup + (k >> 2) * 32 + (k & 3) * 8);
        const float bi = bs[g * 128 + 32 * ib + r32];
        __syncthreads();
        f32x16 acc[2]; acc[0] = (f32x16){}; acc[1] = (f32x16){};
#pragma unroll
        for (int s = 0; s < 8; ++s) {
#pragma unroll
            for (int cb = 0; cb < 2; ++cb) { const int cblk = 2 * chf + cb;
                const s16x4 lo = att::vtr(lds + vbase + (16 * s) * VROW + cblk * 64);
                const s16x4 hh = att::vtr(lds + vbase + (16 * s + 4) * VROW + cblk * 64);
                const bf16x8 vf = (bf16x8){lo[0], lo[1], lo[2], lo[3], hh[0], hh[1], hh[2], hh[3]};
                acc[cb] = __builtin_amdgcn_mfma_f32_32x32x16_bf16(vf, wf[s], acc[cb], 0, 0, 0); }
        }
#pragma unroll
        for (int k = 0; k < 8; ++k) { const int cb = k >> 2, q = k & 3; const v2u w = sw[k];
            const unsigned o0 = cvtpk(bf_lo(w.x) * (acc[cb][4 * q + 0] + bi), bf_hi(w.x) * (acc[cb][4 * q + 1] + bi));
            const unsigned o1 = cvtpk(bf_lo(w.y) * (acc[cb][4 * q + 2] + bi), bf_hi(w.y) * (acc[cb][4 * q + 3] + bi));
            *(v2u*)(sup + cb * 32 + q * 8) = (v2u){o0, o1}; }
        __syncthreads();
    }
}
}
namespace peer {
__device__ __forceinline__ float dpp_xor1(float v) { return __builtin_bit_cast(float, __builtin_amdgcn_mov_dpp(__builtin_bit_cast(int, v), 0xB1, 0xF, 0xF, true)); }
__device__ __forceinline__ float dpp_xor2(float v) { return __builtin_bit_cast(float, __builtin_amdgcn_mov_dpp(__builtin_bit_cast(int, v), 0x4E, 0xF, 0xF, true)); }
__device__ __forceinline__ void ins16(float (&L)[16], const float x) {
#pragma unroll
    for (int i = 15; i >= 1; --i) L[i] = __builtin_amdgcn_fmed3f(L[i - 1], L[i], x);
    L[0] = __builtin_fmaxf(L[0], x);
}
__device__ __forceinline__ float tagf(float v, unsigned mask, unsigned tag) { return __builtin_bit_cast(float, (__builtin_bit_cast(unsigned, v) & ~mask) | tag); }
__device__ __forceinline__ float sel16(const float (&A)[16], int i) {
    float r = A[0];
#pragma unroll
    for (int k = 1; k < 16; ++k) { const float ak = A[k]; r = (i == k) ? ak : r; }
    return r;
}
__device__ __forceinline__ void topk_phase(const Frame& F) {
    const unsigned short* S = (const unsigned short*)(F.ws + WS_SCORES); const float* ssq = (const float*)(F.ws + WS_SSQ);
    float* GW = (float*)(F.ws + WS_GW);
    const int gw = F.vcu * NWAVES + F.wave, NGW = F.G * NWAVES, lane = F.lane;
    const int q = lane & 3;
    static_assert(T * PK_HEADS / 16 == NEXP, "two table rows per top-k wave-item");
    f32x4 g2v[4];
#pragma unroll
    for (int j = 0; j < 4; ++j) g2v[j] = *(const f32x4*)(F.in[17] + 16 * lane + 4 * j);
    for (int it = gw; it < T * PK_HEADS / 16; it += NGW) {
        const bool isu = it < NEXP / 2; const int e0 = isu ? 2 * it : 2 * it - NEXP;
        f32x4 tr0[4], tr1[4];
        const int th = it * 16 + (lane >> 2), t = th >> 3, h = th & 7;
        const unsigned short* sp = S + (size_t)t * 2048 + h * 256 + q * 64;
        float L[16];
#pragma unroll
        for (int i = 0; i < 16; ++i) L[i] = -INFINITY;
#pragma unroll
        for (int c4 = 0; c4 < 4; ++c4) {
            typedef _Float16 h16x8 __attribute__((ext_vector_type(8)));
            h16x8 hv[2];
#pragma unroll
            for (int j = 0; j < 2; ++j) hv[j] = *(const h16x8*)(sp + 16 * c4 + 8 * j);
#pragma unroll
            for (int j = 0; j < 2; ++j)
#pragma unroll
                for (int e = 0; e < 8; ++e) ins16(L, tagf((float)hv[j][e], 127u, (unsigned)((q & 1) * 64 + 16 * c4 + 8 * j + e)));
        }
        __builtin_amdgcn_sched_barrier(0);
        { const float* src = (isu ? F.in[20] : F.in[21]) + (size_t)e0 * DM + 16 * lane;
#pragma unroll
          for (int j = 0; j < 4; ++j) { tr0[j] = *(const f32x4*)(src + 4 * j); tr1[j] = *(const f32x4*)(src + DM + 4 * j); } }
        __builtin_amdgcn_sched_barrier(0);
        { float P[16];
#pragma unroll
          for (int i = 0; i < 16; ++i) P[i] = dpp_xor1(L[i]);
#pragma unroll
          for (int i = 0; i < 16; ++i) ins16(L, P[i]); }
        float A[16], B[16];
        { const bool lowp = q < 2;
#pragma unroll
          for (int i = 0; i < 16; ++i) { const float o = dpp_xor2(L[i]); A[i] = lowp ? L[i] : o; B[i] = lowp ? o : L[i]; } }
        float W[16];
#pragma unroll
        for (int i = 0; i < 16; ++i) W[i] = -INFINITY;
#pragma unroll
        for (int a = 0; a < 16; ++a) { const float sa = tagf(A[a], 127u, 0u);
#pragma unroll
            for (int b = 0; b < 16; ++b) if ((a + 1) * (b + 1) <= 16) ins16(W, tagf(sa + tagf(B[b], 127u, 0u), 255u, (unsigned)(a * 16 + b))); }
        const f32x4 pq = *(const f32x4*)(ssq + (size_t)t * 16 + 4 * q);
        float pss = (pq[0] + pq[1]) + (pq[2] + pq[3]); pss += dpp_xor1(pss); pss += dpp_xor2(pss);
        const float rstd = 1.0f / sqrtf(pss * (1.0f / DM) + EPS);
        const float z0 = tagf(W[0], 255u, 0u) * rstd; float es = 0.f;
#pragma unroll
        for (int i = 0; i < 16; ++i) es += __expf(tagf(W[i], 255u, 0u) * rstd - z0);
        const float inv = 1.0f / es;
        int eo[4]; float go[4];
#pragma unroll
        for (int j = 0; j < 4; ++j) {
            const float w0 = W[j], w1 = W[4 + j], w2 = W[8 + j], w3 = W[12 + j];
            float w = w0; w = (q == 1) ? w1 : w; w = (q == 2) ? w2 : w; w = (q == 3) ? w3 : w;
            const unsigned bits = __builtin_bit_cast(unsigned, w);
            const int ai = (bits >> 4) & 15, bi = bits & 15;
            const unsigned i1 = __builtin_bit_cast(unsigned, sel16(A, ai)) & 127u, i2 = __builtin_bit_cast(unsigned, sel16(B, bi)) & 127u;
            eo[j] = (int)(i1 * 128u + i2);
            go[j] = __expf(tagf(w, 255u, 0u) * rstd - z0) * inv;
        }
        typedef int i32x4 __attribute__((ext_vector_type(4)));
        *(v2u*)((unsigned*)(F.ws + WS_IDX16) + (size_t)t * 64 + h * 8 + 2 * q) = (v2u){(unsigned)eo[0] | ((unsigned)eo[1] << 16), (unsigned)eo[2] | ((unsigned)eo[3] << 16)};
        *(f32x4*)(GW + (size_t)t * 128 + h * 16 + 4 * q) = (f32x4){go[0], go[1], go[2], go[3]};
        if (isu) {
#pragma unroll
            for (int j = 0; j < 4; ++j) { tr0[j] = tr0[j] * g2v[j]; tr1[j] = tr1[j] * g2v[j]; } }
        table_row_store(F.ws, tr0, isu, e0, lane); table_row_store(F.ws, tr1, isu, e0 + 1, lane);
    }
    {
        unsigned char* X1Q = F.ws + WS_X1Q; float* X1S = (float*)(F.ws + WS_X1S);
        for (int t = gw; t < T; t += NGW) {
            f32x4 v[4]; float am = 0.f;
            { const bf16* xb = (const bf16*)(F.ws + WS_XB) + (size_t)t * DM + 16 * lane;
              const v4u w0 = *(const v4u*)xb, w1 = *(const v4u*)(xb + 8);
              v[0] = (f32x4){bf_lo(w0.x), bf_hi(w0.x), bf_lo(w0.y), bf_hi(w0.y)}; v[1] = (f32x4){bf_lo(w0.z), bf_hi(w0.z), bf_lo(w0.w), bf_hi(w0.w)};
              v[2] = (f32x4){bf_lo(w1.x), bf_hi(w1.x), bf_lo(w1.y), bf_hi(w1.y)}; v[3] = (f32x4){bf_lo(w1.z), bf_hi(w1.z), bf_lo(w1.w), bf_hi(w1.w)}; }
#pragma unroll
            for (int j = 0; j < 4; ++j) am = fmaxf(am, fmaxf(fmaxf(fabsf(v[j][0]), fabsf(v[j][1])), fmaxf(fabsf(v[j][2]), fabsf(v[j][3]))));
            am = fmaxf(am, __shfl_xor(am, 1)); am = fmaxf(am, __shfl_xor(am, 2)); am = fmaxf(am, __shfl_xor(am, 4));
            const float sx = am > 0.f ? 127.0f / am : 0.f;
            unsigned wq[4];
#pragma unroll
            for (int j = 0; j < 4; ++j) wq[j] = ((unsigned)__float2int_rn(v[j][0] * sx) & 0xffu) | (((unsigned)__float2int_rn(v[j][1] * sx) & 0xffu) << 8) | (((unsigned)__float2int_rn(v[j][2] * sx) & 0xffu) << 16) | (((unsigned)__float2int_rn(v[j][3] * sx) & 0xffu) << 24);
            *(v4u*)(X1Q + (size_t)t * DM + 16 * lane) = (v4u){wq[0], wq[1], wq[2], wq[3]};
            if ((lane & 7) == 0) X1S[(size_t)t * 8 + (lane >> 3)] = am * (1.0f / 127.0f);
        }
    }
}

__device__ __forceinline__ void unpack16(float (&f)[16], const v4u w) {
    f32x2 t;
    t = __builtin_amdgcn_cvt_pk_f32_fp8((int)w.x, false); f[0] = t[0]; f[1] = t[1]; t = __builtin_amdgcn_cvt_pk_f32_fp8((int)w.x, true); f[2] = t[0]; f[3] = t[1];
    t = __builtin_amdgcn_cvt_pk_f32_fp8((int)w.y, false); f[4] = t[0]; f[5] = t[1]; t = __builtin_amdgcn_cvt_pk_f32_fp8((int)w.y, true); f[6] = t[0]; f[7] = t[1];
    t = __builtin_amdgcn_cvt_pk_f32_fp8((int)w.z, false); f[8] = t[0]; f[9] = t[1]; t = __builtin_amdgcn_cvt_pk_f32_fp8((int)w.z, true); f[10] = t[0]; f[11] = t[1];
    t = __builtin_amdgcn_cvt_pk_f32_fp8((int)w.w, false); f[12] = t[0]; f[13] = t[1]; t = __builtin_amdgcn_cvt_pk_f32_fp8((int)w.w, true); f[14] = t[0]; f[15] = t[1];
}
__device__ __forceinline__ void unpack8x2(f32x2 (&t)[8], const v4u w) {
    t[0] = __builtin_amdgcn_cvt_pk_f32_fp8((int)w.x, false); t[1] = __builtin_amdgcn_cvt_pk_f32_fp8((int)w.x, true);
    t[2] = __builtin_amdgcn_cvt_pk_f32_fp8((int)w.y, false); t[3] = __builtin_amdgcn_cvt_pk_f32_fp8((int)w.y, true);
    t[4] = __builtin_amdgcn_cvt_pk_f32_fp8((int)w.z, false); t[5] = __builtin_amdgcn_cvt_pk_f32_fp8((int)w.z, true);
    t[6] = __builtin_amdgcn_cvt_pk_f32_fp8((int)w.w, false); t[7] = __builtin_amdgcn_cvt_pk_f32_fp8((int)w.w, true);
}
__device__ __forceinline__ float dot_pk(const v4u w, const f32x2 (&xx)[8]) {
    f32x2 t[8]; unpack8x2(t, w);
    f32x2 a = xx[0] * t[0], b = xx[1] * t[1];
    a = xx[2] * t[2] + a; b = xx[3] * t[3] + b; a = xx[4] * t[4] + a; b = xx[5] * t[5] + b; a = xx[6] * t[6] + a; b = xx[7] * t[7] + b;
    const f32x2 c = a + b; return c[0] + c[1];
}
__device__ __forceinline__ void axpy_pk(f32x2 (&acc)[8], const float cf, const v4u w) {
    f32x2 t[8]; unpack8x2(t, w); const f32x2 cv = (f32x2){cf, cf};
#pragma unroll
    for (int k = 0; k < 8; ++k) acc[k] = cv * t[k] + acc[k];
}
struct Slice { int p0, np, wrank, wcount; };
__device__ __forceinline__ Slice slice_of(const Frame& F) {
    Slice s; const int b = (int)blockIdx.x;
    if (F.G % 8 == 0) { s.p0 = b & 7; s.np = 1; s.wrank = (b >> 3) * NWAVES + F.wave; s.wcount = (F.G >> 3) * NWAVES; }
    else { s.p0 = 0; s.np = 8; s.wrank = b * NWAVES + F.wave; s.wcount = F.G * NWAVES; }
    return s;
}
typedef int i32x4 __attribute__((ext_vector_type(4)));
__device__ __forceinline__ void expert_u_phase(const Frame& F, const int tb, const int te) {
    const unsigned char* UQ = F.ws + WS_UQ; const int* IDX = (const int*)(F.ws + WS_IDX); bf16* PART = (bf16*)(F.ws + WS_PART);
    const unsigned char* X1Q = F.ws + WS_X1Q; const float* X1S = (const float*)(F.ws + WS_X1S);
    const int lane = F.lane, g = lane >> 3, i = lane & 7;
    const Slice sl = slice_of(F);
    for (int p = sl.p0; p < sl.p0 + sl.np; ++p) {
    const int tfirst = tb + sl.wrank;
    if (tfirst >= te) continue;
    const int tlast = tfirst + ((te - 1 - tfirst) / sl.wcount) * sl.wcount;
    const unsigned* ID16 = (const unsigned*)(F.ws + WS_IDX16);
    v4u ev[2]; i32x4 xq;
#pragma unroll
    for (int j = 0; j < 2; ++j) ev[j] = *(const v4u*)(ID16 + (size_t)tfirst * 64 + 8 * g + 4 * j);
    xq = *(const i32x4*)(X1Q + (size_t)tfirst * DM + 128 * p + 16 * i);
    for (int t = tfirst; t <= tlast; t += sl.wcount) {
        v4u w[16];
#pragma unroll
        for (int s = 0; s < 16; ++s) { const unsigned pk = ev[s >> 3][(s >> 1) & 3]; const unsigned e = (s & 1) ? (pk >> 16) : (pk & 0xffffu); w[s] = *(const v4u*)(UQ + (size_t)p * (NEXP * 128) + (size_t)e * 128 + 16 * i); }
        const int tn = (t + sl.wcount <= tlast) ? t + sl.wcount : tlast;
        v4u evn[2];
#pragma unroll
        for (int j = 0; j < 2; ++j) evn[j] = *(const v4u*)(ID16 + (size_t)tn * 64 + 8 * g + 4 * j);
        const i32x4 xqn = *(const i32x4*)(X1Q + (size_t)tn * DM + 128 * p + 16 * i);
        const float dq = X1S[(size_t)t * 8 + p];
        int part[16];
#pragma unroll
        for (int s = 0; s < 16; ++s) { int a = __builtin_amdgcn_sdot4((int)w[s].x, xq[0], 0, false); a = __builtin_amdgcn_sdot4((int)w[s].y, xq[1], a, false);
            a = __builtin_amdgcn_sdot4((int)w[s].z, xq[2], a, false); part[s] = __builtin_amdgcn_sdot4((int)w[s].w, xq[3], a, false); }
        { const bool up = (i & 4) != 0;
#pragma unroll
          for (int k = 0; k < 8; ++k) { const int lo_ = part[k], hi_ = part[k + 8]; const int keep = up ? hi_ : lo_, send = up ? lo_ : hi_; part[k] = keep + __shfl_xor(send, 4); } }
        { const bool up = (i & 2) != 0;
#pragma unroll
          for (int k = 0; k < 4; ++k) { const int lo_ = part[k], hi_ = part[k + 4]; const int keep = up ? hi_ : lo_, send = up ? lo_ : hi_; part[k] = keep + __builtin_amdgcn_mov_dpp(send, 0x4E, 0xF, 0xF, true); } }
        { const bool up = (i & 1) != 0;
#pragma unroll
          for (int k = 0; k < 2; ++k) { const int lo_ = part[k], hi_ = part[k + 2]; const int keep = up ? hi_ : lo_, send = up ? lo_ : hi_; part[k] = keep + __builtin_amdgcn_mov_dpp(send, 0xB1, 0xF, 0xF, true); } }
        *(unsigned*)(PART + ((size_t)p * T + t) * 128 + 16 * g + 2 * i) = cvtpk((float)part[0] * dq, (float)part[1] * dq);
        ev[0] = evn[0]; ev[1] = evn[1];
        xq = xqn;
    }
    }
}
__device__ __forceinline__ void expert_coef_phase(const Frame& F, const int tb, const int te) {
    const bf16* PART = (const bf16*)(F.ws + WS_PART); const float* GW = (const float*)(F.ws + WS_GW);
    const float* ssq = (const float*)(F.ws + WS_SSQ); const f32x2* SUV = (const f32x2*)(F.ws + WS_SUQ);
    bf16* COEF = (bf16*)(F.ws + WS_COEF); const unsigned short* ID16 = (const unsigned short*)(F.ws + WS_IDX16);
    const int gt = F.vcu * (NWAVES * 64) + F.tid, NGT = F.G * NWAVES * 64;
    for (int it8 = tb * 16 + gt; it8 < te * 16; it8 += NGT) {
        const int it = it8 * 8, t = it8 >> 4;
        v4u pp[8];
#pragma unroll
        for (int p = 0; p < 8; ++p) pp[p] = *(const v4u*)(PART + (size_t)p * T * 128 + it);
        const v4u idw = *(const v4u*)(ID16 + it);
        const f32x4 g0 = *(const f32x4*)(GW + it), g1 = *(const f32x4*)(GW + it + 4);
        float q = 0.f;
#pragma unroll
        for (int j = 0; j < 4; ++j) { const f32x4 v = *(const f32x4*)(ssq + (size_t)t * 16 + 4 * j); q += (v[0] + v[1]) + (v[2] + v[3]); }
        const float rstd = __builtin_amdgcn_rsqf(q * (1.0f / DM) + EPS);
        unsigned ids[8] = {idw.x & 0xffffu, idw.x >> 16, idw.y & 0xffffu, idw.y >> 16, idw.z & 0xffffu, idw.z >> 16, idw.w & 0xffffu, idw.w >> 16};
        float su[8], sv[8];
#pragma unroll
        for (int k = 0; k < 8; ++k) { const f32x2 s2 = SUV[ids[k]]; su[k] = s2[0]; sv[k] = s2[1]; }
        float s[8];
#pragma unroll
        for (int k = 0; k < 8; ++k) s[k] = 0.f;
#pragma unroll
        for (int p = 0; p < 8; ++p) { s[0] += bf_lo(pp[p].x); s[1] += bf_hi(pp[p].x); s[2] += bf_lo(pp[p].y); s[3] += bf_hi(pp[p].y); s[4] += bf_lo(pp[p].z); s[5] += bf_hi(pp[p].z); s[6] += bf_lo(pp[p].w); s[7] += bf_hi(pp[p].w); }
        const float gw[8] = {g0[0], g0[1], g0[2], g0[3], g1[0], g1[1], g1[2], g1[3]};
        float c[8];
#pragma unroll
        for (int k = 0; k < 8; ++k) c[k] = gelu1(s[k] * rstd * su[k]) * gw[k] * sv[k];
        *(v4u*)(COEF + it) = (v4u){cvtpk(c[0], c[1]), cvtpk(c[2], c[3]), cvtpk(c[4], c[5]), cvtpk(c[6], c[7])};
    }
}
__device__ __forceinline__ float bfly32(float keep_lo, float keep_hi) { asm("s_nop 1\n\tv_permlane32_swap_b32_e32 %0, %1" : "+v"(keep_lo), "+v"(keep_hi)); return keep_lo + keep_hi; }
__device__ __forceinline__ float bfly16(float keep_lo, float keep_hi) { asm("s_nop 1\n\tv_permlane16_swap_b32_e32 %0, %1" : "+v"(keep_lo), "+v"(keep_hi)); return keep_lo + keep_hi; }
__device__ __forceinline__ float dpp_ror8(float v) { return __builtin_bit_cast(float, __builtin_amdgcn_mov_dpp(__builtin_bit_cast(int, v), 0x128, 0xF, 0xF, true)); }
__device__ __forceinline__ float wave_sum_dpp(float v) {
    v += dpp_xor1(v); v += dpp_xor2(v);
    v += __builtin_bit_cast(float, __builtin_amdgcn_mov_dpp(__builtin_bit_cast(int, v), 0x141, 0xF, 0xF, true));
    v += __builtin_bit_cast(float, __builtin_amdgcn_mov_dpp(__builtin_bit_cast(int, v), 0x140, 0xF, 0xF, true));
    const int iv = __builtin_bit_cast(int, v);
    return (__builtin_bit_cast(float, __builtin_amdgcn_readlane(iv, 0)) + __builtin_bit_cast(float, __builtin_amdgcn_readlane(iv, 16))) +
           (__builtin_bit_cast(float, __builtin_amdgcn_readlane(iv, 32)) + __builtin_bit_cast(float, __builtin_amdgcn_readlane(iv, 48)));
}
__device__ __forceinline__ void expert_v_phase(const Frame& F, const int tb, const int te) {
    const unsigned* COEF = (const unsigned*)(F.ws + WS_COEF);
    float* SSQ2 = (float*)(F.ws + WS_SSQ2); const int lane = F.lane, g = lane >> 3, i = lane & 7;
    const Slice sl = slice_of(F);
    for (int p = sl.p0; p < sl.p0 + sl.np; ++p) {
    const int tfirst = tb + sl.wrank;
    if (tfirst >= te) continue;
    const int tlast = tfirst + ((te - 1 - tfirst) / sl.wcount) * sl.wcount;
    const unsigned* ID16 = (const unsigned*)(F.ws + WS_IDX16) + 8 * g;
    const unsigned char* VQs = F.ws + WS_VQ + (size_t)p * (NEXP * 128);
    const unsigned lo16 = 16u * i;
    const bf16* XBp = (const bf16*)(F.ws + WS_XB) + 128 * p + 16 * i + 2 * g;
    bf16* YBp = (bf16*)(F.ws + WS_YB) + 128 * p + 16 * i + 2 * g;
    const unsigned* CFp = COEF + 8 * g;
#define V_IDS(ev, tt) do { ev[0] = *(const v4u*)(ID16 + (size_t)(tt) * 64); ev[1] = *(const v4u*)(ID16 + (size_t)(tt) * 64 + 4); } while (0)
#define V_GATHER(W, cv, xw, ev, tt) do { \
        _Pragma("unroll") for (int s = 0; s < 16; ++s) { const unsigned pk = ev[s >> 3][(s >> 1) & 3]; const unsigned e = (s & 1) ? (pk >> 16) : (pk & 0xffffu); W[s] = *(const v4u*)(VQs + (e * 128u + lo16)); } \
        cv[0] = *(const v4u*)(CFp + (size_t)(tt) * 64); cv[1] = *(const v4u*)(CFp + (size_t)(tt) * 64 + 4); \
        xw = *(const unsigned*)(XBp + (size_t)(tt) * DM); } while (0)
#define V_COMPUTE(W, cv, xw, tt) do { \
        f32x2 acc2[8]; \
        _Pragma("unroll") for (int c = 0; c < 8; ++c) acc2[c] = (f32x2){0.f, 0.f}; \
        _Pragma("unroll") for (int s = 0; s < 16; ++s) { const unsigned pk = cv[s >> 3][(s >> 1) & 3]; axpy_pk(acc2, (s & 1) ? bf_hi(pk) : bf_lo(pk), W[s]); } \
        float acc[16]; \
        _Pragma("unroll") for (int c = 0; c < 8; ++c) { acc[2 * c] = acc2[c][0]; acc[2 * c + 1] = acc2[c][1]; } \
          \
        _Pragma("unroll") for (int k = 0; k < 8; ++k) acc[k] = bfly32(acc[k], acc[k + 8]); \
        _Pragma("unroll") for (int k = 0; k < 4; ++k) acc[k] = bfly16(acc[k], acc[k + 4]); \
        { const bool up = (g & 1) != 0; \
          _Pragma("unroll") for (int k = 0; k < 2; ++k) { const float lo_ = acc[k], hi_ = acc[k + 2]; const float keep = up ? hi_ : lo_, send = up ? lo_ : hi_; acc[k] = keep + dpp_ror8(send); } } \
        const float y0 = bf_lo(xw) + acc[0], y1 = bf_hi(xw) + acc[1]; \
        *(unsigned*)(YBp + (size_t)(tt) * DM) = cvtpk(y0, y1); \
        const float ss = wave_sum_dpp(y0 * y0 + y1 * y1); \
        if (lane == 0) SSQ2[(size_t)(tt) * 8 + p] = ss; } while (0)
#define V_STEP(Wc, cvc, xwc, tc, Wn, cvn, xwn, evn, evnn, tn, tnn) do { \
        V_IDS(evnn, tnn); \
        cvn[0] = *(const v4u*)(CFp + (size_t)(tn) * 64); cvn[1] = *(const v4u*)(CFp + (size_t)(tn) * 64 + 4); \
        xwn = *(const unsigned*)(XBp + (size_t)(tn) * DM); \
        __builtin_amdgcn_sched_barrier(0);                                             \
        f32x2 acc2[8]; \
        _Pragma("unroll") for (int c = 0; c < 8; ++c) acc2[c] = (f32x2){0.f, 0.f}; \
        _Pragma("unroll") for (int s = 0; s < 16; ++s) { \
            if (s < 8) { const unsigned pk = evn[s >> 2][s & 3]; Wn[2 * s] = *(const v4u*)(VQs + ((pk & 0xffffu) * 128u + lo16)); Wn[2 * s + 1] = *(const v4u*)(VQs + ((pk >> 16) * 128u + lo16)); }     \
            { const unsigned pk = cvc[s >> 3][(s >> 1) & 3]; axpy_pk(acc2, (s & 1) ? bf_hi(pk) : bf_lo(pk), Wc[s]); } \
            __builtin_amdgcn_sched_barrier(0); } \
        float acc[16]; \
        _Pragma("unroll") for (int c = 0; c < 8; ++c) { acc[2 * c] = acc2[c][0]; acc[2 * c + 1] = acc2[c][1]; } \
        _Pragma("unroll") for (int k = 0; k < 8; ++k) acc[k] = bfly32(acc[k], acc[k + 8]); \
        _Pragma("unroll") for (int k = 0; k < 4; ++k) acc[k] = bfly16(acc[k], acc[k + 4]); \
        { const bool up = (g & 1) != 0; \
          _Pragma("unroll") for (int k = 0; k < 2; ++k) { const float lo_ = acc[k], hi_ = acc[k + 2]; const float keep = up ? hi_ : lo_, send = up ? lo_ : hi_; acc[k] = keep + dpp_ror8(send); } } \
        const float y0 = bf_lo(xwc) + acc[0], y1 = bf_hi(xwc) + acc[1]; \
        *(unsigned*)(YBp + (size_t)(tc) * DM) = cvtpk(y0, y1); \
        const float ss = wave_sum_dpp(y0 * y0 + y1 * y1); \
        if (lane == 0) SSQ2[(size_t)(tc) * 8 + p] = ss; } while (0)
    v4u evA[2], evB[2], cvA[2], cvB[2], WA[16], WB[16]; unsigned xwA, xwB;
    int t = tfirst;
    V_IDS(evA, t);
    V_GATHER(WA, cvA, xwA, evA, t);
    { const int t1 = (t + sl.wcount <= tlast) ? t + sl.wcount : tlast; V_IDS(evB, t1); }
    for (;;) {
        { const int t1 = (t + sl.wcount <= tlast) ? t + sl.wcount : tlast, t2 = (t1 + sl.wcount <= tlast) ? t1 + sl.wcount : tlast;
          V_STEP(WA, cvA, xwA, t, WB, cvB, xwB, evB, evA, t1, t2); }
        if (t + sl.wcount > tlast) break;
        t += sl.wcount;
        { const int t1 = (t + sl.wcount <= tlast) ? t + sl.wcount : tlast, t2 = (t1 + sl.wcount <= tlast) ? t1 + sl.wcount : tlast;
          V_STEP(WB, cvB, xwB, t, WA, cvA, xwA, evA, evB, t1, t2); }
        if (t + sl.wcount > tlast) break;
        t += sl.wcount;
    }
#undef V_STEP
#undef V_IDS
#undef V_GATHER
#undef V_COMPUTE
    }
}
__device__ __forceinline__ void final_norm_phase(const Frame& F) {
    const float* SSQ2 = (const float*)(F.ws + WS_SSQ2); const float* gf = F.in[22]; float* out = F.out;
    const int gw = F.vcu * NWAVES + F.wave, NGW = F.G * NWAVES, lane = F.lane;
    f32x4 gv[4];
#pragma unroll
    for (int j = 0; j < 4; ++j) gv[j] = *((const f32x4*)gf + lane + 64 * j);
    for (int t = gw; t < T; t += NGW) {
        const f32x4 a = *(const f32x4*)(SSQ2 + (size_t)t * 8), b = *(const f32x4*)(SSQ2 + (size_t)t * 8 + 4);
        const float r = 1.0f / sqrtf(((a[0] + a[1]) + (a[2] + a[3]) + (b[0] + b[1]) + (b[2] + b[3])) * (1.0f / DM) + EPS);
        f32x4* row = (f32x4*)(out + (size_t)t * DM) + lane;
        const v2u* yr = (const v2u*)((const bf16*)(F.ws + WS_YB) + (size_t)t * DM) + lane;
        v2u yv[4];
#pragma unroll
        for (int j = 0; j < 4; ++j) yv[j] = yr[64 * j];
#pragma unroll
        for (int j = 0; j < 4; ++j) { const f32x4 v = {bf_lo(yv[j].x), bf_hi(yv[j].x), bf_lo(yv[j].y), bf_hi(yv[j].y)}; row[64 * j] = v * r * gv[j]; }
    }
}
}
struct Args { const float* in[23]; float* out; unsigned char* ws; };
constexpr int N_PHASES = 8;

template <int K> __device__ __forceinline__ void run_phase(Frame& F) {
    asm volatile("" : "+v"(F.tid), "+v"(F.lane));
    unsigned char* ws = F.ws;
    if constexpr (K == 0) { p0_prologue(F); }
    if constexpr (K == 13) { p0b_quant_weights(F); }
    if constexpr (K == 1) {
        pg8::Gemm g{(const pg8::bf16_t*)(ws + WS_XB), (const pg8::bf16_t*)(ws + WS_W1Q), T, N1, DM / 2};
        pg8::StaticOrder S; S.init(T, N1, F.G, (int)blockIdx.x);
        EpiP1 E{ws, F.in[15], (const float*)(ws + WS_ROPE), (const float*)(ws + WS_XS), (const float*)(ws + WS_WSC)};
        pg8::gemm_phase<EpiP1, pg8::StaticOrder, true, true>(F.lds, g, S, E);
    }
    if constexpr (K == 2) {
        const float lam = ((const float*)(ws + WS_MISC))[0];
        for (int pi = F.vcu; pi < 512; pi += F.G) {
            const int bh = pi >> 5, s = pi & 31;
            att::attn_unit<0>(F, bh >> 2, bh & 3, 63 - s, (bf16*)(ws + WS_Q), (const bf16*)(ws + WS_K), (const bf16*)(ws + WS_V), lam, F.in[7]);
            att::attn_unit<0>(F, bh >> 2, bh & 3, s, (bf16*)(ws + WS_Q), (const bf16*)(ws + WS_K), (const bf16*)(ws + WS_V), lam, F.in[7]);
        }
#ifndef NO_SGU
        for (int u = F.vcu; u < T / 128; u += F.G)
            sgu::sgu_unit(F, u, (bf16*)(ws + WS_SU), (const bf16*)(ws + WS_SV), (const bf16*)(ws + WS_WSM), F.in[8], F.in[9], F.in[11]);
#endif
    }
#ifdef ATT_PROBE
    if constexpr (K == 11) {
        const float lam = ((const float*)(ws + WS_MISC))[0];
        for (int pi = F.vcu; pi < 512; pi += F.G) {
            const int bh = pi >> 5, s = pi & 31;
            att::attn_unit<ATT_PROBE>(F, bh >> 2, bh & 3, 63 - s, (bf16*)(ws + WS_Q), (const bf16*)(ws + WS_K), (const bf16*)(ws + WS_V), lam, F.in[7]);
            att::attn_unit<ATT_PROBE>(F, bh >> 2, bh & 3, s, (bf16*)(ws + WS_Q), (const bf16*)(ws + WS_K), (const bf16*)(ws + WS_V), lam, F.in[7]);
        }
    }
#endif
    if constexpr (K == 3) {
#ifdef P3_STAGGER
        if (F.vcu & 1) { for (int i_ = 0; i_ < P3_STAGGER; ++i_) __builtin_amdgcn_s_sleep(127); }
#endif
        pg8::Gemm g{(const pg8::bf16_t*)(ws + WS_Q), (const pg8::bf16_t*)(ws + WS_WAB), 2 * T, 2048, 512};
        BranchOrder S; S.so.init(T, DM, F.G, (int)blockIdx.x);
        EpiGate E{(bf16*)(ws + WS_G), (const unsigned char*)(ws + WS_GATES)};
        pg8::gemm_phase<EpiGate, BranchOrder, true, true>(F.lds, g, S, E);
    }
    if constexpr (K == 4) {
        pg8::Gemm g{(const pg8::bf16_t*)(ws + WS_G), (const pg8::bf16_t*)(ws + WS_WO2), T, DM, DM};
        pg8::StaticOrder S; S.init(T, DM, F.G, (int)blockIdx.x);
        EpiX1 E{F.in[0], F.out, (bf16*)(ws + WS_XB), (float*)(ws + WS_SSQ)};
        pg8::gemm_phase<EpiX1, pg8::StaticOrder, true, true>(F.lds, g, S, E);
    }
    if constexpr (K == 5) {
        pg8::Gemm g{(const pg8::bf16_t*)(ws + WS_XB), (const pg8::bf16_t*)(ws + WS_WEF), T, 2048, DM};
        pg8::StaticOrder S; S.init(T, 2048, F.G, (int)blockIdx.x);
        EpiScores E{(unsigned short*)(ws + WS_SCORES)};
        pg8::gemm_phase<EpiScores, pg8::StaticOrder, true, true>(F.lds, g, S, E);
    }
    if constexpr (K == 6) { peer::topk_phase(F); }
    if constexpr (K == 7) { peer::expert_u_phase(F, 0, T); }
    if constexpr (K == 8) { peer::expert_coef_phase(F, 0, T); }
    if constexpr (K == 9) { peer::expert_v_phase(F, 0, T); }
    if constexpr (K == 10) { peer::final_norm_phase(F); }
}

#ifndef PROGRAM
#define PROGRAM P(0) S0 P(13) S P(1) S P(2) S P(3) S P(4) S P(5) S P(6) S P(7) S P(8) S P(9) S P(10)
#endif

__global__ void __launch_bounds__(NWAVES * 64, 2) mk_fwd(Args args) {
    extern __shared__ __attribute__((aligned(16))) unsigned char lds[];
    cg::grid_group grid = cg::this_grid();
    Frame F;
    F.lds = (LAS unsigned char*)lds;
    F.tid = threadIdx.x; F.lane = F.tid & 63; F.wave = __builtin_amdgcn_readfirstlane(F.tid >> 6);
    F.G = gridDim.x; { const int bx = blockIdx.x; F.vcu = (F.G % 8 == 0) ? (bx % 8) * (F.G / 8) + bx / 8 : bx; }
#pragma unroll
    for (int i = 0; i < 23; ++i) F.in[i] = args.in[i];
    F.out = args.out; F.ws = args.ws;
    volatile LAS unsigned* bst = (volatile LAS unsigned*)(F.lds + BAR_LDS_OFF);
    if (F.tid < 2) bst[F.tid] = 0u;
    __syncthreads();
    const XcdBarrier bar = xcd_barrier_post((unsigned*)(F.ws + WS_CTL) + CW_BAR, bst);
#define P(k) run_phase<k>(F);
#define S0 { __syncthreads(); grid.sync(); }
#define S { xcd_barrier(bar); }
    PROGRAM
#undef P
#undef S
#undef S0
}

#if DBG
struct DumpEnt { unsigned long long off; unsigned n; int type; };
struct DumpArgs { DumpEnt e[10]; int cnt; int pad; unsigned char* ws; float* out; };
__global__ void dbg_dump(DumpArgs a) {
    const unsigned NOUT = (unsigned)T * DM;
    for (unsigned i = blockIdx.x * blockDim.x + threadIdx.x; i < NOUT; i += gridDim.x * blockDim.x) {
        float acc = 0.f;
        for (int k = 0; k < a.cnt; ++k) {
            const DumpEnt en = a.e[k];
            const unsigned char* base = (en.off == ~0ull) ? (const unsigned char*)a.out : a.ws + en.off;
            for (unsigned j = i; j < en.n; j += NOUT) {
                float v;
                if (en.type == 0) v = bf2f(((const bf16*)base)[j]); else if (en.type == 1) v = ((const float*)base)[j]; else v = (float)((const int*)base)[j];
                acc += v;
            }
        }
        a.out[i] = acc;
    }
}
#endif
extern "C" void kernel_launch(void* const* d_in, const int* in_sizes, int n_in, void* d_out, int out_size, void* d_ws, size_t ws_size, hipStream_t stream) {
    static int grid = 0;
    if (grid == 0) {
        if (n_in != 23 || in_sizes[0] != T * DM || out_size != T * DM || ws_size < WS_END) { fprintf(stderr, "kernel_launch: unexpected shapes (n_in %d, in0 %d, out %d, ws %zu)\n", n_in, n_in > 0 ? in_sizes[0] : -1, out_size, ws_size); grid = -1; return; }
        int dev = 0, cus = 0, per_cu = 0;
        if (hipGetDevice(&dev) != hipSuccess || hipDeviceGetAttribute(&cus, hipDeviceAttributeMultiprocessorCount, dev) != hipSuccess) { grid = -1; return; }
        if (hipFuncSetAttribute((const void*)mk_fwd, hipFuncAttributeMaxDynamicSharedMemorySize, LDS_BYTES) != hipSuccess) { fprintf(stderr, "kernel_launch: hipFuncSetAttribute failed\n"); grid = -1; return; }
        if (hipOccupancyMaxActiveBlocksPerMultiprocessor(&per_cu, (const void*)mk_fwd, NWAVES * 64, LDS_BYTES) != hipSuccess || per_cu < 1) { fprintf(stderr, "kernel_launch: occupancy query says %d\n", per_cu); per_cu = 1; }
        (void)hipGetLastError();
        grid = cus;
    }
    if (grid < 0) return;
    if (hipMemsetAsync((char*)d_ws + WS_CTL, 0, CTL_ZERO_BYTES, stream) != hipSuccess) { fprintf(stderr, "kernel_launch: hipMemsetAsync failed\n"); return; }
    Args a{};
    for (int i = 0; i < 23; ++i) a.in[i] = (const float*)d_in[i];
    a.out = (float*)d_out; a.ws = (unsigned char*)d_ws;
    void* kargs[] = {&a};
    hipError_t e = hipLaunchCooperativeKernel((const void*)mk_fwd, dim3(grid), dim3(NWAVES * 64), kargs, LDS_BYTES, stream);
    if (e != hipSuccess) fprintf(stderr, "kernel_launch: cooperative launch failed: %s (grid %d)\n", hipGetErrorString(e), grid);
#if DBG
    const int last_phase = (DBG - 1) % 10;
#endif
#if DBG
    {
        DumpArgs d{}; d.ws = (unsigned char*)d_ws; d.out = (float*)d_out; int c = 0;
        auto add = [&](unsigned long long off, unsigned n, int type) { d.e[c].off = off; d.e[c].n = n; d.e[c].type = type; ++c; };
        const unsigned M1 = 1u << 20;
        switch (last_phase) {
            case 0: if (DBG >= 10) { add(WS_W1T, 4608 * 1024, 0); break; } add(WS_XB, 32 * M1, 0); add(WS_W1T, 4608 * 1024, 0); add(WS_WAB, M1, 0); add(WS_WO2, 2 * M1, 0); add(WS_WEF, 2 * M1, 0);  add(WS_ROPE, 512 * 1024, 1); add(WS_WSM, 65536, 0); add(WS_MISC, 1, 1); break;
            case 1: if (DBG < 10) { add(WS_Q, 16 * M1, 0); add(WS_SU, 16 * M1, 0); add(WS_GATES, 64 * M1, 0); add(WS_K, 16 * M1, 0); add(WS_V, 16 * M1, 0); add(WS_SV, 16 * M1, 0); }
                    else if (DBG < 20) add(WS_GATES, 64 * M1, 0);
                    else if (DBG < 30) { add(WS_Q, 16 * M1, 0); add(WS_K, 16 * M1, 0); }
                    else if (DBG < 40) { add(WS_V, 16 * M1, 0); }
                    else { add(WS_SU, 16 * M1, 0); add(WS_SV, 16 * M1, 0); } break;
            case 2: if (DBG < 10) { add(WS_Q, 16 * M1, 0); add(WS_SU, 16 * M1, 0); } else if (DBG < 20) add(WS_Q, 16 * M1, 0); else add(WS_SU, 16 * M1, 0); break;
            case 3: add(WS_G, 64 * M1, 0); break;
            case 4: add(~0ull, 32 * M1, 1); add(WS_XB, 32 * M1, 0); add(WS_SSQ, 512 * 1024, 1); break;
            case 5: add(WS_SCORES, 64 * M1, 1); break;
            case 6: add(WS_IDX, 4 * M1, 2); add(WS_GW, 4 * M1, 1); break;
            default: break;
        }
        d.cnt = c;
        if (c) hipLaunchKernelGGL(dbg_dump, dim3(2048), dim3(256), 0, stream, d);
    }
#endif
}
```

```cpp
#include <hip/hip_runtime.h>
#include <hip/hip_cooperative_groups.h>
#include <cstdio>
#include <cstdint>
#include <type_traits>
namespace cg = cooperative_groups;

#ifndef DBG
#define DBG 0
#endif
#define ATT_AHEAD 4
namespace pg8 {
#define PG8_LAS __attribute__((address_space(3)))
typedef unsigned short bf16_t;
typedef short bf16x8 __attribute__((ext_vector_type(8)));
typedef float f32x4 __attribute__((ext_vector_type(4)));
typedef unsigned u32x4 __attribute__((ext_vector_type(4)));
constexpr int BM = 256, BK = 64, HALF = 128, HTB = HALF * BK * 2  , STAGE_BYTES = 8 * HTB, NXCD = 8, WGM = 8;

__host__ __device__ __forceinline__ int lds_byte(int r, int c) { const int st = (r >> 4) * 2 + (c >> 5), rr = r & 15, cc = c & 31, ob = rr * 64 + cc * 2; return st * 1024 + (ob ^ (((ob >> 9) & 1) << 5)); }
__host__ __device__ __forceinline__ void stage_rc(int b, int& R, int& C) { const int st = b / 1024, sb = b % 1024, swz = sb ^ (((sb >> 9) & 1) << 5); R = (st >> 1) * 16 + swz / 64; C = (st & 1) * 32 + (swz % 64) / 2; }
__host__ __device__ __forceinline__ int perm32(int rho) { const int n = rho >> 4, i = rho & 15; return 8 * (i >> 2) + 4 * n + (i & 3); }

struct Unit { int pm, pn; };
struct Gemm { const bf16_t* A; const bf16_t* Bt; int M, N, K; };

struct StaticOrder {
    int nM, nN, nwg, G, c;
    __host__ __device__ void init(int M, int N, int G_, int c_) { nM = M / BM; nN = N / BM; nwg = nM * nN; G = G_; c = c_; }
    __host__ __device__ bool next(int i, Unit& u) const {
        const long L = (long)i * G + c; if (L >= nwg) return false;
        int wgid = (int)L; { const int q = nwg / NXCD, r = nwg % NXCD, xcd = wgid % NXCD, off = wgid / NXCD; wgid = (xcd < r ? xcd * (q + 1) : r * (q + 1) + (xcd - r) * q) + off; }
        const int nig = WGM * nN, gid = wgid / nig, fm = gid * WGM, gsz = (nM - fm) < WGM ? (nM - fm) : WGM;
        u.pm = fm + ((wgid % nig) % gsz); u.pn = (wgid % nig) / gsz; return true;
    }
    __device__ __forceinline__ void a_ready(const Unit&) const {}
    __device__ __forceinline__ void done(const Unit&) const {}
};

__device__ __forceinline__ unsigned cvt_pk_bf16(float lo, float hi) { unsigned r; asm volatile("v_cvt_pk_bf16_f32 %0, %1, %2" : "=v"(r) : "v"(lo), "v"(hi)); return r; }
typedef float f32x2 __attribute__((ext_vector_type(2)));
__device__ __forceinline__ f32x2 gelu_pk(f32x2 v) {
    const f32x2 av = __builtin_elementwise_abs(v), d = av * 0.2316418882f + 1.0f;
    f32x2 t; t.x = __builtin_amdgcn_rcpf(d.x); t.y = __builtin_amdgcn_rcpf(d.y);
    f32x2 q = t * 0.5307027145f + (-0.7265760135f); q = q * t + 0.7107068705f; q = q * t + (-0.142248368f); q = q * t + 0.127414796f; q = q * t;
    const f32x2 s = (v * v) * (-0.72134752044f);
    f32x2 e; e.x = __builtin_amdgcn_exp2f(s.x); e.y = __builtin_amdgcn_exp2f(s.y);
    const f32x2 m = v * (q * e), r = v - m;
    f32x2 o; o.x = v.x < 0.f ? m.x : r.x; o.y = v.y < 0.f ? m.y : r.y; return o;
}

typedef int i32x4 __attribute__((ext_vector_type(4)));
template <class Epi, class Sched, bool ALIGN_EPI = false, bool SP2 = false>
__device__ __forceinline__ void gemm_phase(PG8_LAS unsigned char* lds, const Gemm g, const Sched& S, const Epi& E) {
    int tid_ = threadIdx.x; asm volatile("" : "+v"(tid_));
    const int tid = tid_, wid = __builtin_amdgcn_readfirstlane(tid >> 6), lane = tid & 63, wr = wid >> 2, wc = wid & 3, fr = lane & 15, fq = lane >> 4;
    const int K = g.K, nt = K / BK;
    unsigned voffA[2], voffB[2];
#pragma unroll
    for (int i = 0; i < 2; ++i) { int R, C; stage_rc(tid * 16 + i * 8192, R, C); const int Rb = Epi::PERM ? ((R & ~31) + perm32(R & 31)) : R;
        voffA[i] = (unsigned)(R * K + C) * 2u; voffB[i] = (unsigned)(Rb * K + C) * 2u; }
    const size_t kstep = (size_t)(BK * 2);
    const size_t hstep = (size_t)HALF * K * 2;
    const size_t tstep = 2 * hstep;
    const unsigned ldsw = (unsigned)wid * 1024u;
    const int aoff = lds_byte(wr * 64 + fr, fq * 8), boff = lds_byte(wc * 32 + fr, fq * 8);
#define PG8_SA(b, h) (((b) * 2 + (h)) * HTB)
#define PG8_SB(b, h) ((4 + (b) * 2 + (h)) * HTB)
#define PG8_STAGE(bufoff, gbase, voff) do { _Pragma("unroll") for (int _i = 0; _i < 2; ++_i) \
        __builtin_amdgcn_global_load_lds((const unsigned*)((const char*)(gbase) + (voff)[_i]), (PG8_LAS unsigned*)(lds + (bufoff) + ldsw + _i * 8192), 16, 0, 0); } while (0)
#define PG8_LDA(dst, b, h) do { _Pragma("unroll") for (int m = 0; m < 4; ++m) _Pragma("unroll") for (int k = 0; k < 2; ++k) dst[m][k] = *(const PG8_LAS bf16x8*)(lds + PG8_SA(b, h) + aoff + m * 2048 + k * 1024); } while (0)
#define PG8_LDB(dst, b, h) do { _Pragma("unroll") for (int n = 0; n < 2; ++n) _Pragma("unroll") for (int k = 0; k < 2; ++k) dst[n][k] = *(const PG8_LAS bf16x8*)(lds + PG8_SB(b, h) + boff + n * 2048 + k * 1024); } while (0)
#define PG8_MMA(ai, bj, At, Bt) do { __builtin_amdgcn_s_setprio(1); _Pragma("unroll") for (int m = 0; m < 4; ++m) _Pragma("unroll") for (int n = 0; n < 2; ++n) _Pragma("unroll") for (int k = 0; k < 2; ++k) \
        { if constexpr (Epi::I8) acc[ai][bj][m][n] = __builtin_amdgcn_mfma_i32_16x16x64_i8(__builtin_bit_cast(i32x4, Bt[n][k]), __builtin_bit_cast(i32x4, At[m][k]), acc[ai][bj][m][n], 0, 0, 0); \
          else acc[ai][bj][m][n] = __builtin_amdgcn_mfma_f32_16x16x32_bf16(Bt[n][k], At[m][k], acc[ai][bj][m][n], 0, 0, 0); } __builtin_amdgcn_s_setprio(0); } while (0)
#define PG8_WAIT_V(n) asm volatile("s_waitcnt vmcnt(" #n ")" ::: "memory")
#define PG8_WAIT_L(n) asm volatile("s_waitcnt lgkmcnt(" #n ")" ::: "memory")
#define PG8_BAR __builtin_amdgcn_s_barrier()
#define PG8_SCHED __builtin_amdgcn_sched_barrier(0)
    Unit cur, nxt; int ui = 0;
    if (!S.next(0, cur)) return;
    typedef typename std::conditional<Epi::I8, i32x4, f32x4>::type acc_t;
    acc_t acc[2][2][4][2];
#pragma unroll
    for (int a = 0; a < 2; ++a)
#pragma unroll
        for (int b = 0; b < 2; ++b)
#pragma unroll
            for (int m = 0; m < 4; ++m)
#pragma unroll
                for (int n = 0; n < 2; ++n) acc[a][b][m][n] = (acc_t){0, 0, 0, 0};
    bf16x8 At[4][2], B0[2][2], B1[2][2];
    const char* cA = (const char*)g.A + (size_t)cur.pm * tstep; const char* cB = (const char*)g.Bt + (size_t)cur.pn * tstep;
    S.a_ready(cur);
    if constexpr (SP2) {
        PG8_STAGE(PG8_SB(0, 0), cB, voffB); PG8_STAGE(PG8_SB(0, 1), cB + hstep, voffB); PG8_STAGE(PG8_SA(0, 0), cA, voffA); PG8_STAGE(PG8_SA(0, 1), cA + hstep, voffA);
        if (wr == 1) PG8_BAR;
        PG8_WAIT_V(2); PG8_BAR;
        PG8_STAGE(PG8_SB(1, 0), cB + kstep, voffB); PG8_STAGE(PG8_SA(1, 0), cA + kstep, voffA); PG8_STAGE(PG8_SB(1, 1), cB + hstep + kstep, voffB);
        PG8_WAIT_V(6); PG8_BAR;
    } else {
        PG8_STAGE(PG8_SB(0, 0), cB, voffB); PG8_STAGE(PG8_SA(0, 0), cA, voffA); PG8_STAGE(PG8_SB(0, 1), cB + hstep, voffB); PG8_STAGE(PG8_SA(0, 1), cA + hstep, voffA);
        if (wr == 1) PG8_BAR;
        PG8_WAIT_V(4); PG8_BAR;
        PG8_STAGE(PG8_SB(1, 0), cB + kstep, voffB); PG8_STAGE(PG8_SA(1, 0), cA + kstep, voffA); PG8_STAGE(PG8_SB(1, 1), cB + hstep + kstep, voffB);
        PG8_WAIT_V(6); PG8_BAR;
    }
    for (;;) {
        const bool has_next = S.next(ui + 1, nxt);
        const char* nA = has_next ? (const char*)g.A + (size_t)nxt.pm * tstep : cA; const char* nB = has_next ? (const char*)g.Bt + (size_t)nxt.pn * tstep : cB;
        for (int t = 0; t < nt; t += 2) {
            const bool last = (t == nt - 2);
            const char* a1 = cA + (size_t)(t + 1) * kstep;
            const char* a2 = last ? nA : cA + (size_t)(t + 2) * kstep; const char* b2 = last ? nB : cB + (size_t)(t + 2) * kstep;
            const char* a3 = a2 + kstep; const char* b3 = b2 + kstep;
            if (last && has_next) S.a_ready(nxt);
            if constexpr (SP2) {
            PG8_LDB(B0, 0, 0); PG8_LDB(B1, 0, 1); PG8_SCHED; PG8_LDA(At, 0, 0); PG8_STAGE(PG8_SA(1, 1), a1 + hstep, voffA);
            PG8_WAIT_V(8); PG8_WAIT_L(0); PG8_BAR; PG8_MMA(0, 0, At, B0); PG8_MMA(0, 1, At, B1); PG8_BAR; PG8_SCHED;
            PG8_LDA(At, 0, 1); PG8_STAGE(PG8_SB(0, 0), b2, voffB); PG8_STAGE(PG8_SB(0, 1), b2 + hstep, voffB); PG8_STAGE(PG8_SA(0, 0), a2, voffA);
            PG8_WAIT_V(8); PG8_WAIT_L(0); PG8_BAR; PG8_MMA(1, 0, At, B0); PG8_MMA(1, 1, At, B1); PG8_BAR; PG8_SCHED;
            PG8_LDB(B0, 1, 0); PG8_LDB(B1, 1, 1); PG8_SCHED; PG8_LDA(At, 1, 0); PG8_STAGE(PG8_SA(0, 1), a2 + hstep, voffA);
            PG8_WAIT_V(8); PG8_WAIT_L(0); PG8_BAR; PG8_MMA(0, 0, At, B0); PG8_MMA(0, 1, At, B1); PG8_BAR; PG8_SCHED;
            PG8_LDA(At, 1, 1); PG8_STAGE(PG8_SB(1, 0), b3, voffB); PG8_STAGE(PG8_SB(1, 1), b3 + hstep, voffB); PG8_STAGE(PG8_SA(1, 0), a3, voffA);
            PG8_WAIT_V(8); PG8_WAIT_L(0); PG8_BAR; PG8_MMA(1, 0, At, B0); PG8_MMA(1, 1, At, B1); PG8_BAR; PG8_SCHED;
            } else {
            PG8_LDB(B0, 0, 0); PG8_SCHED; PG8_LDA(At, 0, 0); PG8_STAGE(PG8_SA(1, 1), a1 + hstep, voffA);
            PG8_WAIT_L(8); PG8_BAR; PG8_WAIT_L(0); PG8_MMA(0, 0, At, B0); PG8_BAR; PG8_SCHED;
            PG8_LDB(B1, 0, 1); PG8_STAGE(PG8_SB(0, 0), b2, voffB);
            PG8_BAR; PG8_WAIT_L(0); PG8_MMA(0, 1, At, B1); PG8_BAR;
            PG8_LDA(At, 0, 1); PG8_STAGE(PG8_SA(0, 0), a2, voffA);
            PG8_BAR; PG8_WAIT_L(0); PG8_MMA(1, 0, At, B0); PG8_BAR; PG8_SCHED;
            PG8_STAGE(PG8_SB(0, 1), b2 + hstep, voffB);
            PG8_WAIT_V(6); PG8_BAR; PG8_MMA(1, 1, At, B1); PG8_BAR;
            PG8_LDB(B0, 1, 0); PG8_SCHED; PG8_LDA(At, 1, 0); PG8_STAGE(PG8_SA(0, 1), a2 + hstep, voffA);
            PG8_WAIT_L(8); PG8_BAR; PG8_WAIT_L(0); PG8_MMA(0, 0, At, B0); PG8_BAR; PG8_SCHED;
            PG8_LDB(B1, 1, 1); PG8_STAGE(PG8_SB(1, 0), b3, voffB);
            PG8_BAR; PG8_WAIT_L(0); PG8_MMA(0, 1, At, B1); PG8_BAR;
            PG8_LDA(At, 1, 1); PG8_STAGE(PG8_SA(1, 0), a3, voffA);
            PG8_BAR; PG8_WAIT_L(0); PG8_MMA(1, 0, At, B0); PG8_BAR; PG8_SCHED;
            PG8_STAGE(PG8_SB(1, 1), b3 + hstep, voffB);
            PG8_WAIT_V(6); PG8_BAR; PG8_MMA(1, 1, At, B1); PG8_BAR;
            }
        }
        if constexpr (ALIGN_EPI) { if (wr == 0) PG8_BAR; }
        if constexpr (!Epi::AFTER_DRAIN) { E(acc, cur, wr, wc, fr, fq); S.done(cur); }
        if (!has_next) break;
#pragma unroll
        for (int a = 0; a < 2; ++a)
#pragma unroll
            for (int b = 0; b < 2; ++b)
#pragma unroll
                for (int m = 0; m < 4; ++m)
#pragma unroll
                    for (int n = 0; n < 2; ++n) acc[a][b][m][n] = (acc_t){0, 0, 0, 0};
        cur = nxt; cA = nA; cB = nB; ++ui;
        if constexpr (ALIGN_EPI) { if (wr == 1) PG8_BAR; }
    }
    PG8_WAIT_V(0);
    if constexpr (!ALIGN_EPI) { if (wr == 0) PG8_BAR; }
    PG8_BAR;
    if constexpr (Epi::AFTER_DRAIN) { E.fused(acc, cur, wr, wc, fr, fq, lds, wid, lane); S.done(cur); }
#undef PG8_SA
#undef PG8_SB
#undef PG8_STAGE
#undef PG8_LDA
#undef PG8_LDB
#undef PG8_MMA
#undef PG8_WAIT_V
#undef PG8_WAIT_L
#undef PG8_BAR
#undef PG8_SCHED
}
}
constexpr int NB = 4, SEQ = 8192, DM = 1024, T = NB * SEQ;
constexpr int HW = 512;
constexpr int N1 = 4608;
constexpr int NEXP = 16384, PK_TOP = 16, PK_HEADS = 8;
constexpr float EPS = 1e-6f;
constexpr float QSCALE = 0.125f * 1.4426950408889634f;
constexpr float LAMBDA_INIT = 0.2f;

constexpr size_t MiB = 1u << 20;
constexpr size_t WS_CTL = 0, CTL_ZERO_BYTES = 65536;
constexpr int CW_BAR = 1024;
constexpr size_t WS_W1T = 2 * MiB;
constexpr size_t WS_WAB = 11 * MiB;
constexpr size_t WS_WO2 = 13 * MiB;
constexpr size_t WS_WEF = 17 * MiB;
constexpr size_t WS_ROPE = 21 * MiB;
constexpr size_t WS_WSM = 23 * MiB;
constexpr size_t WS_MISC = 23 * MiB + 512 * 1024;
constexpr size_t WS_UQ = 24 * MiB;
constexpr size_t WS_VQ = 40 * MiB;
constexpr size_t WS_SUQ = 56 * MiB;
constexpr size_t WS_XB = 88 * MiB;
constexpr size_t WS_W1Q = 58 * MiB;
constexpr size_t WS_XS = 63 * MiB;
constexpr size_t WS_WSC = 63 * MiB + 256 * 1024;
constexpr int CW_CMAX = 8192;
constexpr size_t WS_Q = 152 * MiB;
constexpr size_t WS_SU = 184 * MiB;
constexpr size_t WS_GATES = 216 * MiB;
constexpr size_t WS_K = 344 * MiB;
constexpr size_t WS_V = 376 * MiB;
constexpr size_t WS_SV = 408 * MiB;
constexpr size_t WS_G = 344 * MiB;
constexpr size_t WS_SCORES = 152 * MiB;
constexpr size_t WS_SSQ = 472 * MiB;
constexpr size_t WS_IDX = 474 * MiB;
constexpr size_t WS_GW = 490 * MiB;
constexpr size_t WS_PART = 152 * MiB;
constexpr size_t WS_COEF = 280 * MiB;
constexpr size_t WS_X1Q = 408 * MiB;
constexpr size_t WS_X1S = 440 * MiB;
constexpr size_t WS_IDX16 = 444 * MiB;
constexpr size_t WS_YB = 216 * MiB;
constexpr size_t WS_SSQ2 = 296 * MiB;
constexpr size_t WS_END = 506 * MiB;
static_assert(WS_SCORES + (size_t)T * 2048 * 4 <= WS_SSQ && WS_G + (size_t)T * 2048 * 2 <= WS_SSQ, "ws map");

constexpr int RING_BYTES = 131072;
constexpr int BAR_LDS_OFF = 147456 - 64;
constexpr int LDS_BYTES = 147456;
constexpr int NWAVES = 8;

#define GAS __attribute__((address_space(1)))
#define LAS __attribute__((address_space(3)))
typedef unsigned short bf16;
typedef unsigned v4u __attribute__((ext_vector_type(4)));
typedef unsigned v2u __attribute__((ext_vector_type(2)));
typedef float f32x4 __attribute__((ext_vector_type(4)));
typedef float f32x2 __attribute__((ext_vector_type(2)));
typedef float f32x16 __attribute__((ext_vector_type(16)));
typedef short bf16x8 __attribute__((ext_vector_type(8)));
typedef short s16x4 __attribute__((ext_vector_type(4)));
#define LDS_WAIT() asm volatile("s_waitcnt lgkmcnt(0)" ::: "memory")
#define VM_WAIT() asm volatile("s_waitcnt vmcnt(0)" ::: "memory")
#define CFENCE() asm volatile("" ::: "memory")
__device__ __forceinline__ unsigned f2bf(float f) { unsigned u = __builtin_bit_cast(unsigned, f); return (u + 0x7fffu + ((u >> 16) & 1u)) >> 16; }
__device__ __forceinline__ unsigned pk2(float lo, float hi) { return f2bf(lo) | (f2bf(hi) << 16); }
typedef __bf16 bf16x2_t __attribute__((ext_vector_type(2)));
__device__ __forceinline__ unsigned cvtpk(float lo, float hi) { const f32x2 v = {lo, hi}; const bf16x2_t b = __builtin_convertvector(v, bf16x2_t); return __builtin_bit_cast(unsigned, b); }
__device__ __forceinline__ float bf_lo(unsigned w) { return __builtin_bit_cast(float, w << 16); }
__device__ __forceinline__ float bf_hi(unsigned w) { return __builtin_bit_cast(float, w & 0xffff0000u); }
__device__ __forceinline__ float bf2f(bf16 b) { return __builtin_bit_cast(float, (unsigned)b << 16); }
__device__ __forceinline__ float wave_sum(float v) {
#pragma unroll
    for (int o = 1; o < 64; o <<= 1) v += __shfl_xor(v, o);
    return v;
}
__device__ __forceinline__ float gelu1(float v) {
    const float av = __builtin_fabsf(v), t = __builtin_amdgcn_rcpf(av * 0.2316418882f + 1.0f);
    float q = t * 0.5307027145f + (-0.7265760135f); q = q * t + 0.7107068705f; q = q * t + (-0.142248368f); q = q * t + 0.127414796f; q = q * t;
    const float e = __builtin_amdgcn_exp2f((v * v) * (-0.72134752044f));
    const float m = v * (q * e);
    return v < 0.f ? m : v - m;
}

struct Frame {
    LAS unsigned char* lds;
    int tid, lane, wave, vcu, G;
    const float* in[23]; float* out; unsigned char* ws;
};

__device__ __forceinline__ int rowmap_fn(int n, int rowmode, int row_off) {
    if (rowmode == 1 && n < 1024) return (n & ~63) | (2 * (n & 31) + ((n >> 5) & 1));
    return row_off + n;
}
__device__ __forceinline__ void p0_transpose_item(const float* W, int N, bf16* WT, int ldt, int koff, int rowmode, int row_off, LAS float* scr, int item, int lane, unsigned* cmax = nullptr) {
    const int nblk = N / 32, kb = item / nblk, nb = item % nblk, k0 = 64 * kb, n0 = 32 * nb;
#pragma unroll 8
    for (int i = 0; i < 32; ++i) { const int kk = 2 * i + (lane >> 5); scr[kk * 33 + (lane & 31)] = W[(size_t)(k0 + kk) * N + n0 + (lane & 31)]; }
    LDS_WAIT(); CFENCE();
    const int c = lane & 7;
#pragma unroll
    for (int j = 0; j < 4; ++j) { const int n = (lane >> 3) + 8 * j; const LAS float* s = scr + (8 * c) * 33 + n;
        v4u o; o.x = pk2(s[0 * 33], s[1 * 33]); o.y = pk2(s[2 * 33], s[3 * 33]); o.z = pk2(s[4 * 33], s[5 * 33]); o.w = pk2(s[6 * 33], s[7 * 33]);
        *(v4u*)(WT + (size_t)rowmap_fn(n0 + n, rowmode, row_off) * ldt + koff + k0 + 8 * c) = o;
        if (cmax) { float am = 0.f;
#pragma unroll
            for (int q = 0; q < 4; ++q) { const unsigned w = q == 0 ? o.x : q == 1 ? o.y : q == 2 ? o.z : o.w; am = fmaxf(am, fmaxf(fabsf(bf_lo(w)), fabsf(bf_hi(w)))); }
            int iv = __builtin_bit_cast(int, am);
            iv = max(iv, __builtin_amdgcn_mov_dpp(iv, 0xB1, 0xF, 0xF, true)); iv = max(iv, __builtin_amdgcn_mov_dpp(iv, 0x4E, 0xF, 0xF, true)); iv = max(iv, __builtin_amdgcn_mov_dpp(iv, 0x141, 0xF, 0xF, true));
            if (c == 0) atomicMax(cmax + rowmap_fn(n0 + n, rowmode, row_off), (unsigned)iv); } }
    LDS_WAIT(); CFENCE();
}

__device__ __forceinline__ void table_row_store(unsigned char* ws, const f32x4 (&v)[4], bool isu, int e, int lane) {
    float am = 0.f;
#pragma unroll
    for (int j = 0; j < 4; ++j) am = fmaxf(am, fmaxf(fmaxf(fabsf(v[j][0]), fabsf(v[j][1])), fmaxf(fabsf(v[j][2]), fabsf(v[j][3]))));
    { int iv = __builtin_bit_cast(int, am);
      iv = max(iv, __builtin_amdgcn_mov_dpp(iv, 0xB1, 0xF, 0xF, true)); iv = max(iv, __builtin_amdgcn_mov_dpp(iv, 0x4E, 0xF, 0xF, true));
      iv = max(iv, __builtin_amdgcn_mov_dpp(iv, 0x141, 0xF, 0xF, true)); iv = max(iv, __builtin_amdgcn_mov_dpp(iv, 0x140, 0xF, 0xF, true));
      iv = max(max(__builtin_amdgcn_readlane(iv, 0), __builtin_amdgcn_readlane(iv, 16)), max(__builtin_amdgcn_readlane(iv, 32), __builtin_amdgcn_readlane(iv, 48)));
      am = __builtin_bit_cast(float, iv); }
    v4u q;
    if (isu) {
        const float sc = am > 0.f ? 127.0f / am : 0.f;
        unsigned wq[4];
#pragma unroll
        for (int j = 0; j < 4; ++j) wq[j] = ((unsigned)__float2int_rn(v[j][0] * sc) & 0xffu) | (((unsigned)__float2int_rn(v[j][1] * sc) & 0xffu) << 8) | (((unsigned)__float2int_rn(v[j][2] * sc) & 0xffu) << 16) | (((unsigned)__float2int_rn(v[j][3] * sc) & 0xffu) << 24);
        q = (v4u){wq[0], wq[1], wq[2], wq[3]};
    } else {
        const float sc = am > 0.f ? 224.0f / am : 0.f;
        { int w = 0; w = __builtin_amdgcn_cvt_pk_fp8_f32(v[0][0] * sc, v[0][1] * sc, w, false); w = __builtin_amdgcn_cvt_pk_fp8_f32(v[0][2] * sc, v[0][3] * sc, w, true); q.x = (unsigned)w; }
        { int w = 0; w = __builtin_amdgcn_cvt_pk_fp8_f32(v[1][0] * sc, v[1][1] * sc, w, false); w = __builtin_amdgcn_cvt_pk_fp8_f32(v[1][2] * sc, v[1][3] * sc, w, true); q.y = (unsigned)w; }
        { int w = 0; w = __builtin_amdgcn_cvt_pk_fp8_f32(v[2][0] * sc, v[2][1] * sc, w, false); w = __builtin_amdgcn_cvt_pk_fp8_f32(v[2][2] * sc, v[2][3] * sc, w, true); q.z = (unsigned)w; }
        { int w = 0; w = __builtin_amdgcn_cvt_pk_fp8_f32(v[3][0] * sc, v[3][1] * sc, w, false); w = __builtin_amdgcn_cvt_pk_fp8_f32(v[3][2] * sc, v[3][3] * sc, w, true); q.w = (unsigned)w; }
    }
    *(v4u*)(ws + (isu ? WS_UQ : WS_VQ) + (size_t)(lane >> 3) * (NEXP * 128) + (size_t)e * 128 + 16 * (lane & 7)) = q;
    if (lane == 0) ((float*)(ws + WS_SUQ))[2 * e + (isu ? 0 : 1)] = am * (isu ? (1.0f / 127.0f) : (1.0f / 224.0f));
}

__device__ __forceinline__ void p0_prologue(Frame& F) {
    unsigned char* ws = F.ws;
    const int gw = F.vcu * NWAVES + F.wave, NGW = F.G * NWAVES;
    const int gt = F.vcu * (NWAVES * 64) + F.tid, NGT = F.G * NWAVES * 64;
    {
        LAS float* scr = (LAS float*)(F.lds + F.wave * 16384);
        bf16* W1T = (bf16*)(ws + WS_W1T); bf16* WAB = (bf16*)(ws + WS_WAB); bf16* WO2 = (bf16*)(ws + WS_WO2);
        constexpr int I_IN = 16 * 80, I_GT = 16 * 64, I_A = 8 * 32, I_B = 8 * 32, I_O = 16 * 32;
        constexpr int NIT = I_IN + I_GT + I_A + I_B + I_O;
        for (int it = gw; it < NIT; it += NGW) {
            int r = it;
            if (r < I_IN) { p0_transpose_item(F.in[2], 2560, W1T, 1024, 0, 1, 0, scr, r, F.lane, (unsigned*)(ws + WS_CTL) + CW_CMAX); continue; } r -= I_IN;
            if (r < I_GT) { p0_transpose_item(F.in[14], 2048, W1T, 1024, 0, 0, 2560, scr, r, F.lane, (unsigned*)(ws + WS_CTL) + CW_CMAX); continue; } r -= I_GT;
            if (r < I_A) { p0_transpose_item(F.in[12], 1024, WAB, 512, 0, 0, 0, scr, r, F.lane); continue; } r -= I_A;
            if (r < I_B) { p0_transpose_item(F.in[13], 1024, WAB, 512, 0, 0, 1024, scr, r, F.lane); continue; } r -= I_B;
            p0_transpose_item(F.in[16], 1024, WO2, 1024, 0, 0, 0, scr, r, F.lane);
        }
    }
    __syncthreads();
    {
        const float* wq = F.in[18]; const float* keys = F.in[19]; const float* g2 = F.in[17];
        bf16* WEF = (bf16*)(ws + WS_WEF);
        const int r32 = F.lane & 31, hi = F.lane >> 5;
        for (int task = gw; task < 16 * 4 * 32; task += NGW) {
            const int hp = task >> 7, k0 = ((task >> 5) & 3) * 32, d0 = (task & 31) * 32;
            const float* ap = keys + (size_t)(hp * 128 + k0 + r32) * 128 + 8 * hi;
            const float* bp = wq + (size_t)(d0 + r32) * 2048 + hp * 128 + 8 * hi;
            f32x16 acc = (f32x16){};
#pragma unroll 1
            for (int half = 0; half < 2; ++half) {
                f32x4 av[8], bv[8];
#pragma unroll
                for (int s = 0; s < 4; ++s) { av[2 * s] = *(const f32x4*)(ap + 16 * (4 * half + s)); av[2 * s + 1] = *(const f32x4*)(ap + 16 * (4 * half + s) + 4);
                    bv[2 * s] = *(const f32x4*)(bp + 16 * (4 * half + s)); bv[2 * s + 1] = *(const f32x4*)(bp + 16 * (4 * half + s) + 4); }
#pragma unroll
                for (int s = 0; s < 4; ++s) {
                    unsigned ah[4], al[4], bh[4], bl[4];
#pragma unroll
                    for (int q = 0; q < 4; ++q) { const f32x4 a4 = av[2 * s + (q >> 1)], b4 = bv[2 * s + (q >> 1)]; const int e = (q & 1) * 2;
                        const unsigned ha = cvtpk(a4[e], a4[e + 1]), hb = cvtpk(b4[e], b4[e + 1]);
                        ah[q] = ha; bh[q] = hb;
                        al[q] = cvtpk(a4[e] - bf_lo(ha), a4[e + 1] - bf_hi(ha)); bl[q] = cvtpk(b4[e] - bf_lo(hb), b4[e + 1] - bf_hi(hb)); }
                    const bf16x8 Ah = __builtin_bit_cast(bf16x8, (v4u){ah[0], ah[1], ah[2], ah[3]}), Al = __builtin_bit_cast(bf16x8, (v4u){al[0], al[1], al[2], al[3]});
                    const bf16x8 Bh = __builtin_bit_cast(bf16x8, (v4u){bh[0], bh[1], bh[2], bh[3]}), Bl = __builtin_bit_cast(bf16x8, (v4u){bl[0], bl[1], bl[2], bl[3]});
                    acc = __builtin_amdgcn_mfma_f32_32x32x16_bf16(Ah, Bh, acc, 0, 0, 0);
                    acc = __builtin_amdgcn_mfma_f32_32x32x16_bf16(Ah, Bl, acc, 0, 0, 0);
                    acc = __builtin_amdgcn_mfma_f32_32x32x16_bf16(Al, Bh, acc, 0, 0, 0);
                }
            }
            const float gd = g2[d0 + r32];
#pragma unroll
            for (int r = 0; r < 16; ++r) { const int k = k0 + (r & 3) + 8 * (r >> 2) + 4 * hi;
                WEF[(size_t)(hp * 128 + k) * 1024 + d0 + r32] = (bf16)f2bf(acc[r] * gd); }
        }
    }
    {
        const float* x = F.in[0]; const float* g1 = F.in[1]; unsigned char* A8 = ws + WS_XB; float* XS = (float*)(ws + WS_XS);
        f32x4 gv[4];
#pragma unroll
        for (int j = 0; j < 4; ++j) gv[j] = *((const f32x4*)g1 + F.lane + 64 * j);
        for (int m = gw; m < T; m += NGW) {
            const f32x4* xr = (const f32x4*)(x + (size_t)m * DM) + F.lane;
            f32x4 v[4]; float s = 0.f, am = 0.f;
#pragma unroll
            for (int j = 0; j < 4; ++j) { v[j] = xr[64 * j]; s += (v[j].x * v[j].x + v[j].y * v[j].y) + (v[j].z * v[j].z + v[j].w * v[j].w); }
            const float rstd = 1.0f / sqrtf(wave_sum(s) * (1.f / DM) + EPS);
#pragma unroll
            for (int j = 0; j < 4; ++j) { v[j] = v[j] * rstd * gv[j]; am = fmaxf(am, fmaxf(fmaxf(fabsf(v[j].x), fabsf(v[j].y)), fmaxf(fabsf(v[j].z), fabsf(v[j].w)))); }
            { int iv = __builtin_bit_cast(int, am);
              iv = max(iv, __builtin_amdgcn_mov_dpp(iv, 0xB1, 0xF, 0xF, true)); iv = max(iv, __builtin_amdgcn_mov_dpp(iv, 0x4E, 0xF, 0xF, true));
              iv = max(iv, __builtin_amdgcn_mov_dpp(iv, 0x141, 0xF, 0xF, true)); iv = max(iv, __builtin_amdgcn_mov_dpp(iv, 0x140, 0xF, 0xF, true));
              iv = max(max(__builtin_amdgcn_readlane(iv, 0), __builtin_amdgcn_readlane(iv, 16)), max(__builtin_amdgcn_readlane(iv, 32), __builtin_amdgcn_readlane(iv, 48)));
              am = __builtin_bit_cast(float, iv); }
            const float sc = am > 0.f ? 127.0f / am : 0.f;
            unsigned* o4 = (unsigned*)(A8 + (size_t)m * DM) + F.lane;
#pragma unroll
            for (int j = 0; j < 4; ++j) o4[64 * j] = ((unsigned)__float2int_rn(v[j].x * sc) & 0xffu) | (((unsigned)__float2int_rn(v[j].y * sc) & 0xffu) << 8) | (((unsigned)__float2int_rn(v[j].z * sc) & 0xffu) << 16) | (((unsigned)__float2int_rn(v[j].w * sc) & 0xffu) << 24);
            if (F.lane == 0) XS[m] = am * (1.0f / 127.0f);
        }
    }
    {
        float* rope = (float*)(ws + WS_ROPE);
        for (int i = gt; i < SEQ * 32; i += NGT) {
            const int pos = i >> 5, j = i & 31;
            const float inv = 1.0f / powf(10000.0f, (float)(2 * j) * (1.0f / 64.0f));
            const float ang = (float)pos * inv;
            double rv = (double)ang * 0.15915494309189535; rv -= floor(rv);
            const float fr = (float)rv; const float sn = __builtin_amdgcn_sinf(fr), cs = __builtin_amdgcn_cosf(fr);
            *(f32x2*)(rope + 2 * (size_t)i) = (f32x2){cs, sn};
        }
        const float* wsp = F.in[10]; bf16* WSM = (bf16*)(ws + WS_WSM);
        for (int i = gt; i < 4 * 128 * 128; i += NGT) { const int ii = (i >> 7) & 127, jj = i & 127; WSM[i] = (bf16)f2bf(((jj >> 6) <= (ii >> 6)) ? wsp[i] : 0.f); }
        if (F.vcu == 0 && F.wave == 0) {
            const float p1 = F.in[3][F.lane] * F.in[4][F.lane], p2 = F.in[5][F.lane] * F.in[6][F.lane];
            const float s1 = wave_sum(p1), s2 = wave_sum(p2);
            if (F.lane == 0) ((float*)(ws + WS_MISC))[0] = expf(s1) - expf(s2) + LAMBDA_INIT;
        }
    }
}

__device__ __forceinline__ void p0b_quant_weights(Frame& F) {
    unsigned char* ws = F.ws;
    const int gw = F.vcu * NWAVES + F.wave, NGW = F.G * NWAVES;
    const unsigned* cmax = (const unsigned*)(ws + WS_CTL) + CW_CMAX; float* WSC = (float*)(ws + WS_WSC);
    for (int n = gw; n < N1; n += NGW) {
        const float am = __builtin_bit_cast(float, cmax[n]); const float sc = am > 0.f ? 127.0f / am : 0.f;
        const bf16* src = (const bf16*)(ws + WS_W1T) + (size_t)n * DM + 16 * F.lane;
        const v4u w0 = *(const v4u*)src, w1 = *(const v4u*)(src + 8);
        const float v[16] = {bf_lo(w0.x), bf_hi(w0.x), bf_lo(w0.y), bf_hi(w0.y), bf_lo(w0.z), bf_hi(w0.z), bf_lo(w0.w), bf_hi(w0.w), bf_lo(w1.x), bf_hi(w1.x), bf_lo(w1.y), bf_hi(w1.y), bf_lo(w1.z), bf_hi(w1.z), bf_lo(w1.w), bf_hi(w1.w)};
        unsigned wq[4];
#pragma unroll
        for (int j = 0; j < 4; ++j) wq[j] = ((unsigned)__float2int_rn(v[4 * j] * sc) & 0xffu) | (((unsigned)__float2int_rn(v[4 * j + 1] * sc) & 0xffu) << 8) | (((unsigned)__float2int_rn(v[4 * j + 2] * sc) & 0xffu) << 16) | (((unsigned)__float2int_rn(v[4 * j + 3] * sc) & 0xffu) << 24);
        *(v4u*)(ws + WS_W1Q + (size_t)n * DM + 16 * F.lane) = (v4u){wq[0], wq[1], wq[2], wq[3]};
        if (F.lane == 0) WSC[n] = am * (1.0f / 127.0f);
    }
}
#define XB_TMO      128
#define XB_XCNT(j)  (256  + 64 * (j))
#define XB_XSUB(j)  (1280 + 64 * (j))
#define XB_XGEN(j)  (2304 + 64 * (j))
#define XB_TOP      3328
#define XB_TOPGEN   3392
#define XCD_BAR_WORDS 3456
#define XB_SPIN_CAP (1u << 22)

__device__ __forceinline__ unsigned xb_ld(unsigned* p)              { return __hip_atomic_load(p, __ATOMIC_RELAXED, __HIP_MEMORY_SCOPE_AGENT); }
__device__ __forceinline__ unsigned xb_add(unsigned* p, unsigned v) { return __hip_atomic_fetch_add(p, v, __ATOMIC_RELAXED, __HIP_MEMORY_SCOPE_AGENT); }
__device__ __forceinline__ unsigned xb_xcc_id() { return (unsigned)__builtin_amdgcn_s_getreg((3 << 11) | 20) & 0xFu; }
#define XB_SPIN(cond, bar) do { unsigned _sp = 0; while (cond) { __builtin_amdgcn_s_sleep(1); \
    if ((++_sp & 255u) == 0u) { if (xb_ld(&(bar)[XB_TMO])) break; if (_sp > XB_SPIN_CAP) { atomicAdd(&(bar)[XB_TMO], 1u); break; } } } } while (0)

struct XcdBarrier {
    unsigned* bar; unsigned x;
    volatile LAS unsigned* st;
};

__device__ __forceinline__ XcdBarrier xcd_barrier_post(unsigned* bar, volatile LAS unsigned* st) {
    XcdBarrier b; b.bar = bar; b.x = xb_xcc_id(); b.st = st;
    if (threadIdx.x == 0) (void)xb_add(&bar[XB_XCNT(b.x)], 1u);
    return b;
}
__device__ __forceinline__ void xcd_barrier_complete(unsigned* bar, unsigned x, unsigned& nloc, unsigned& nx) {
    const unsigned G = gridDim.x * gridDim.y * gridDim.z;
    unsigned sum, cnt, mine, sp = 0u;
    for (;;) {
        sum = 0u; cnt = 0u; mine = 0u;
#pragma unroll
        for (unsigned j = 0; j < 16; ++j) { const unsigned c = xb_ld(&bar[XB_XCNT(j)]); sum += c; cnt += (c > 0u) ? 1u : 0u; mine = (j == x) ? c : mine; }
        if (sum == G) break;
        __builtin_amdgcn_s_sleep(1);
        if ((++sp & 255u) == 0u) { if (xb_ld(&bar[XB_TMO])) break; if (sp > XB_SPIN_CAP) { atomicAdd(&bar[XB_TMO], 1u); break; } }
    }
    nloc = mine > 0u ? mine : 1u; nx = cnt > 0u ? cnt : 1u;
}

__device__ __forceinline__ void xcd_barrier(const XcdBarrier& b) {
    asm volatile("s_waitcnt vmcnt(0)" ::: "memory");
    __syncthreads();
    if (threadIdx.x == 0) {
        unsigned* bar = b.bar;
        __builtin_amdgcn_s_waitcnt(0);
        unsigned nloc = b.st[0], nx = b.st[1];
        if (nloc == 0u) { xcd_barrier_complete(bar, b.x, nloc, nx); b.st[0] = nloc; b.st[1] = nx; }
        const unsigned old = xb_add(&bar[XB_XSUB(b.x)], 1u);
        const unsigned gen = old / nloc;
        if (old + 1u == (gen + 1u) * nloc) {
            __builtin_amdgcn_fence(__ATOMIC_RELEASE, "agent");
            asm volatile("s_waitcnt vmcnt(0)" ::: "memory");
            const unsigned og = xb_add(&bar[XB_TOP], 1u);
            const unsigned tg = og / nx;
            if (og + 1u == (tg + 1u) * nx) xb_add(&bar[XB_TOPGEN], 1u);
            else XB_SPIN(xb_ld(&bar[XB_TOPGEN]) == tg, bar);
            __builtin_amdgcn_fence(__ATOMIC_ACQUIRE, "agent");
            xb_add(&bar[XB_XGEN(b.x)], 1u);
            asm volatile("s_waitcnt vmcnt(0)" ::: "memory");
        } else {
            XB_SPIN(xb_ld(&bar[XB_XGEN(b.x)]) == gen, bar);
            __builtin_amdgcn_fence(__ATOMIC_ACQUIRE, "agent");
            asm volatile("s_waitcnt vmcnt(0)" ::: "memory");
        }
    }
    __syncthreads();
}
__device__ __forceinline__ v4u pack8(const f32x4 a, const f32x4 b) { v4u w; w.x = cvtpk(a[0], a[1]); w.y = cvtpk(a[2], a[3]); w.z = cvtpk(b[0], b[1]); w.w = cvtpk(b[2], b[3]); return w; }

struct EpiP1 {
    static constexpr bool PERM = true, AFTER_DRAIN = false, I8 = true;
    unsigned char* ws; const float* bgate; const float* rope; const float* xs; const float* wsc;
    __device__ __forceinline__ void operator()(const pg8::i32x4 (&acci)[2][2][4][2], const pg8::Unit& u, int wr, int wc, int fr, int fq) const {
        const int row0 = u.pm * 256 + wr * 64 + fr, pn = u.pn, ct = wc * 32 + 8 * fq;
        float rs[8]; f32x4 cs[2][2];
#pragma unroll
        for (int k = 0; k < 8; ++k) rs[k] = xs[row0 + (k >> 2) * 128 + (k & 3) * 16];
#pragma unroll
        for (int bj = 0; bj < 2; ++bj) { cs[bj][0] = *(const f32x4*)(wsc + pn * 256 + bj * 128 + ct); cs[bj][1] = *(const f32x4*)(wsc + pn * 256 + bj * 128 + ct + 4); }
        f32x4 acc[2][2][4][2];
#pragma unroll
        for (int ai = 0; ai < 2; ++ai)
#pragma unroll
            for (int bj = 0; bj < 2; ++bj)
#pragma unroll
                for (int m = 0; m < 4; ++m)
#pragma unroll
                    for (int n = 0; n < 2; ++n) { const pg8::i32x4 v = acci[ai][bj][m][n]; const float r = rs[4 * ai + m];
                        acc[ai][bj][m][n] = (f32x4){(float)v[0] * r * cs[bj][n][0], (float)v[1] * r * cs[bj][n][1], (float)v[2] * r * cs[bj][n][2], (float)v[3] * r * cs[bj][n][3]}; }
        if (pn < 4) {
            bf16* dst = (bf16*)(ws + (pn < 2 ? WS_Q : WS_K)); const float sc = pn < 2 ? QSCALE : 1.0f; const int cb = (pn & 1) * 256 + ct; const bool hm = pn >= 2;
#pragma unroll
            for (int ai = 0; ai < 2; ++ai)
#pragma unroll
                for (int m = 0; m < 4; ++m) { const int row = row0 + ai * 128 + m * 16, pos = row & (SEQ - 1);
#pragma unroll
                    for (int bj = 0; bj < 2; ++bj) { const int col = cb + bj * 128, i0 = (col & 63) >> 1;
                        const f32x4 r0 = *(const f32x4*)(rope + (size_t)(pos * 32 + i0) * 2), r1 = *(const f32x4*)(rope + (size_t)(pos * 32 + i0 + 2) * 2);
                        const f32x4 a = acc[ai][bj][m][0], b = acc[ai][bj][m][1]; f32x4 oa, ob;
                        oa[0] = (a[0] * r0[0] - a[1] * r0[1]) * sc; oa[1] = (a[0] * r0[1] + a[1] * r0[0]) * sc;
                        oa[2] = (a[2] * r0[2] - a[3] * r0[3]) * sc; oa[3] = (a[2] * r0[3] + a[3] * r0[2]) * sc;
                        ob[0] = (b[0] * r1[0] - b[1] * r1[1]) * sc; ob[1] = (b[0] * r1[1] + b[1] * r1[0]) * sc;
                        ob[2] = (b[2] * r1[2] - b[3] * r1[3]) * sc; ob[3] = (b[2] * r1[3] + b[3] * r1[2]) * sc;
                        const size_t off = hm ? ((size_t)(((row >> 13) * 4 + (col >> 7)) * SEQ + pos) * 128 + (col & 127)) : ((size_t)row * HW + col);
                        *(v4u*)(dst + off) = pack8(oa, ob); } }
        } else if (pn < 10) {
            bf16* dst = (bf16*)(ws + (pn < 6 ? WS_V : (pn < 8 ? WS_SU : WS_SV))); const bool act = pn >= 6; const int cb = (pn & 1) * 256 + ct;
#pragma unroll
            for (int ai = 0; ai < 2; ++ai)
#pragma unroll
                for (int m = 0; m < 4; ++m) { const int row = row0 + ai * 128 + m * 16;
#pragma unroll
                    for (int bj = 0; bj < 2; ++bj) { const int col = cb + bj * 128; f32x4 a = acc[ai][bj][m][0], b = acc[ai][bj][m][1];
                        if (act) {
#pragma unroll
                            for (int e = 0; e < 4; ++e) { a[e] = gelu1(a[e]); b[e] = gelu1(b[e]); } }
                        const size_t off = (pn < 6) ? ((size_t)(((row >> 13) * 4 + (col >> 7)) * SEQ + (row & (SEQ - 1))) * 128 + (col & 127)) : ((size_t)row * HW + col);
                        *(v4u*)(dst + off) = pack8(a, b); } }
        } else {
            const int cb = (pn - 10) * 256 + ct;
#pragma unroll
            for (int bj = 0; bj < 2; ++bj) { const int col = cb + bj * 128;
                const f32x4 b0 = *(const f32x4*)(bgate + col), b1 = *(const f32x4*)(bgate + col + 4);
#pragma unroll
                for (int ai = 0; ai < 2; ++ai)
#pragma unroll
                    for (int m = 0; m < 4; ++m) { const int row = row0 + ai * 128 + m * 16; f32x4 a = acc[ai][bj][m][0] + b0, b = acc[ai][bj][m][1] + b1;
#pragma unroll
                        for (int e = 0; e < 4; ++e) { a[e] = __builtin_amdgcn_rcpf(1.0f + __builtin_amdgcn_exp2f(a[e] * -1.4426950408889634f)); b[e] = __builtin_amdgcn_rcpf(1.0f + __builtin_amdgcn_exp2f(b[e] * -1.4426950408889634f)); }
                        unsigned w0 = 0u, w1 = 0u;
#pragma unroll
                        for (int e = 0; e < 4; ++e) { w0 = __builtin_amdgcn_cvt_pk_u8_f32(a[e] * 255.0f, e, w0); w1 = __builtin_amdgcn_cvt_pk_u8_f32(b[e] * 255.0f, e, w1); }
                        *(v2u*)(ws + WS_GATES + (size_t)row * 2048 + col) = (v2u){w0, w1}; } }
        }
    }
};

struct EpiGate {
    static constexpr bool PERM = true, AFTER_DRAIN = false, I8 = false;
    bf16* M; const unsigned char* gates;
    __device__ __forceinline__ void operator()(const f32x4 (&acc)[2][2][4][2], const pg8::Unit& u, int wr, int wc, int fr, int fq) const {
        const int br = u.pn >> 2, pm = u.pm - 128 * br, pn = u.pn & 3;
        const int row0 = pm * 256 + wr * 64 + fr, col0 = pn * 256 + wc * 32 + 8 * fq;
#pragma unroll
        for (int ai = 0; ai < 2; ++ai) {
            v2u g[8]; v4u o[8];
#pragma unroll
            for (int m = 0; m < 4; ++m)
#pragma unroll
                for (int bj = 0; bj < 2; ++bj) g[2 * m + bj] = *(const v2u*)(gates + (size_t)(row0 + ai * 128 + m * 16) * 2048 + br * 1024 + col0 + bj * 128);
            if (br) {
#pragma unroll
                for (int m = 0; m < 4; ++m)
#pragma unroll
                    for (int bj = 0; bj < 2; ++bj) o[2 * m + bj] = *(const v4u*)(M + (size_t)(row0 + ai * 128 + m * 16) * DM + col0 + bj * 128);
            } else {
#pragma unroll
                for (int k = 0; k < 8; ++k) o[k] = (v4u){0u, 0u, 0u, 0u};
            }
#pragma unroll
            for (int m = 0; m < 4; ++m)
#pragma unroll
                for (int bj = 0; bj < 2; ++bj) { const v2u gg = g[2 * m + bj]; const v4u oo = o[2 * m + bj]; f32x4 a = acc[ai][bj][m][0] * (1.0f / 255.0f), b = acc[ai][bj][m][1] * (1.0f / 255.0f);
                    a[0] = a[0] * (float)(gg.x & 0xffu) + bf_lo(oo.x); a[1] = a[1] * (float)((gg.x >> 8) & 0xffu) + bf_hi(oo.x); a[2] = a[2] * (float)((gg.x >> 16) & 0xffu) + bf_lo(oo.y); a[3] = a[3] * (float)(gg.x >> 24) + bf_hi(oo.y);
                    b[0] = b[0] * (float)(gg.y & 0xffu) + bf_lo(oo.z); b[1] = b[1] * (float)((gg.y >> 8) & 0xffu) + bf_hi(oo.z); b[2] = b[2] * (float)((gg.y >> 16) & 0xffu) + bf_lo(oo.w); b[3] = b[3] * (float)(gg.y >> 24) + bf_hi(oo.w);
                    *(v4u*)(M + (size_t)(row0 + ai * 128 + m * 16) * DM + col0 + bj * 128) = pack8(a, b); }
        }
    }
};

struct EpiX1 {
    static constexpr bool PERM = true, AFTER_DRAIN = false, I8 = false;
    const float* x; float* out; bf16* x1b; float* ssq;
    __device__ __forceinline__ void operator()(const f32x4 (&acc)[2][2][4][2], const pg8::Unit& u, int wr, int wc, int fr, int fq) const {
        const int row0 = u.pm * 256 + wr * 64 + fr, col0 = u.pn * 256 + wc * 32 + 8 * fq;
#pragma unroll
        for (int ai = 0; ai < 2; ++ai) {
            f32x4 xa[8], xb[8];
#pragma unroll
            for (int m = 0; m < 4; ++m)
#pragma unroll
                for (int bj = 0; bj < 2; ++bj) { const size_t off = (size_t)(row0 + ai * 128 + m * 16) * DM + col0 + bj * 128; xa[2 * m + bj] = *(const f32x4*)(x + off); xb[2 * m + bj] = *(const f32x4*)(x + off + 4); }
            float ssv[4];
#pragma unroll
            for (int m = 0; m < 4; ++m) { float ss = 0.f;
#pragma unroll
                for (int bj = 0; bj < 2; ++bj) { const size_t off = (size_t)(row0 + ai * 128 + m * 16) * DM + col0 + bj * 128;
                    const f32x4 a = acc[ai][bj][m][0] + xa[2 * m + bj], b = acc[ai][bj][m][1] + xb[2 * m + bj];
                    *(v4u*)(x1b + off) = pack8(a, b);
                    ss += (a[0] * a[0] + a[1] * a[1]) + (a[2] * a[2] + a[3] * a[3]) + (b[0] * b[0] + b[1] * b[1]) + (b[2] * b[2] + b[3] * b[3]); }
                ss += __shfl_xor(ss, 16); ss += __shfl_xor(ss, 32); ssv[m] = ss; }
            if (fq == 0) {
#pragma unroll
                for (int m = 0; m < 4; ++m) ssq[(size_t)(row0 + ai * 128 + m * 16) * 16 + u.pn * 4 + wc] = ssv[m]; }
        }
    }
};

typedef _Float16 h16x2 __attribute__((ext_vector_type(2)));
__device__ __forceinline__ unsigned pkh(float a, float b) { const f32x2 v = {a, b}; const h16x2 h = __builtin_convertvector(v, h16x2); return __builtin_bit_cast(unsigned, h); }
struct EpiScores {
    static constexpr bool PERM = true, AFTER_DRAIN = false, I8 = false;
    unsigned short* S;
    __device__ __forceinline__ void operator()(const f32x4 (&acc)[2][2][4][2], const pg8::Unit& u, int wr, int wc, int fr, int fq) const {
        const int row0 = u.pm * 256 + wr * 64 + fr, col0 = u.pn * 256 + wc * 32 + 8 * fq;
#pragma unroll
        for (int ai = 0; ai < 2; ++ai)
#pragma unroll
            for (int m = 0; m < 4; ++m) { const int row = row0 + ai * 128 + m * 16;
#pragma unroll
                for (int bj = 0; bj < 2; ++bj) { const f32x4 a = acc[ai][bj][m][0], b = acc[ai][bj][m][1];
                    *(v4u*)(S + (size_t)row * 2048 + col0 + bj * 128) = (v4u){pkh(a[0], a[1]), pkh(a[2], a[3]), pkh(b[0], b[1]), pkh(b[2], b[3])}; } }
    }
};

struct BranchOrder {
    pg8::StaticOrder so;
    __device__ __forceinline__ bool next(int i, pg8::Unit& u) const { if (!so.next(i >> 1, u)) return false; const int br = i & 1; u.pm += 128 * br; u.pn += 4 * br; return true; }
    __device__ __forceinline__ void a_ready(const pg8::Unit&) const {}
    __device__ __forceinline__ void done(const pg8::Unit&) const {}
};
namespace att {
constexpr int SLOT = 64 * 256;
constexpr int KRING = 0, VRING = 3 * SLOT;
constexpr int XROW = 132, XBYTES = 128 * XROW * 4;
constexpr int WSF_OFF = 2 * XBYTES;
static_assert(VRING + 3 * SLOT <= WSF_OFF && WSF_OFF + 8 * 256 <= BAR_LDS_OFF, "attention LDS map");
__device__ __forceinline__ int crow(int r, int hi) { return (r & 3) + 8 * (r >> 2) + 4 * hi; }
__device__ __forceinline__ void glds16s(const unsigned char* sbase, unsigned voff, unsigned lds_dst) { unsigned keep;
    asm volatile("s_mov_b32 %0, m0\n\ts_mov_b32 m0, %3\n\ts_nop 2\n\tglobal_load_lds_dwordx4 %1, %2\n\ts_mov_b32 m0, %0" : "=&s"(keep) : "v"(voff), "s"(sbase), "s"(lds_dst) : "memory"); }
__device__ __forceinline__ float max3f(float a, float b, float c) { float r; asm("v_max3_f32 %0, %1, %2, %3" : "=v"(r) : "v"(a), "v"(b), "v"(c)); return r; }
__device__ __forceinline__ float max2f(float a, float b) { float r; asm("v_max_f32_e32 %0, %1, %2" : "=v"(r) : "v"(a), "v"(b)); return r; }
__device__ __forceinline__ s16x4 vtr(LAS const unsigned char* p) {
    typedef short v4i16_t __attribute__((ext_vector_type(4)));
    return __builtin_bit_cast(s16x4, __builtin_amdgcn_ds_read_tr16_b64_v4i16((LAS v4i16_t*)p));
}
__device__ __forceinline__ void halves32(float v, float& lo, float& hh) {
    float a = v, b2 = v;
    asm("s_nop 1\n\tv_permlane32_swap_b32_e32 %0, %1" : "+v"(a), "+v"(b2));
    lo = a; hh = b2;
}
#ifndef ATT_MX
#define ATT_MX 1
#endif
#if ATT_MX
#define MX3_(a, b, c) __builtin_fmaxf(__builtin_fmaxf((a), (b)), (c))
#define MX2_(a, b) __builtin_fmaxf((a), (b))
#define ATT_PAD(C0, C1) do { } while (0)
#else
#define MX3_(a, b, c) max3f((a), (b), (c))
#define MX2_(a, b) max2f((a), (b))
#define ATT_PAD(C0, C1) asm volatile("s_nop 15\n\ts_nop 7" : "+v"(C0), "+v"(C1))
#endif
__device__ __forceinline__ float rowmax(const f32x16& p0, const f32x16& p1) {
    float a = MX3_(p0[0], p0[1], p1[0]), b = MX3_(p0[2], p0[3], p1[1]); a = MX3_(a, p1[2], p1[3]);
#pragma unroll
    for (int r = 4; r < 16; r += 4) { a = MX3_(a, p0[r], p0[r + 1]); b = MX3_(b, p0[r + 2], p0[r + 3]); a = MX3_(a, p1[r], p1[r + 1]); b = MX3_(b, p1[r + 2], p1[r + 3]); }
    const float m = MX2_(a, b);
    float lo, hh; halves32(m, lo, hh);
    return MX2_(lo, hh);
}
#ifndef ATT_THR
#define ATT_THR 8
#endif
#ifndef ATT_AHEAD
#define ATT_AHEAD 6
#endif

template <int VAR> __device__ __forceinline__ void attn_unit(const Frame& F, int b, int h, int qb, bf16* Q, const bf16* K, const bf16* V, float lam, const float* subg) {
    LAS unsigned char* lds = F.lds;
    int tid = F.tid; asm volatile("" : "+v"(tid));
    const int lane = tid & 63, r32 = lane & 31, hi = lane >> 5, wid = F.wave;
    const int c = wid >> 2, wq = wid & 3;
    const size_t rowbase = (size_t)b * SEQ;
    const int q0 = qb * 128 + wq * 32;
    const int NT = 2 * qb + 2;
    const int dkey = lane >> 4, dpos = lane & 15;
    unsigned kvo[2], vvo[2];
#pragma unroll
    for (int i2 = 0; i2 < 2; ++i2) { const int key = 4 * (2 * wid + i2) + dkey;
        kvo[i2] = (unsigned)(key * 256 + ((dpos ^ (key & 15)) << 4));
        vvo[i2] = (unsigned)(key * 256 + ((dpos ^ ((key & 3) << 2)) << 4)); }
    const unsigned char* Kb = (const unsigned char*)(K + (size_t)(b * 4 + h) * SEQ * 128);
    const unsigned char* Vb = (const unsigned char*)(V + (size_t)(b * 4 + h) * SEQ * 128);
    const unsigned lds0 = (unsigned)(uintptr_t)lds;
    const unsigned kdst = lds0 + KRING + 2 * wid * 1024, vdst = lds0 + VRING + 2 * wid * 1024;
#define RFL(x) ((unsigned)__builtin_amdgcn_readfirstlane((int)(x)))
#define DMA_K(t, slot) do { const unsigned char* s_ = Kb + (size_t)(t) * SLOT; glds16s(s_, kvo[0], RFL(kdst + (slot))); glds16s(s_, kvo[1], RFL(kdst + (slot) + 1024)); } while (0)
#define DMA_V(t, slot) do { const unsigned char* s_ = Vb + (size_t)(t) * SLOT; glds16s(s_, vvo[0], RFL(vdst + (slot))); glds16s(s_, vvo[1], RFL(vdst + (slot) + 1024)); } while (0)
    const int kb0 = KRING + r32 * 256 + (((c * 8 + hi) ^ (r32 & 15)) << 4);
    const int grp = lane >> 4, qi = (lane & 15) >> 2, pi = lane & 3;
    const int vb0 = VRING + (4 * (grp >> 1) + qi) * 256 + ((2 * (grp & 1) + (pi >> 1)) << 4) + (pi & 1) * 8 + (qi << 6);
    LAS float* wsf = (LAS float*)(lds + WSF_OFF) + wid * 64;

    DMA_K(0, 0); DMA_V(0, 0); DMA_K(1, SLOT);
    bf16x8 qr[4];
    { const bf16* Qw = Q + (rowbase + q0 + r32) * HW + h * 128 + c * 64 + hi * 8;
#pragma unroll
      for (int s = 0; s < 4; ++s) qr[s] = *(const bf16x8*)(Qw + s * 16); }
    if (NT > 2) DMA_K(2, 2 * SLOT);
    float mhat = 0.f, l_reg = 0.f;
    f32x16 o[4];
#pragma unroll
    for (int d = 0; d < 4; ++d) o[d] = (f32x16){};
    f32x16 negm = (f32x16){}; asm volatile("" : "+v"(negm));
    bool resc = false;
    f32x16 pA0, pA1, pB0, pB1; bf16x8 kf[8]; s16x4 vlo[16], vhi[16]; v4u pw0, pw1, pw2, pw3;
    int sl_prev = 0, sl_cur = 0, sl_next = SLOT;
    if (VAR & 32) { s16x4 z = (s16x4){}; asm volatile("" : "+v"(z));
#pragma unroll
        for (int i = 0; i < 16; ++i) { vlo[i] = z; vhi[i] = z; } }
    if (VAR & 16) { v4u z = (v4u){}; asm volatile("" : "+v"(z)); pw0 = pw1 = pw2 = pw3 = z; }
#define SBAR() __builtin_amdgcn_sched_barrier(0)
#define PIN(x) asm volatile("" : "+v"(x))
#define MFMA(a, b, cc) __builtin_amdgcn_mfma_f32_32x32x16_bf16(a, b, cc, 0, 0, 0)
#define WAIT_BAR(N) asm volatile("s_waitcnt vmcnt(" #N ") lgkmcnt(0)\n\ts_barrier" ::: "memory")
#define ROT() do { sl_prev = sl_cur; sl_cur = sl_next; sl_next = (sl_next == 2 * SLOT) ? 0 : sl_next + SLOT; } while (0)
#define KLOAD2(ka, j) do { kf[2 * (j)] = *(LAS const bf16x8*)(lds + ((ka) ^ ((j) << 5))); kf[2 * (j) + 1] = *(LAS const bf16x8*)(lds + ((ka) ^ ((j) << 5)) + 8192); } while (0)
#define RESC() do { if (resc) { \
        _Pragma("unroll") for (int g = 0; g < 4; ++g) { const f32x4 f = *(LAS const f32x4*)(wsf + 8 * g + 4 * hi); \
            _Pragma("unroll") for (int d = 0; d < 4; ++d) { o[d][4 * g + 0] *= f[0]; o[d][4 * g + 1] *= f[1]; o[d][4 * g + 2] *= f[2]; o[d][4 * g + 3] *= f[3]; } } } } while (0)
#define ENDW(tt) do { if ((tt) + 3 < NT) { WAIT_BAR(4); } else if ((tt) + 2 < NT) { WAIT_BAR(2); } else { WAIT_BAR(0); } } while (0)
    if (NT > 2) { WAIT_BAR(10); } else { WAIT_BAR(8); }
    { const int ka = kb0;
#pragma unroll
      for (int j = 0; j < 4; ++j) KLOAD2(ka, j); }
    pA0 = MFMA(kf[0], qr[0], negm); pA1 = MFMA(kf[1], qr[0], negm); pA0 = MFMA(kf[2], qr[1], pA0); pA1 = MFMA(kf[3], qr[1], pA1);
    pA0 = MFMA(kf[4], qr[2], pA0); pA1 = MFMA(kf[5], qr[2], pA1); pA0 = MFMA(kf[6], qr[3], pA0); pA1 = MFMA(kf[7], qr[3], pA1);
    ATT_PAD(pA0, pA1);
    { const float rm = rowmax(pA0, pA1); mhat = rm;
#pragma unroll
      for (int r = 0; r < 16; ++r) { pA0[r] = __builtin_amdgcn_exp2f(pA0[r] - rm); pA1[r] = __builtin_amdgcn_exp2f(pA1[r] - rm); }
#pragma unroll
      for (int r = 0; r < 16; ++r) negm[r] = -mhat;
      asm volatile("" : "+v"(negm)); }
    WAIT_BAR(0);
    if (NT > 3) DMA_K(3, 0);
    DMA_V(1, SLOT); ROT();
    { const int ka = kb0 + sl_cur;
#pragma unroll
      for (int j = 0; j < 4; ++j) KLOAD2(ka, j); }
    ENDW(0);
#define PKW(P, i) cvtpk(P[i], P[(i) + 1])
#define PAF(k) __builtin_bit_cast(bf16x8, pw##k)
#define VFR(i) (bf16x8){vlo[i][0], vlo[i][1], vlo[i][2], vlo[i][3], vhi[i][0], vhi[i][1], vhi[i][2], vhi[i][3]}
#define VADR(i, half) (lds + ((va_ ^ ((((i) & 15) & 3) << 6)) + (16 * (((i) & 15) >> 2) + 8 * (half)) * 256))
#define VRD(i) do { if (!(VAR & 32) && (i) >= 0 && (i) < 16) { \
        if (VAR & 128) { const bf16x8 w_ = *(LAS const bf16x8*)(lds + (((va_ ^ ((((i) & 15) & 3) << 6)) + (16 * (((i) & 15) >> 2)) * 256) & ~15)); vlo[(i) & 15] = (s16x4){w_[0], w_[1], w_[2], w_[3]}; vhi[(i) & 15] = (s16x4){w_[4], w_[5], w_[6], w_[7]}; } \
        else if (VAR & 256) { vlo[(i) & 15] = *(LAS const s16x4*)VADR(i, 0); vhi[(i) & 15] = *(LAS const s16x4*)VADR(i, 1); } \
        else { vlo[(i) & 15] = vtr(VADR(i, 0)); vhi[(i) & 15] = vtr(VADR(i, 1)); } SBAR(); } } while (0)
#define KRD(G, j) do { if (!(VAR & 64) && (G)) { KLOAD2(ka_, j); SBAR(); } } while (0)
#define GAPA(MF, a0, a1, a2, a3, W0, W1, PW) do { MF; if (!(VAR & 16)) { sacc += a0; sacc2 += a1; sacc += a2; sacc2 += a3; PIN(sacc); PIN(sacc2); W0; W1; } PIN(PW); SBAR(); } while (0)
#define GAPB(j, X, i) do { VRD((j) + ATT_AHEAD); o[(j) & 3] = MFMA(PAF_((j) >> 2), VFR(j), o[(j) & 3]); if (!(VAR & 4)) { X[i] = __builtin_amdgcn_exp2f(X[i]); X[(i) + 1] = __builtin_amdgcn_exp2f(X[(i) + 1]); } PIN(X); SBAR(); } while (0)
#define PAF_(k) ((k) == 0 ? PAF(0) : (k) == 1 ? PAF(1) : (k) == 2 ? PAF(2) : PAF(3))
#define STEP(C0, C1, P0, P1, t, GK, GV, GL, MASK) do { SBAR(); \
    const int va_ = vb0 + sl_prev; const int ka_ = kb0 + sl_next; \
    float sacc = P0[0], sacc2 = P0[1]; \
    GAPA(C0 = MFMA(kf[0], qr[0], negm), P0[2], P0[3], P0[4], P0[5],     pw0[0] = PKW(P0, 0),  pw0[1] = PKW(P0, 2),  pw0); \
    GAPA(C1 = MFMA(kf[1], qr[0], negm), P0[6], P0[7], P0[8], P0[9],     pw0[2] = PKW(P0, 4),  pw0[3] = PKW(P0, 6),  pw0); \
    VRD(ATT_AHEAD - 6); GAPA(C0 = MFMA(kf[2], qr[1], C0),   P0[10], P0[11], P0[12], P0[13], pw1[0] = PKW(P0, 8),  pw1[1] = PKW(P0, 10), pw1); \
    VRD(ATT_AHEAD - 5); GAPA(C1 = MFMA(kf[3], qr[1], C1),   P0[14], P0[15], P1[0], P1[1],   pw1[2] = PKW(P0, 12), pw1[3] = PKW(P0, 14), pw1); \
    VRD(ATT_AHEAD - 4); GAPA(C0 = MFMA(kf[4], qr[2], C0),   P1[2], P1[3], P1[4], P1[5],     pw2[0] = PKW(P1, 0),  pw2[1] = PKW(P1, 2),  pw2); \
    VRD(ATT_AHEAD - 3); GAPA(C1 = MFMA(kf[5], qr[2], C1),   P1[6], P1[7], P1[8], P1[9],     pw2[2] = PKW(P1, 4),  pw2[3] = PKW(P1, 6),  pw2); \
    VRD(ATT_AHEAD - 2); GAPA(C0 = MFMA(kf[6], qr[3], C0),   P1[10], P1[11], P1[12], P1[13], pw3[0] = PKW(P1, 8),  pw3[1] = PKW(P1, 10), pw3); \
    VRD(ATT_AHEAD - 1); GAPA(C1 = MFMA(kf[7], qr[3], C1),   P1[14], P1[15], 0.f, 0.f,       pw3[2] = PKW(P1, 12), pw3[3] = PKW(P1, 14), pw3); \
    l_reg += sacc + sacc2; \
    if (!(VAR & 2)) { if (GK) DMA_K((t) + 3, sl_cur); if (GV) DMA_V((t) + 1, sl_next); }                                    \
    ATT_PAD(C0, C1); \
    if (MASK) { _Pragma("unroll") for (int r = 0; r < 16; ++r) { C0[r] = -INFINITY; C1[r] = -INFINITY; } }                                   \
    { const float rm = (VAR & 8) ? 0.f : rowmax(C0, C1); resc = false;                                                        \
      if (__builtin_expect(__any(rm > (float)ATT_THR), 0)) { const float dl = __builtin_fmaxf(rm, 0.f); mhat += dl;        \
          _Pragma("unroll") for (int r = 0; r < 16; ++r) { C0[r] -= dl; C1[r] -= dl; } \
          _Pragma("unroll") for (int r = 0; r < 16; ++r) negm[r] = -mhat; \
          asm volatile("" : "+v"(negm)); \
          const float f = __builtin_amdgcn_exp2f(-dl); l_reg *= f; if (hi == 0) wsf[r32] = f; resc = true; } } \
    SBAR(); \
    GAPB(0, C0, 0);  GAPB(1, C0, 2);  GAPB(2, C0, 4);  GAPB(3, C0, 6); \
    KRD(GL, 0); GAPB(4, C0, 8);  GAPB(5, C0, 10); KRD(GL, 1); GAPB(6, C0, 12); GAPB(7, C0, 14); \
    KRD(GL, 2); GAPB(8, C1, 0);  GAPB(9, C1, 2);  KRD(GL, 3); GAPB(10, C1, 4); GAPB(11, C1, 6); \
    GAPB(12, C1, 8); GAPB(13, C1, 10); GAPB(14, C1, 12); GAPB(15, C1, 14); \
    } while (0)
#define DRAIN(P0, P1, vs) do { float sacc = P0[0] + P0[1]; \
      _Pragma("unroll") for (int r = 2; r < 16; ++r) sacc += P0[r]; \
      _Pragma("unroll") for (int r = 0; r < 16; ++r) sacc += P1[r]; \
      l_reg += sacc; \
      pw0 = (v4u){PKW(P0, 0), PKW(P0, 2), PKW(P0, 4), PKW(P0, 6)}; pw1 = (v4u){PKW(P0, 8), PKW(P0, 10), PKW(P0, 12), PKW(P0, 14)}; \
      pw2 = (v4u){PKW(P1, 0), PKW(P1, 2), PKW(P1, 4), PKW(P1, 6)}; pw3 = (v4u){PKW(P1, 8), PKW(P1, 10), PKW(P1, 12), PKW(P1, 14)}; \
      const int va_ = vb0 + (vs); \
      _Pragma("unroll") for (int ks = 0; ks < 4; ++ks) { \
          _Pragma("unroll") for (int d = 0; d < 4; ++d) { \
              const s16x4 lo = vtr(lds + ((va_ ^ (d << 6)) + (16 * ks) * 256)); const s16x4 hh = vtr(lds + ((va_ ^ (d << 6)) + (16 * ks + 8) * 256)); \
              const bf16x8 vf = (bf16x8){lo[0], lo[1], lo[2], lo[3], hh[0], hh[1], hh[2], hh[3]}; \
              o[d] = MFMA(PAF_(ks), vf, o[d]); } SBAR(); } } while (0)
    int t = 1;
    for (; t + 5 < NT; t += 2) {
        STEP(pB0, pB1, pA0, pA1, t, true, true, true, false);     WAIT_BAR(4); RESC(); ROT();
        STEP(pA0, pA1, pB0, pB1, t + 1, true, true, true, false); WAIT_BAR(4); RESC(); ROT();
    }
    for (; t + 1 < NT; t += 2) {
        STEP(pB0, pB1, pA0, pA1, t, (t + 3 < NT), (t + 1 < NT), (t + 1 < NT), false);         ENDW(t);     RESC(); ROT();
        STEP(pA0, pA1, pB0, pB1, t + 1, (t + 4 < NT), (t + 2 < NT), (t + 2 < NT), false);     ENDW(t + 1); RESC(); ROT();
    }
    STEP(pB0, pB1, pA0, pA1, NT - 1, false, false, false, (wq < 2)); RESC();
    DRAIN(pB0, pB1, sl_cur);
    const float l_run = l_reg;
    __syncthreads();
#undef STEP
#undef DRAIN
#undef GAPA
#undef GAPB
#undef PAF_
#undef PAF
#undef PKW
#undef VFR
#undef VRD
#undef VADR
#undef KRD
#undef ENDW
#undef RESC
#undef KLOAD2
#undef ROT
#undef WAIT_BAR
#undef MFMA
#undef PIN
#undef SBAR
#undef DMA_K
#undef DMA_V
#undef RFL
    int tide = F.tid; asm volatile("" : "+v"(tide));
    const int lane_e = tide & 63, r32e = lane_e & 31, hie = lane_e >> 5;
    LAS float* wse = (LAS float*)(lds + WSF_OFF) + wid * 64;
    float lt; { float lo_, hh_; halves32(l_run, lo_, hh_); lt = lo_ + hh_; }
    CFENCE();
    if (hie == 0) wse[32 + r32e] = lt;
    CFENCE(); LDS_WAIT();
    {
        const float csc = c ? lam : 1.0f;
        LAS float* Xc = (LAS float*)(lds + c * XBYTES) + (wq * 32) * XROW + r32e;
#pragma unroll
        for (int g = 0; g < 4; ++g) { const f32x4 f = *(LAS const f32x4*)(wse + 32 + 8 * g + 4 * hie);
#pragma unroll
            for (int e = 0; e < 4; ++e) { const float sc = csc * __builtin_amdgcn_rcpf(f[e]); const int q = 8 * g + 4 * hie + e;
#pragma unroll
                for (int d = 0; d < 4; ++d) Xc[q * XROW + 32 * d] = o[d][4 * g + e] * sc; } }
    }
    __syncthreads();
    {
        const int row = tide >> 2, sg = tide & 3;
        const LAS float* x0 = (const LAS float*)lds + row * XROW + sg * 32;
        const LAS float* x1 = (const LAS float*)(lds + XBYTES) + row * XROW + sg * 32;
        f32x4 dv[8]; float ss = 0.f;
#pragma unroll
        for (int j = 0; j < 8; ++j) { dv[j] = *(const LAS f32x4*)(x0 + 4 * j) - *(const LAS f32x4*)(x1 + 4 * j); ss += (dv[j][0] * dv[j][0] + dv[j][1] * dv[j][1]) + (dv[j][2] * dv[j][2] + dv[j][3] * dv[j][3]); }
        ss += __builtin_bit_cast(float, __builtin_amdgcn_mov_dpp(__builtin_bit_cast(int, ss), 0xB1, 0xF, 0xF, true)); ss += __builtin_bit_cast(float, __builtin_amdgcn_mov_dpp(__builtin_bit_cast(int, ss), 0x4E, 0xF, 0xF, true));
        const float rs = (1.0f - LAMBDA_INIT) * __builtin_amdgcn_rsqf(ss * (1.0f / 128.0f) + EPS);
        bf16* yr = Q + (rowbase + qb * 128 + row) * HW + h * 128 + sg * 32;
        const float* sgp = subg + sg * 32;
#pragma unroll
        for (int j = 0; j < 4; ++j) { const f32x4 ga = *(const f32x4*)(sgp + 8 * j), gb = *(const f32x4*)(sgp + 8 * j + 4);
            v4u w; w.x = cvtpk(dv[2 * j][0] * rs * ga[0], dv[2 * j][1] * rs * ga[1]); w.y = cvtpk(dv[2 * j][2] * rs * ga[2], dv[2 * j][3] * rs * ga[3]);
            w.z = cvtpk(dv[2 * j + 1][0] * rs * gb[0], dv[2 * j + 1][1] * rs * gb[1]); w.w = cvtpk(dv[2 * j + 1][2] * rs * gb[2], dv[2 * j + 1][3] * rs * gb[3]);
            if (!(VAR & 1)) *(v4u*)(yr + 8 * j) = w; }
    }
    __syncthreads();
}
}

namespace sgu {
constexpr int VROW = 320, VN_BYTES = 128 * VROW;
constexpr int STAT_OFF = VN_BYTES;
__device__ __forceinline__ float dppx(float v, int ctrl_sel) {
    const int iv = __builtin_bit_cast(int, v);
    return __builtin_bit_cast(float, ctrl_sel == 0 ? __builtin_amdgcn_mov_dpp(iv, 0xB1, 0xF, 0xF, true) : ctrl_sel == 1 ? __builtin_amdgcn_mov_dpp(iv, 0x4E, 0xF, 0xF, true)
                                   : ctrl_sel == 2 ? __builtin_amdgcn_mov_dpp(iv, 0x141, 0xF, 0xF, true) : __builtin_amdgcn_mov_dpp(iv, 0x140, 0xF, 0xF, true));
}
__device__ __forceinline__ float wsum(float v) {
    v += dppx(v, 0); v += dppx(v, 1); v += dppx(v, 2); v += dppx(v, 3);
    const int iv = __builtin_bit_cast(int, v);
    return (__builtin_bit_cast(float, __builtin_amdgcn_readlane(iv, 0)) + __builtin_bit_cast(float, __builtin_amdgcn_readlane(iv, 16))) +
           (__builtin_bit_cast(float, __builtin_amdgcn_readlane(iv, 32)) + __builtin_bit_cast(float, __builtin_amdgcn_readlane(iv, 48)));
}
__device__ __forceinline__ void sgu_unit(const Frame& F, int blk, bf16* SU, const bf16* SV, const bf16* WSM, const float* lng, const float* lnb, const float* bs) {
    LAS unsigned char* lds = F.lds;
    int tid = F.tid; asm volatile("" : "+v"(tid));
    const int lane = tid & 63, r32 = lane & 31, hi = lane >> 5, wid = F.wave;
    const size_t R0 = (size_t)blk * 128;
    LAS float* stat = (LAS float*)(lds + STAT_OFF);
    { v4u wv[16];
#pragma unroll
      for (int i = 0; i < 16; ++i) wv[i] = *(const v4u*)(SV + (R0 + wid * 16 + i) * HW + lane * 8);
#pragma unroll
      for (int i = 0; i < 16; ++i) { const v4u w = wv[i];
        const float x[8] = {bf_lo(w.x), bf_hi(w.x), bf_lo(w.y), bf_hi(w.y), bf_lo(w.z), bf_hi(w.z), bf_lo(w.w), bf_hi(w.w)};
        float sm = 0.f;
#pragma unroll
        for (int e = 0; e < 8; ++e) sm += x[e];
        const float mu = wsum(sm) * (1.0f / 512.0f); float qv = 0.f;
#pragma unroll
        for (int e = 0; e < 8; ++e) { const float d = x[e] - mu; qv += d * d; }
        const float rstd = __builtin_amdgcn_rsqf(wsum(qv) * (1.0f / 512.0f) + EPS);
        if (lane == 0) { stat[2 * (wid * 16 + i)] = mu; stat[2 * (wid * 16 + i) + 1] = rstd; } } }
    __syncthreads();
    const int ib = wid & 3, chf = wid >> 2;
    const int grp = lane >> 4, qi = (lane & 15) >> 2, pi = lane & 3;
    const int vbase = (8 * (grp >> 1) + qi) * VROW + (16 * (grp & 1) + 4 * pi) * 2;
    for (int g = 0; g < 4; ++g) {
        { const int j = tid >> 2, sg = tid & 3; const float mu = stat[2 * j], rstd = stat[2 * j + 1];
          const bf16* src = SV + (R0 + j) * HW + g * 128 + sg * 32;
          v4u wv[4];
#pragma unroll
          for (int q = 0; q < 4; ++q) wv[q] = *(const v4u*)(src + q * 8);
#pragma unroll
          for (int q = 0; q < 4; ++q) { const v4u w = wv[q]; const int ch = g * 128 + sg * 32 + q * 8;
              const f32x4 ga = *(const f32x4*)(lng + ch), gb = *(const f32x4*)(lng + ch + 4), ba = *(const f32x4*)(lnb + ch), bb = *(const f32x4*)(lnb + ch + 4);
              v4u o;
              o.x = cvtpk((bf_lo(w.x) - mu) * rstd * ga[0] + ba[0], (bf_hi(w.x) - mu) * rstd * ga[1] + ba[1]);
              o.y = cvtpk((bf_lo(w.y) - mu) * rstd * ga[2] + ba[2], (bf_hi(w.y) - mu) * rstd * ga[3] + ba[3]);
              o.z = cvtpk((bf_lo(w.z) - mu) * rstd * gb[0] + bb[0], (bf_hi(w.z) - mu) * rstd * gb[1] + bb[1]);
              o.w = cvtpk((bf_lo(w.w) - mu) * rstd * gb[2] + bb[2], (bf_hi(w.w) - mu) * rstd * gb[3] + bb[3]);
              *(LAS v4u*)(lds + j * VROW + (sg * 32 + q * 8) * 2) = o; } }
        bf16x8 wf[8];
        { const bf16* Wg = WSM + (size_t)g * 128 * 128 + (size_t)(32 * ib + r32) * 128 + hi * 8;
#pragma unroll
          for (int s = 0; s < 8; ++s) wf[s] = *(const bf16x8*)(Wg + 16 * s); }
        bf16* sup = SU + (R0 + 32 * ib + r32) * HW + g * 128 + chf * 64 + 4 * hi;
        v2u sw[8];
#pragma unroll
        for (int k = 0; k < 8; ++k) sw[k] = *(const v2u*)(sup + (k >> 2) * 32 + (k & 3) * 8);
        const float bi = bs[g * 128 + 32 * ib + r32];
        __syncthreads();
        f32x16 acc[2]; acc[0] = (f32x16){}; acc[1] = (f32x16){};
#pragma unroll
        for (int s = 0; s < 8; ++s) {
#pragma unroll
            for (int cb = 0; cb < 2; ++cb) { const int cblk = 2 * chf + cb;
                const s16x4 lo = att::vtr(lds + vbase + (16 * s) * VROW + cblk * 64);
                const s16x4 hh = att::vtr(lds + vbase + (16 * s + 4) * VROW + cblk * 64);
                const bf16x8 vf = (bf16x8){lo[0], lo[1], lo[2], lo[3], hh[0], hh[1], hh[2], hh[3]};
                acc[cb] = __builtin_amdgcn_mfma_f32_32x32x16_bf16(vf, wf[s], acc[cb], 0, 0, 0); }
        }
#pragma unroll
        for (int k = 0; k < 8; ++k) { const int cb = k >> 2, q = k & 3; const v2u w = sw[k];
            const unsigned o0 = cvtpk(bf_lo(w.x) * (acc[cb][4 * q + 0] + bi), bf_hi(w.x) * (acc[cb][4 * q + 1] + bi));
            const unsigned o1 = cvtpk(bf_lo(w.y) * (acc[cb][4 * q + 2] + bi), bf_hi(w.y) * (acc[cb][4 * q + 3] + bi));
            *(v2u*)(sup + cb * 32 + q * 8) = (v2u){o0, o1}; }
        __syncthreads();
    }
}
}
namespace peer {
__device__ __forceinline__ float dpp_xor1(float v) { return __builtin_bit_cast(float, __builtin_amdgcn_mov_dpp(__builtin_bit_cast(int, v), 0xB1, 0xF, 0xF, true)); }
__device__ __forceinline__ float dpp_xor2(float v) { return __builtin_bit_cast(float, __builtin_amdgcn_mov_dpp(__builtin_bit_cast(int, v), 0x4E, 0xF, 0xF, true)); }
__device__ __forceinline__ void ins16(float (&L)[16], const float x, const float pinf) {
#pragma unroll
    for (int i = 15; i >= 1; --i) L[i] = __builtin_amdgcn_fmed3f(L[i - 1], L[i], x);
    L[0] = __builtin_amdgcn_fmed3f(L[0], x, pinf);
}
#define CE_(s, i, j) { const float a_ = s[i], b_ = s[j]; s[i] = __builtin_amdgcn_fmed3f(a_, b_, PINF); s[j] = __builtin_amdgcn_fmed3f(a_, b_, NINF); }
#define SORT16(s) do { CE_(s, 0, 1); CE_(s, 2, 3); CE_(s, 0, 2); CE_(s, 1, 3); CE_(s, 1, 2); CE_(s, 4, 5); CE_(s, 6, 7); CE_(s, 4, 6); CE_(s, 5, 7); CE_(s, 5, 6); CE_(s, 0, 4); CE_(s, 2, 6); CE_(s, 2, 4); CE_(s, 1, 5); CE_(s, 3, 7); CE_(s, 3, 5); CE_(s, 1, 2); CE_(s, 3, 4); CE_(s, 5, 6); CE_(s, 8, 9); CE_(s, 10, 11); CE_(s, 8, 10); CE_(s, 9, 11); CE_(s, 9, 10); CE_(s, 12, 13); CE_(s, 14, 15); CE_(s, 12, 14); CE_(s, 13, 15); CE_(s, 13, 14); CE_(s, 8, 12); CE_(s, 10, 14); CE_(s, 10, 12); CE_(s, 9, 13); CE_(s, 11, 15); CE_(s, 11, 13); CE_(s, 9, 10); CE_(s, 11, 12); CE_(s, 13, 14); CE_(s, 0, 8); CE_(s, 4, 12); CE_(s, 4, 8); CE_(s, 2, 10); CE_(s, 6, 14); CE_(s, 6, 10); CE_(s, 2, 4); CE_(s, 6, 8); CE_(s, 10, 12); CE_(s, 1, 9); CE_(s, 5, 13); CE_(s, 5, 9); CE_(s, 3, 11); CE_(s, 7, 15); CE_(s, 7, 11); CE_(s, 3, 5); CE_(s, 7, 9); CE_(s, 11, 13); CE_(s, 1, 2); CE_(s, 3, 4); CE_(s, 5, 6); CE_(s, 7, 8); CE_(s, 9, 10); CE_(s, 11, 12); CE_(s, 13, 14); } while (0)
#define BITONIC16(s) do { CE_(s, 0, 8); CE_(s, 1, 9); CE_(s, 2, 10); CE_(s, 3, 11); CE_(s, 4, 12); CE_(s, 5, 13); CE_(s, 6, 14); CE_(s, 7, 15); CE_(s, 0, 4); CE_(s, 1, 5); CE_(s, 2, 6); CE_(s, 3, 7); CE_(s, 8, 12); CE_(s, 9, 13); CE_(s, 10, 14); CE_(s, 11, 15); CE_(s, 0, 2); CE_(s, 1, 3); CE_(s, 4, 6); CE_(s, 5, 7); CE_(s, 8, 10); CE_(s, 9, 11); CE_(s, 12, 14); CE_(s, 13, 15); CE_(s, 0, 1); CE_(s, 2, 3); CE_(s, 4, 5); CE_(s, 6, 7); CE_(s, 8, 9); CE_(s, 10, 11); CE_(s, 12, 13); CE_(s, 14, 15); } while (0)
#define MERGE16(L, C) do { _Pragma("unroll") for (int i_ = 0; i_ < 16; ++i_) L[i_] = __builtin_amdgcn_fmed3f(L[i_], C[15 - i_], PINF); BITONIC16(L); } while (0)
__device__ __forceinline__ float tagf(float v, unsigned mask, unsigned tag) { return __builtin_bit_cast(float, (__builtin_bit_cast(unsigned, v) & ~mask) | tag); }
__device__ __forceinline__ float sel16(const float (&A)[16], int i) {
    float r = A[0];
#pragma unroll
    for (int k = 1; k < 16; ++k) { const float ak = A[k]; r = (i == k) ? ak : r; }
    return r;
}
__device__ __forceinline__ void topk_phase(const Frame& F) {
    const unsigned short* S = (const unsigned short*)(F.ws + WS_SCORES); const float* ssq = (const float*)(F.ws + WS_SSQ);
    float* GW = (float*)(F.ws + WS_GW);
    const int gw = F.vcu * NWAVES + F.wave, NGW = F.G * NWAVES, lane = F.lane;
    const int q = lane & 3;
    static_assert(T * PK_HEADS / 16 == NEXP, "two table rows per top-k wave-item");
    float PINF = __builtin_inff(), NINF = -__builtin_inff(); asm volatile("" : "+s"(PINF), "+s"(NINF));
    f32x4 g2v[4];
#pragma unroll
    for (int j = 0; j < 4; ++j) g2v[j] = *(const f32x4*)(F.in[17] + 16 * lane + 4 * j);
    for (int it = gw; it < T * PK_HEADS / 16; it += NGW) {
        const bool isu = it < NEXP / 2; const int e0 = isu ? 2 * it : 2 * it - NEXP;
        f32x4 tr0[4], tr1[4];
        const int th = it * 16 + (lane >> 2), t = th >> 3, h = th & 7;
        const unsigned short* sp = S + (size_t)t * 2048 + h * 256 + q * 64;
        typedef _Float16 h16x8 __attribute__((ext_vector_type(8)));
        h16x8 hv[8];
#pragma unroll
        for (int j = 0; j < 8; ++j) hv[j] = *(const h16x8*)(sp + 8 * j);
        float L[16];
#pragma unroll
        for (int e = 0; e < 8; ++e) { L[e] = tagf((float)hv[0][e], 127u, (unsigned)((q & 1) * 64 + e)); L[8 + e] = tagf((float)hv[1][e], 127u, (unsigned)((q & 1) * 64 + 8 + e)); }
        SORT16(L);
#pragma unroll
        for (int c4 = 1; c4 < 4; ++c4) { float C[16];
#pragma unroll
            for (int e = 0; e < 8; ++e) { C[e] = tagf((float)hv[2 * c4][e], 127u, (unsigned)((q & 1) * 64 + 16 * c4 + e)); C[8 + e] = tagf((float)hv[2 * c4 + 1][e], 127u, (unsigned)((q & 1) * 64 + 16 * c4 + 8 + e)); }
            SORT16(C); MERGE16(L, C); }
        __builtin_amdgcn_sched_barrier(0);
        { const float* src = (isu ? F.in[20] : F.in[21]) + (size_t)e0 * DM + 16 * lane;
#pragma unroll
          for (int j = 0; j < 4; ++j) { tr0[j] = *(const f32x4*)(src + 4 * j); tr1[j] = *(const f32x4*)(src + DM + 4 * j); } }
        __builtin_amdgcn_sched_barrier(0);
        { float P[16];
#pragma unroll
          for (int i = 0; i < 16; ++i) P[i] = dpp_xor1(L[i]);
          MERGE16(L, P); }
        float A[16], B[16];
        { const bool lowp = q < 2;
#pragma unroll
          for (int i = 0; i < 16; ++i) { const float o = dpp_xor2(L[i]); A[i] = lowp ? L[i] : o; B[i] = lowp ? o : L[i]; } }
        float Bc[16], W[16];
#pragma unroll
        for (int b = 0; b < 16; ++b) Bc[b] = tagf(B[b], 127u, 0u);
        { const float sa = tagf(A[0], 127u, 0u);
#pragma unroll
          for (int b = 0; b < 16; ++b) W[b] = tagf(sa + Bc[b], 255u, (unsigned)(255 - b)); }
        { const float sa = tagf(A[1], 127u, 0u);
#pragma unroll
          for (int i = 8; i < 16; ++i) W[i] = __builtin_amdgcn_fmed3f(W[i], tagf(sa + Bc[15 - i], 255u, (unsigned)(255 - (16 + 15 - i))), PINF);
          BITONIC16(W); }
#pragma unroll
        for (int a = 2; a < 16; ++a) { const float sa = tagf(A[a], 127u, 0u);
#pragma unroll
            for (int b = 0; b < 16; ++b) if ((a + 1) * (b + 1) <= 16) ins16(W, tagf(sa + Bc[b], 255u, (unsigned)(255 - (a * 16 + b))), PINF); }
        const f32x4 pq = *(const f32x4*)(ssq + (size_t)t * 16 + 4 * q);
        float pss = (pq[0] + pq[1]) + (pq[2] + pq[3]); pss += dpp_xor1(pss); pss += dpp_xor2(pss);
        const float rstd = 1.0f / sqrtf(pss * (1.0f / DM) + EPS);
        const float z0 = tagf(W[0], 255u, 0u) * rstd; float es = 0.f;
#pragma unroll
        for (int i = 0; i < 16; ++i) es += __expf(tagf(W[i], 255u, 0u) * rstd - z0);
        const float inv = 1.0f / es;
        int eo[4]; float go[4];
#pragma unroll
        for (int j = 0; j < 4; ++j) {
            const float w0 = W[j], w1 = W[4 + j], w2 = W[8 + j], w3 = W[12 + j];
            float w = w0; w = (q == 1) ? w1 : w; w = (q == 2) ? w2 : w; w = (q == 3) ? w3 : w;
            const unsigned bits = __builtin_bit_cast(unsigned, w);
            const int ai = 15 - (int)((bits >> 4) & 15), bi = 15 - (int)(bits & 15);
            const unsigned i1 = __builtin_bit_cast(unsigned, sel16(A, ai)) & 127u, i2 = __builtin_bit_cast(unsigned, sel16(B, bi)) & 127u;
            eo[j] = (int)(i1 * 128u + i2);
            go[j] = __expf(tagf(w, 255u, 0u) * rstd - z0) * inv;
        }
        typedef int i32x4 __attribute__((ext_vector_type(4)));
        *(v2u*)((unsigned*)(F.ws + WS_IDX16) + (size_t)t * 64 + h * 8 + 2 * q) = (v2u){(unsigned)eo[0] | ((unsigned)eo[1] << 16), (unsigned)eo[2] | ((unsigned)eo[3] << 16)};
        *(f32x4*)(GW + (size_t)t * 128 + h * 16 + 4 * q) = (f32x4){go[0], go[1], go[2], go[3]};
        if (isu) {
#pragma unroll
            for (int j = 0; j < 4; ++j) { tr0[j] = tr0[j] * g2v[j]; tr1[j] = tr1[j] * g2v[j]; } }
        table_row_store(F.ws, tr0, isu, e0, lane); table_row_store(F.ws, tr1, isu, e0 + 1, lane);
    }
    {
        unsigned char* X1Q = F.ws + WS_X1Q; float* X1S = (float*)(F.ws + WS_X1S);
        for (int t = gw; t < T; t += NGW) {
            f32x4 v[4]; float am = 0.f;
            { const bf16* xb = (const bf16*)(F.ws + WS_XB) + (size_t)t * DM + 16 * lane;
              const v4u w0 = *(const v4u*)xb, w1 = *(const v4u*)(xb + 8);
              v[0] = (f32x4){bf_lo(w0.x), bf_hi(w0.x), bf_lo(w0.y), bf_hi(w0.y)}; v[1] = (f32x4){bf_lo(w0.z), bf_hi(w0.z), bf_lo(w0.w), bf_hi(w0.w)};
              v[2] = (f32x4){bf_lo(w1.x), bf_hi(w1.x), bf_lo(w1.y), bf_hi(w1.y)}; v[3] = (f32x4){bf_lo(w1.z), bf_hi(w1.z), bf_lo(w1.w), bf_hi(w1.w)}; }
#pragma unroll
            for (int j = 0; j < 4; ++j) am = fmaxf(am, fmaxf(fmaxf(fabsf(v[j][0]), fabsf(v[j][1])), fmaxf(fabsf(v[j][2]), fabsf(v[j][3]))));
            am = fmaxf(am, __shfl_xor(am, 1)); am = fmaxf(am, __shfl_xor(am, 2)); am = fmaxf(am, __shfl_xor(am, 4));
            const float sx = am > 0.f ? 127.0f / am : 0.f;
            unsigned wq[4];
#pragma unroll
            for (int j = 0; j < 4; ++j) wq[j] = ((unsigned)__float2int_rn(v[j][0] * sx) & 0xffu) | (((unsigned)__float2int_rn(v[j][1] * sx) & 0xffu) << 8) | (((unsigned)__float2int_rn(v[j][2] * sx) & 0xffu) << 16) | (((unsigned)__float2int_rn(v[j][3] * sx) & 0xffu) << 24);
            *(v4u*)(X1Q + (size_t)t * DM + 16 * lane) = (v4u){wq[0], wq[1], wq[2], wq[3]};
            if ((lane & 7) == 0) X1S[(size_t)t * 8 + (lane >> 3)] = am * (1.0f / 127.0f);
        }
    }
}

__device__ __forceinline__ void unpack16(float (&f)[16], const v4u w) {
    f32x2 t;
    t = __builtin_amdgcn_cvt_pk_f32_fp8((int)w.x, false); f[0] = t[0]; f[1] = t[1]; t = __builtin_amdgcn_cvt_pk_f32_fp8((int)w.x, true); f[2] = t[0]; f[3] = t[1];
    t = __builtin_amdgcn_cvt_pk_f32_fp8((int)w.y, false); f[4] = t[0]; f[5] = t[1]; t = __builtin_amdgcn_cvt_pk_f32_fp8((int)w.y, true); f[6] = t[0]; f[7] = t[1];
    t = __builtin_amdgcn_cvt_pk_f32_fp8((int)w.z, false); f[8] = t[0]; f[9] = t[1]; t = __builtin_amdgcn_cvt_pk_f32_fp8((int)w.z, true); f[10] = t[0]; f[11] = t[1];
    t = __builtin_amdgcn_cvt_pk_f32_fp8((int)w.w, false); f[12] = t[0]; f[13] = t[1]; t = __builtin_amdgcn_cvt_pk_f32_fp8((int)w.w, true); f[14] = t[0]; f[15] = t[1];
}
__device__ __forceinline__ void unpack8x2(f32x2 (&t)[8], const v4u w) {
    t[0] = __builtin_amdgcn_cvt_pk_f32_fp8((int)w.x, false); t[1] = __builtin_amdgcn_cvt_pk_f32_fp8((int)w.x, true);
    t[2] = __builtin_amdgcn_cvt_pk_f32_fp8((int)w.y, false); t[3] = __builtin_amdgcn_cvt_pk_f32_fp8((int)w.y, true);
    t[4] = __builtin_amdgcn_cvt_pk_f32_fp8((int)w.z, false); t[5] = __builtin_amdgcn_cvt_pk_f32_fp8((int)w.z, true);
    t[6] = __builtin_amdgcn_cvt_pk_f32_fp8((int)w.w, false); t[7] = __builtin_amdgcn_cvt_pk_f32_fp8((int)w.w, true);
}
__device__ __forceinline__ float dot_pk(const v4u w, const f32x2 (&xx)[8]) {
    f32x2 t[8]; unpack8x2(t, w);
    f32x2 a = xx[0] * t[0], b = xx[1] * t[1];
    a = xx[2] * t[2] + a; b = xx[3] * t[3] + b; a = xx[4] * t[4] + a; b = xx[5] * t[5] + b; a = xx[6] * t[6] + a; b = xx[7] * t[7] + b;
    const f32x2 c = a + b; return c[0] + c[1];
}
__device__ __forceinline__ void axpy_pk(f32x2 (&acc)[8], const float cf, const v4u w) {
    f32x2 t[8]; unpack8x2(t, w); const f32x2 cv = (f32x2){cf, cf};
#pragma unroll
    for (int k = 0; k < 8; ++k) acc[k] = cv * t[k] + acc[k];
}
struct Slice { int p0, np, wrank, wcount; };
__device__ __forceinline__ Slice slice_of(const Frame& F) {
    Slice s; const int b = (int)blockIdx.x;
    if (F.G % 8 == 0) { s.p0 = b & 7; s.np = 1; s.wrank = (b >> 3) * NWAVES + F.wave; s.wcount = (F.G >> 3) * NWAVES; }
    else { s.p0 = 0; s.np = 8; s.wrank = b * NWAVES + F.wave; s.wcount = F.G * NWAVES; }
    return s;
}
typedef int i32x4 __attribute__((ext_vector_type(4)));
__device__ __forceinline__ void expert_u_phase(const Frame& F, const int tb, const int te) {
    const unsigned char* UQ = F.ws + WS_UQ; const int* IDX = (const int*)(F.ws + WS_IDX); bf16* PART = (bf16*)(F.ws + WS_PART);
    const unsigned char* X1Q = F.ws + WS_X1Q; const float* X1S = (const float*)(F.ws + WS_X1S);
    const int lane = F.lane, g = lane >> 3, i = lane & 7;
    const Slice sl = slice_of(F);
    for (int p = sl.p0; p < sl.p0 + sl.np; ++p) {
    const int tfirst = tb + sl.wrank;
    if (tfirst >= te) continue;
    const int tlast = tfirst + ((te - 1 - tfirst) / sl.wcount) * sl.wcount;
    const unsigned* ID16 = (const unsigned*)(F.ws + WS_IDX16);
    v4u ev[2]; i32x4 xq;
#pragma unroll
    for (int j = 0; j < 2; ++j) ev[j] = *(const v4u*)(ID16 + (size_t)tfirst * 64 + 8 * g + 4 * j);
    xq = *(const i32x4*)(X1Q + (size_t)tfirst * DM + 128 * p + 16 * i);
    for (int t = tfirst; t <= tlast; t += sl.wcount) {
        v4u w[16];
#pragma unroll
        for (int s = 0; s < 16; ++s) { const unsigned pk = ev[s >> 3][(s >> 1) & 3]; const unsigned e = (s & 1) ? (pk >> 16) : (pk & 0xffffu); w[s] = *(const v4u*)(UQ + (size_t)p * (NEXP * 128) + (size_t)e * 128 + 16 * i); }
        const int tn = (t + sl.wcount <= tlast) ? t + sl.wcount : tlast;
        v4u evn[2];
#pragma unroll
        for (int j = 0; j < 2; ++j) evn[j] = *(const v4u*)(ID16 + (size_t)tn * 64 + 8 * g + 4 * j);
        const i32x4 xqn = *(const i32x4*)(X1Q + (size_t)tn * DM + 128 * p + 16 * i);
        const float dq = X1S[(size_t)t * 8 + p];
        int part[16];
#pragma unroll
        for (int s = 0; s < 16; ++s) { int a = __builtin_amdgcn_sdot4((int)w[s].x, xq[0], 0, false); a = __builtin_amdgcn_sdot4((int)w[s].y, xq[1], a, false);
            a = __builtin_amdgcn_sdot4((int)w[s].z, xq[2], a, false); part[s] = __builtin_amdgcn_sdot4((int)w[s].w, xq[3], a, false); }
        { const bool up = (i & 4) != 0;
#pragma unroll
          for (int k = 0; k < 8; ++k) { const int lo_ = part[k], hi_ = part[k + 8]; const int keep = up ? hi_ : lo_, send = up ? lo_ : hi_; part[k] = keep + __shfl_xor(send, 4); } }
        { const bool up = (i & 2) != 0;
#pragma unroll
          for (int k = 0; k < 4; ++k) { const int lo_ = part[k], hi_ = part[k + 4]; const int keep = up ? hi_ : lo_, send = up ? lo_ : hi_; part[k] = keep + __builtin_amdgcn_mov_dpp(send, 0x4E, 0xF, 0xF, true); } }
        { const bool up = (i & 1) != 0;
#pragma unroll
          for (int k = 0; k < 2; ++k) { const int lo_ = part[k], hi_ = part[k + 2]; const int keep = up ? hi_ : lo_, send = up ? lo_ : hi_; part[k] = keep + __builtin_amdgcn_mov_dpp(send, 0xB1, 0xF, 0xF, true); } }
        *(unsigned*)(PART + ((size_t)p * T + t) * 128 + 16 * g + 2 * i) = cvtpk((float)part[0] * dq, (float)part[1] * dq);
        ev[0] = evn[0]; ev[1] = evn[1];
        xq = xqn;
    }
    }
}
__device__ __forceinline__ void expert_coef_phase(const Frame& F, const int tb, const int te) {
    const bf16* PART = (const bf16*)(F.ws + WS_PART); const float* GW = (const float*)(F.ws + WS_GW);
    const float* ssq = (const float*)(F.ws + WS_SSQ); const f32x2* SUV = (const f32x2*)(F.ws + WS_SUQ);
    bf16* COEF = (bf16*)(F.ws + WS_COEF); const unsigned short* ID16 = (const unsigned short*)(F.ws + WS_IDX16);
    const int gt = F.vcu * (NWAVES * 64) + F.tid, NGT = F.G * NWAVES * 64;
    for (int it8 = tb * 16 + gt; it8 < te * 16; it8 += NGT) {
        const int it = it8 * 8, t = it8 >> 4;
        v4u pp[8];
#pragma unroll
        for (int p = 0; p < 8; ++p) pp[p] = *(const v4u*)(PART + (size_t)p * T * 128 + it);
        const v4u idw = *(const v4u*)(ID16 + it);
        const f32x4 g0 = *(const f32x4*)(GW + it), g1 = *(const f32x4*)(GW + it + 4);
        float q = 0.f;
#pragma unroll
        for (int j = 0; j < 4; ++j) { const f32x4 v = *(const f32x4*)(ssq + (size_t)t * 16 + 4 * j); q += (v[0] + v[1]) + (v[2] + v[3]); }
        const float rstd = __builtin_amdgcn_rsqf(q * (1.0f / DM) + EPS);
        unsigned ids[8] = {idw.x & 0xffffu, idw.x >> 16, idw.y & 0xffffu, idw.y >> 16, idw.z & 0xffffu, idw.z >> 16, idw.w & 0xffffu, idw.w >> 16};
        float su[8], sv[8];
#pragma unroll
        for (int k = 0; k < 8; ++k) { const f32x2 s2 = SUV[ids[k]]; su[k] = s2[0]; sv[k] = s2[1]; }
        float s[8];
#pragma unroll
        for (int k = 0; k < 8; ++k) s[k] = 0.f;
#pragma unroll
        for (int p = 0; p < 8; ++p) { s[0] += bf_lo(pp[p].x); s[1] += bf_hi(pp[p].x); s[2] += bf_lo(pp[p].y); s[3] += bf_hi(pp[p].y); s[4] += bf_lo(pp[p].z); s[5] += bf_hi(pp[p].z); s[6] += bf_lo(pp[p].w); s[7] += bf_hi(pp[p].w); }
        const float gw[8] = {g0[0], g0[1], g0[2], g0[3], g1[0], g1[1], g1[2], g1[3]};
        float c[8];
#pragma unroll
        for (int k = 0; k < 8; ++k) c[k] = gelu1(s[k] * rstd * su[k]) * gw[k] * sv[k];
        *(v4u*)(COEF + it) = (v4u){cvtpk(c[0], c[1]), cvtpk(c[2], c[3]), cvtpk(c[4], c[5]), cvtpk(c[6], c[7])};
    }
}
__device__ __forceinline__ float bfly32(float keep_lo, float keep_hi) { asm("s_nop 1\n\tv_permlane32_swap_b32_e32 %0, %1" : "+v"(keep_lo), "+v"(keep_hi)); return keep_lo + keep_hi; }
__device__ __forceinline__ float bfly16(float keep_lo, float keep_hi) { asm("s_nop 1\n\tv_permlane16_swap_b32_e32 %0, %1" : "+v"(keep_lo), "+v"(keep_hi)); return keep_lo + keep_hi; }
__device__ __forceinline__ float dpp_ror8(float v) { return __builtin_bit_cast(float, __builtin_amdgcn_mov_dpp(__builtin_bit_cast(int, v), 0x128, 0xF, 0xF, true)); }
__device__ __forceinline__ float wave_sum_dpp(float v) {
    v += dpp_xor1(v); v += dpp_xor2(v);
    v += __builtin_bit_cast(float, __builtin_amdgcn_mov_dpp(__builtin_bit_cast(int, v), 0x141, 0xF, 0xF, true));
    v += __builtin_bit_cast(float, __builtin_amdgcn_mov_dpp(__builtin_bit_cast(int, v), 0x140, 0xF, 0xF, true));
    const int iv = __builtin_bit_cast(int, v);
    return (__builtin_bit_cast(float, __builtin_amdgcn_readlane(iv, 0)) + __builtin_bit_cast(float, __builtin_amdgcn_readlane(iv, 16))) +
           (__builtin_bit_cast(float, __builtin_amdgcn_readlane(iv, 32)) + __builtin_bit_cast(float, __builtin_amdgcn_readlane(iv, 48)));
}
__device__ __forceinline__ void expert_v_phase(const Frame& F, const int tb, const int te) {
    const unsigned* COEF = (const unsigned*)(F.ws + WS_COEF);
    float* SSQ2 = (float*)(F.ws + WS_SSQ2); const int lane = F.lane, g = lane >> 3, i = lane & 7;
    const Slice sl = slice_of(F);
    for (int p = sl.p0; p < sl.p0 + sl.np; ++p) {
    const int tfirst = tb + sl.wrank;
    if (tfirst >= te) continue;
    const int tlast = tfirst + ((te - 1 - tfirst) / sl.wcount) * sl.wcount;
    const unsigned* ID16 = (const unsigned*)(F.ws + WS_IDX16) + 8 * g;
    const unsigned char* VQs = F.ws + WS_VQ + (size_t)p * (NEXP * 128);
    const unsigned lo16 = 16u * i;
    const bf16* XBp = (const bf16*)(F.ws + WS_XB) + 128 * p + 16 * i + 2 * g;
    bf16* YBp = (bf16*)(F.ws + WS_YB) + 128 * p + 16 * i + 2 * g;
    const unsigned* CFp = COEF + 8 * g;
#define V_IDS(ev, tt) do { ev[0] = *(const v4u*)(ID16 + (size_t)(tt) * 64); ev[1] = *(const v4u*)(ID16 + (size_t)(tt) * 64 + 4); } while (0)
#define V_GATHER(W, cv, xw, ev, tt) do { \
        _Pragma("unroll") for (int s = 0; s < 16; ++s) { const unsigned pk = ev[s >> 3][(s >> 1) & 3]; const unsigned e = (s & 1) ? (pk >> 16) : (pk & 0xffffu); W[s] = *(const v4u*)(VQs + (e * 128u + lo16)); } \
        cv[0] = *(const v4u*)(CFp + (size_t)(tt) * 64); cv[1] = *(const v4u*)(CFp + (size_t)(tt) * 64 + 4); \
        xw = *(const unsigned*)(XBp + (size_t)(tt) * DM); } while (0)
#define V_COMPUTE(W, cv, xw, tt) do { \
        f32x2 acc2[8]; \
        _Pragma("unroll") for (int c = 0; c < 8; ++c) acc2[c] = (f32x2){0.f, 0.f}; \
        _Pragma("unroll") for (int s = 0; s < 16; ++s) { const unsigned pk = cv[s >> 3][(s >> 1) & 3]; axpy_pk(acc2, (s & 1) ? bf_hi(pk) : bf_lo(pk), W[s]); } \
        float acc[16]; \
        _Pragma("unroll") for (int c = 0; c < 8; ++c) { acc[2 * c] = acc2[c][0]; acc[2 * c + 1] = acc2[c][1]; } \
          \
        _Pragma("unroll") for (int k = 0; k < 8; ++k) acc[k] = bfly32(acc[k], acc[k + 8]); \
        _Pragma("unroll") for (int k = 0; k < 4; ++k) acc[k] = bfly16(acc[k], acc[k + 4]); \
        { const bool up = (g & 1) != 0; \
          _Pragma("unroll") for (int k = 0; k < 2; ++k) { const float lo_ = acc[k], hi_ = acc[k + 2]; const float keep = up ? hi_ : lo_, send = up ? lo_ : hi_; acc[k] = keep + dpp_ror8(send); } } \
        const float y0 = bf_lo(xw) + acc[0], y1 = bf_hi(xw) + acc[1]; \
        *(unsigned*)(YBp + (size_t)(tt) * DM) = cvtpk(y0, y1); \
        const float ss = wave_sum_dpp(y0 * y0 + y1 * y1); \
        if (lane == 0) SSQ2[(size_t)(tt) * 8 + p] = ss; } while (0)
#define V_STEP(Wc, cvc, xwc, tc, Wn, cvn, xwn, evn, evnn, tn, tnn) do { \
        V_IDS(evnn, tnn); \
        cvn[0] = *(const v4u*)(CFp + (size_t)(tn) * 64); cvn[1] = *(const v4u*)(CFp + (size_t)(tn) * 64 + 4); \
        xwn = *(const unsigned*)(XBp + (size_t)(tn) * DM); \
        __builtin_amdgcn_sched_barrier(0);                                             \
        f32x2 acc2[8]; \
        _Pragma("unroll") for (int c = 0; c < 8; ++c) acc2[c] = (f32x2){0.f, 0.f}; \
        _Pragma("unroll") for (int s = 0; s < 16; ++s) { \
            if (s < 8) { const unsigned pk = evn[s >> 2][s & 3]; Wn[2 * s] = *(const v4u*)(VQs + ((pk & 0xffffu) * 128u + lo16)); Wn[2 * s + 1] = *(const v4u*)(VQs + ((pk >> 16) * 128u + lo16)); }     \
            { const unsigned pk = cvc[s >> 3][(s >> 1) & 3]; axpy_pk(acc2, (s & 1) ? bf_hi(pk) : bf_lo(pk), Wc[s]); } \
            __builtin_amdgcn_sched_barrier(0); } \
        float acc[16]; \
        _Pragma("unroll") for (int c = 0; c < 8; ++c) { acc[2 * c] = acc2[c][0]; acc[2 * c + 1] = acc2[c][1]; } \
        _Pragma("unroll") for (int k = 0; k < 8; ++k) acc[k] = bfly32(acc[k], acc[k + 8]); \
        _Pragma("unroll") for (int k = 0; k < 4; ++k) acc[k] = bfly16(acc[k], acc[k + 4]); \
        { const bool up = (g & 1) != 0; \
          _Pragma("unroll") for (int k = 0; k < 2; ++k) { const float lo_ = acc[k], hi_ = acc[k + 2]; const float keep = up ? hi_ : lo_, send = up ? lo_ : hi_; acc[k] = keep + dpp_ror8(send); } } \
        const float y0 = bf_lo(xwc) + acc[0], y1 = bf_hi(xwc) + acc[1]; \
        *(unsigned*)(YBp + (size_t)(tc) * DM) = cvtpk(y0, y1); \
        const float ss = wave_sum_dpp(y0 * y0 + y1 * y1); \
        if (lane == 0) SSQ2[(size_t)(tc) * 8 + p] = ss; } while (0)
    v4u evA[2], evB[2], cvA[2], cvB[2], WA[16], WB[16]; unsigned xwA, xwB;
    int t = tfirst;
    V_IDS(evA, t);
    V_GATHER(WA, cvA, xwA, evA, t);
    { const int t1 = (t + sl.wcount <= tlast) ? t + sl.wcount : tlast; V_IDS(evB, t1); }
    for (;;) {
        { const int t1 = (t + sl.wcount <= tlast) ? t + sl.wcount : tlast, t2 = (t1 + sl.wcount <= tlast) ? t1 + sl.wcount : tlast;
          V_STEP(WA, cvA, xwA, t, WB, cvB, xwB, evB, evA, t1, t2); }
        if (t + sl.wcount > tlast) break;
        t += sl.wcount;
        { const int t1 = (t + sl.wcount <= tlast) ? t + sl.wcount : tlast, t2 = (t1 + sl.wcount <= tlast) ? t1 + sl.wcount : tlast;
          V_STEP(WB, cvB, xwB, t, WA, cvA, xwA, evA, evB, t1, t2); }
        if (t + sl.wcount > tlast) break;
        t += sl.wcount;
    }
#undef V_STEP
#undef V_IDS
#undef V_GATHER
#undef V_COMPUTE
    }
}
__device__ __forceinline__ void final_norm_phase(const Frame& F) {
    const float* SSQ2 = (const float*)(F.ws + WS_SSQ2); const float* gf = F.in[22]; float* out = F.out;
    const int gw = F.vcu * NWAVES + F.wave, NGW = F.G * NWAVES, lane = F.lane;
    f32x4 gv[4];
#pragma unroll
    for (int j = 0; j < 4; ++j) gv[j] = *((const f32x4*)gf + lane + 64 * j);
    for (int t = gw; t < T; t += NGW) {
        const f32x4 a = *(const f32x4*)(SSQ2 + (size_t)t * 8), b = *(const f32x4*)(SSQ2 + (size_t)t * 8 + 4);
        const float r = 1.0f / sqrtf(((a[0] + a[1]) + (a[2] + a[3]) + (b[0] + b[1]) + (b[2] + b[3])) * (1.0f / DM) + EPS);
        f32x4* row = (f32x4*)(out + (size_t)t * DM) + lane;
        const v2u* yr = (const v2u*)((const bf16*)(F.ws + WS_YB) + (size_t)t * DM) + lane;
        v2u yv[4];
#pragma unroll
        for (int j = 0; j < 4; ++j) yv[j] = yr[64 * j];
#pragma unroll
        for (int j = 0; j < 4; ++j) { const f32x4 v = {bf_lo(yv[j].x), bf_hi(yv[j].x), bf_lo(yv[j].y), bf_hi(yv[j].y)}; row[64 * j] = v * r * gv[j]; }
    }
}
}
struct Args { const float* in[23]; float* out; unsigned char* ws; };
constexpr int N_PHASES = 8;

template <int K> __device__ __forceinline__ void run_phase(Frame& F) {
    asm volatile("" : "+v"(F.tid), "+v"(F.lane));
    unsigned char* ws = F.ws;
    if constexpr (K == 0) { p0_prologue(F); }
    if constexpr (K == 13) { p0b_quant_weights(F); }
    if constexpr (K == 1) {
        pg8::Gemm g{(const pg8::bf16_t*)(ws + WS_XB), (const pg8::bf16_t*)(ws + WS_W1Q), T, N1, DM / 2};
        pg8::StaticOrder S; S.init(T, N1, F.G, (int)blockIdx.x);
        EpiP1 E{ws, F.in[15], (const float*)(ws + WS_ROPE), (const float*)(ws + WS_XS), (const float*)(ws + WS_WSC)};
        pg8::gemm_phase<EpiP1, pg8::StaticOrder, true, true>(F.lds, g, S, E);
    }
    if constexpr (K == 2) {
        const float lam = ((const float*)(ws + WS_MISC))[0];
        for (int pi = F.vcu; pi < 512; pi += F.G) {
            const int bh = pi >> 5, s = pi & 31;
            att::attn_unit<0>(F, bh >> 2, bh & 3, 63 - s, (bf16*)(ws + WS_Q), (const bf16*)(ws + WS_K), (const bf16*)(ws + WS_V), lam, F.in[7]);
            att::attn_unit<0>(F, bh >> 2, bh & 3, s, (bf16*)(ws + WS_Q), (const bf16*)(ws + WS_K), (const bf16*)(ws + WS_V), lam, F.in[7]);
        }
#ifndef NO_SGU
        for (int u = F.vcu; u < T / 128; u += F.G)
            sgu::sgu_unit(F, u, (bf16*)(ws + WS_SU), (const bf16*)(ws + WS_SV), (const bf16*)(ws + WS_WSM), F.in[8], F.in[9], F.in[11]);
#endif
    }
#ifdef ATT_PROBE
    if constexpr (K == 11) {
        const float lam = ((const float*)(ws + WS_MISC))[0];
        for (int pi = F.vcu; pi < 512; pi += F.G) {
            const int bh = pi >> 5, s = pi & 31;
            att::attn_unit<ATT_PROBE>(F, bh >> 2, bh & 3, 63 - s, (bf16*)(ws + WS_Q), (const bf16*)(ws + WS_K), (const bf16*)(ws + WS_V), lam, F.in[7]);
            att::attn_unit<ATT_PROBE>(F, bh >> 2, bh & 3, s, (bf16*)(ws + WS_Q), (const bf16*)(ws + WS_K), (const bf16*)(ws + WS_V), lam, F.in[7]);
        }
    }
#endif
    if constexpr (K == 3) {
#ifdef P3_STAGGER
        if (F.vcu & 1) { for (int i_ = 0; i_ < P3_STAGGER; ++i_) __builtin_amdgcn_s_sleep(127); }
#endif
        pg8::Gemm g{(const pg8::bf16_t*)(ws + WS_Q), (const pg8::bf16_t*)(ws + WS_WAB), 2 * T, 2048, 512};
        BranchOrder S; S.so.init(T, DM, F.G, (int)blockIdx.x);
        EpiGate E{(bf16*)(ws + WS_G), (const unsigned char*)(ws + WS_GATES)};
        pg8::gemm_phase<EpiGate, BranchOrder, true, true>(F.lds, g, S, E);
    }
    if constexpr (K == 4) {
        pg8::Gemm g{(const pg8::bf16_t*)(ws + WS_G), (const pg8::bf16_t*)(ws + WS_WO2), T, DM, DM};
        pg8::StaticOrder S; S.init(T, DM, F.G, (int)blockIdx.x);
        EpiX1 E{F.in[0], F.out, (bf16*)(ws + WS_XB), (float*)(ws + WS_SSQ)};
        pg8::gemm_phase<EpiX1, pg8::StaticOrder, true, true>(F.lds, g, S, E);
    }
    if constexpr (K == 5) {
        pg8::Gemm g{(const pg8::bf16_t*)(ws + WS_XB), (const pg8::bf16_t*)(ws + WS_WEF), T, 2048, DM};
        pg8::StaticOrder S; S.init(T, 2048, F.G, (int)blockIdx.x);
        EpiScores E{(unsigned short*)(ws + WS_SCORES)};
        pg8::gemm_phase<EpiScores, pg8::StaticOrder, true, true>(F.lds, g, S, E);
    }
    if constexpr (K == 6) { peer::topk_phase(F); }
    if constexpr (K == 7) { peer::expert_u_phase(F, 0, T); }
    if constexpr (K == 8) { peer::expert_coef_phase(F, 0, T); }
    if constexpr (K == 9) { peer::expert_v_phase(F, 0, T); }
    if constexpr (K == 10) { peer::final_norm_phase(F); }
}

#ifndef PROGRAM
#define PROGRAM P(0) S0 P(13) S P(1) S P(2) S P(3) S P(4) S P(5) S P(6) S P(7) S P(8) S P(9) S P(10)
#endif

__global__ void __launch_bounds__(NWAVES * 64, 2) mk_fwd(Args args) {
    extern __shared__ __attribute__((aligned(16))) unsigned char lds[];
    cg::grid_group grid = cg::this_grid();
    Frame F;
    F.lds = (LAS unsigned char*)lds;
    F.tid = threadIdx.x; F.lane = F.tid & 63; F.wave = __builtin_amdgcn_readfirstlane(F.tid >> 6);
    F.G = gridDim.x; { const int bx = blockIdx.x; F.vcu = (F.G % 8 == 0) ? (bx % 8) * (F.G / 8) + bx / 8 : bx; }
#pragma unroll
    for (int i = 0; i < 23; ++i) F.in[i] = args.in[i];
    F.out = args.out; F.ws = args.ws;
    volatile LAS unsigned* bst = (volatile LAS unsigned*)(F.lds + BAR_LDS_OFF);
    if (F.tid < 2) bst[F.tid] = 0u;
    __syncthreads();
    const XcdBarrier bar = xcd_barrier_post((unsigned*)(F.ws + WS_CTL) + CW_BAR, bst);
#define P(k) run_phase<k>(F);
#define S0 { __syncthreads(); grid.sync(); }
#define S { xcd_barrier(bar); }
    PROGRAM
#undef P
#undef S
#undef S0
}

#if DBG
struct DumpEnt { unsigned long long off; unsigned n; int type; };
struct DumpArgs { DumpEnt e[10]; int cnt; int pad; unsigned char* ws; float* out; };
__global__ void dbg_dump(DumpArgs a) {
    const unsigned NOUT = (unsigned)T * DM;
    for (unsigned i = blockIdx.x * blockDim.x + threadIdx.x; i < NOUT; i += gridDim.x * blockDim.x) {
        float acc = 0.f;
        for (int k = 0; k < a.cnt; ++k) {
            const DumpEnt en = a.e[k];
            const unsigned char* base = (en.off == ~0ull) ? (const unsigned char*)a.out : a.ws + en.off;
            for (unsigned j = i; j < en.n; j += NOUT) {
                float v;
                if (en.type == 0) v = bf2f(((const bf16*)base)[j]); else if (en.type == 1) v = ((const float*)base)[j]; else v = (float)((const int*)base)[j];
                acc += v;
            }
        }
        a.out[i] = acc;
    }
}
#endif
extern "C" void kernel_launch(void* const* d_in, const int* in_sizes, int n_in, void* d_out, int out_size, void* d_ws, size_t ws_size, hipStream_t stream) {
    static int grid = 0;
    if (grid == 0) {
        if (n_in != 23 || in_sizes[0] != T * DM || out_size != T * DM || ws_size < WS_END) { fprintf(stderr, "kernel_launch: unexpected shapes (n_in %d, in0 %d, out %d, ws %zu)\n", n_in, n_in > 0 ? in_sizes[0] : -1, out_size, ws_size); grid = -1; return; }
        int dev = 0, cus = 0, per_cu = 0;
        if (hipGetDevice(&dev) != hipSuccess || hipDeviceGetAttribute(&cus, hipDeviceAttributeMultiprocessorCount, dev) != hipSuccess) { grid = -1; return; }
        if (hipFuncSetAttribute((const void*)mk_fwd, hipFuncAttributeMaxDynamicSharedMemorySize, LDS_BYTES) != hipSuccess) { fprintf(stderr, "kernel_launch: hipFuncSetAttribute failed\n"); grid = -1; return; }
        if (hipOccupancyMaxActiveBlocksPerMultiprocessor(&per_cu, (const void*)mk_fwd, NWAVES * 64, LDS_BYTES) != hipSuccess || per_cu < 1) { fprintf(stderr, "kernel_launch: occupancy query says %d\n", per_cu); per_cu = 1; }
        (void)hipGetLastError();
        grid = cus;
    }
    if (grid < 0) return;
    if (hipMemsetAsync((char*)d_ws + WS_CTL, 0, CTL_ZERO_BYTES, stream) != hipSuccess) { fprintf(stderr, "kernel_launch: hipMemsetAsync failed\n"); return; }
    Args a{};
    for (int i = 0; i < 23; ++i) a.in[i] = (const float*)d_in[i];
    a.out = (float*)d_out; a.ws = (unsigned char*)d_ws;
    void* kargs[] = {&a};
    hipError_t e = hipLaunchCooperativeKernel((const void*)mk_fwd, dim3(grid), dim3(NWAVES * 64), kargs, LDS_BYTES, stream);
    if (e != hipSuccess) fprintf(stderr, "kernel_launch: cooperative launch failed: %s (grid %d)\n", hipGetErrorString(e), grid);
#if DBG
    const int last_phase = (DBG - 1) % 10;
#endif
#if DBG
    {
        DumpArgs d{}; d.ws = (unsigned char*)d_ws; d.out = (float*)d_out; int c = 0;
        auto add = [&](unsigned long long off, unsigned n, int type) { d.e[c].off = off; d.e[c].n = n; d.e[c].type = type; ++c; };
        const unsigned M1 = 1u << 20;
        switch (last_phase) {
            case 0: if (DBG >= 10) { add(WS_W1T, 4608 * 1024, 0); break; } add(WS_XB, 32 * M1, 0); add(WS_W1T, 4608 * 1024, 0); add(WS_WAB, M1, 0); add(WS_WO2, 2 * M1, 0); add(WS_WEF, 2 * M1, 0);  add(WS_ROPE, 512 * 1024, 1); add(WS_WSM, 65536, 0); add(WS_MISC, 1, 1); break;
            case 1: if (DBG < 10) { add(WS_Q, 16 * M1, 0); add(WS_SU, 16 * M1, 0); add(WS_GATES, 64 * M1, 0); add(WS_K, 16 * M1, 0); add(WS_V, 16 * M1, 0); add(WS_SV, 16 * M1, 0); }
                    else if (DBG < 20) add(WS_GATES, 64 * M1, 0);
                    else if (DBG < 30) { add(WS_Q, 16 * M1, 0); add(WS_K, 16 * M1, 0); }
                    else if (DBG < 40) { add(WS_V, 16 * M1, 0); }
                    else { add(WS_SU, 16 * M1, 0); add(WS_SV, 16 * M1, 0); } break;
            case 2: if (DBG < 10) { add(WS_Q, 16 * M1, 0); add(WS_SU, 16 * M1, 0); } else if (DBG < 20) add(WS_Q, 16 * M1, 0); else add(WS_SU, 16 * M1, 0); break;
            case 3: add(WS_G, 64 * M1, 0); break;
            case 4: add(~0ull, 32 * M1, 1); add(WS_XB, 32 * M1, 0); add(WS_SSQ, 512 * 1024, 1); break;
            case 5: add(WS_SCORES, 64 * M1, 1); break;
            case 6: add(WS_IDX, 4 * M1, 2); add(WS_GW, 4 * M1, 1); break;
            default: break;
        }
        d.cnt = c;
        if (c) hipLaunchKernelGGL(dbg_dump, dim3(2048), dim3(256), 0, stream, d);
    }
#endif
}
```

```cpp
#include <hip/hip_runtime.h>
#include <hip/hip_cooperative_groups.h>
#include <cstdio>
#include <cstdint>
#include <type_traits>
namespace cg = cooperative_groups;

#ifndef DBG
#define DBG 0
#endif
#define ATT_AHEAD 4
namespace pg8 {
#define PG8_LAS __attribute__((address_space(3)))
typedef unsigned short bf16_t;
typedef short bf16x8 __attribute__((ext_vector_type(8)));
typedef float f32x4 __attribute__((ext_vector_type(4)));
typedef unsigned u32x4 __attribute__((ext_vector_type(4)));
constexpr int BM = 256, BK = 64, HALF = 128, HTB = HALF * BK * 2  , STAGE_BYTES = 8 * HTB, NXCD = 8, WGM = 8;

__host__ __device__ __forceinline__ int lds_byte(int r, int c) { const int st = (r >> 4) * 2 + (c >> 5), rr = r & 15, cc = c & 31, ob = rr * 64 + cc * 2; return st * 1024 + (ob ^ (((ob >> 9) & 1) << 5)); }
__host__ __device__ __forceinline__ void stage_rc(int b, int& R, int& C) { const int st = b / 1024, sb = b % 1024, swz = sb ^ (((sb >> 9) & 1) << 5); R = (st >> 1) * 16 + swz / 64; C = (st & 1) * 32 + (swz % 64) / 2; }
__host__ __device__ __forceinline__ int perm32(int rho) { const int n = rho >> 4, i = rho & 15; return 8 * (i >> 2) + 4 * n + (i & 3); }

struct Unit { int pm, pn; };
struct Gemm { const bf16_t* A; const bf16_t* Bt; int M, N, K; };

struct StaticOrder {
    int nM, nN, nwg, G, c;
    __host__ __device__ void init(int M, int N, int G_, int c_) { nM = M / BM; nN = N / BM; nwg = nM * nN; G = G_; c = c_; }
    __host__ __device__ bool next(int i, Unit& u) const {
        const long L = (long)i * G + c; if (L >= nwg) return false;
        int wgid = (int)L; { const int q = nwg / NXCD, r = nwg % NXCD, xcd = wgid % NXCD, off = wgid / NXCD; wgid = (xcd < r ? xcd * (q + 1) : r * (q + 1) + (xcd - r) * q) + off; }
        const int nig = WGM * nN, gid = wgid / nig, fm = gid * WGM, gsz = (nM - fm) < WGM ? (nM - fm) : WGM;
        u.pm = fm + ((wgid % nig) % gsz); u.pn = (wgid % nig) / gsz; return true;
    }
    __device__ __forceinline__ void a_ready(const Unit&) const {}
    __device__ __forceinline__ void done(const Unit&) const {}
};

__device__ __forceinline__ unsigned cvt_pk_bf16(float lo, float hi) { unsigned r; asm volatile("v_cvt_pk_bf16_f32 %0, %1, %2" : "=v"(r) : "v"(lo), "v"(hi)); return r; }
typedef float f32x2 __attribute__((ext_vector_type(2)));
__device__ __forceinline__ f32x2 gelu_pk(f32x2 v) {
    const f32x2 av = __builtin_elementwise_abs(v), d = av * 0.2316418882f + 1.0f;
    f32x2 t; t.x = __builtin_amdgcn_rcpf(d.x); t.y = __builtin_amdgcn_rcpf(d.y);
    f32x2 q = t * 0.5307027145f + (-0.7265760135f); q = q * t + 0.7107068705f; q = q * t + (-0.142248368f); q = q * t + 0.127414796f; q = q * t;
    const f32x2 s = (v * v) * (-0.72134752044f);
    f32x2 e; e.x = __builtin_amdgcn_exp2f(s.x); e.y = __builtin_amdgcn_exp2f(s.y);
    const f32x2 m = v * (q * e), r = v - m;
    f32x2 o; o.x = v.x < 0.f ? m.x : r.x; o.y = v.y < 0.f ? m.y : r.y; return o;
}

typedef int i32x4 __attribute__((ext_vector_type(4)));
template <class Epi, class Sched, bool ALIGN_EPI = false, bool SP2 = false>
__device__ __forceinline__ void gemm_phase(PG8_LAS unsigned char* lds, const Gemm g, const Sched& S, const Epi& E) {
    int tid_ = threadIdx.x; asm volatile("" : "+v"(tid_));
    const int tid = tid_, wid = __builtin_amdgcn_readfirstlane(tid >> 6), lane = tid & 63, wr = wid >> 2, wc = wid & 3, fr = lane & 15, fq = lane >> 4;
    const int K = g.K, nt = K / BK;
    unsigned voffA[2], voffB[2];
#pragma unroll
    for (int i = 0; i < 2; ++i) { int R, C; stage_rc(tid * 16 + i * 8192, R, C); const int Rb = Epi::PERM ? ((R & ~31) + perm32(R & 31)) : R;
        voffA[i] = (unsigned)(R * K + C) * 2u; voffB[i] = (unsigned)(Rb * K + C) * 2u; }
    const size_t kstep = (size_t)(BK * 2);
    const size_t hstep = (size_t)HALF * K * 2;
    const size_t tstep = 2 * hstep;
    const unsigned ldsw = (unsigned)wid * 1024u;
    const int aoff = lds_byte(wr * 64 + fr, fq * 8), boff = lds_byte(wc * 32 + fr, fq * 8);
#define PG8_SA(b, h) (((b) * 2 + (h)) * HTB)
#define PG8_SB(b, h) ((4 + (b) * 2 + (h)) * HTB)
#define PG8_STAGE(bufoff, gbase, voff) do { _Pragma("unroll") for (int _i = 0; _i < 2; ++_i) \
        __builtin_amdgcn_global_load_lds((const unsigned*)((const char*)(gbase) + (voff)[_i]), (PG8_LAS unsigned*)(lds + (bufoff) + ldsw + _i * 8192), 16, 0, 0); } while (0)
#define PG8_LDA(dst, b, h) do { _Pragma("unroll") for (int m = 0; m < 4; ++m) _Pragma("unroll") for (int k = 0; k < 2; ++k) dst[m][k] = *(const PG8_LAS bf16x8*)(lds + PG8_SA(b, h) + aoff + m * 2048 + k * 1024); } while (0)
#define PG8_LDB(dst, b, h) do { _Pragma("unroll") for (int n = 0; n < 2; ++n) _Pragma("unroll") for (int k = 0; k < 2; ++k) dst[n][k] = *(const PG8_LAS bf16x8*)(lds + PG8_SB(b, h) + boff + n * 2048 + k * 1024); } while (0)
#define PG8_MMA(ai, bj, At, Bt) do { __builtin_amdgcn_s_setprio(1); _Pragma("unroll") for (int m = 0; m < 4; ++m) _Pragma("unroll") for (int n = 0; n < 2; ++n) _Pragma("unroll") for (int k = 0; k < 2; ++k) \
        { if constexpr (Epi::I8) acc[ai][bj][m][n] = __builtin_amdgcn_mfma_i32_16x16x64_i8(__builtin_bit_cast(i32x4, Bt[n][k]), __builtin_bit_cast(i32x4, At[m][k]), acc[ai][bj][m][n], 0, 0, 0); \
          else acc[ai][bj][m][n] = __builtin_amdgcn_mfma_f32_16x16x32_bf16(Bt[n][k], At[m][k], acc[ai][bj][m][n], 0, 0, 0); } __builtin_amdgcn_s_setprio(0); } while (0)
#define PG8_WAIT_V(n) asm volatile("s_waitcnt vmcnt(" #n ")" ::: "memory")
#define PG8_WAIT_L(n) asm volatile("s_waitcnt lgkmcnt(" #n ")" ::: "memory")
#define PG8_BAR __builtin_amdgcn_s_barrier()
#define PG8_SCHED __builtin_amdgcn_sched_barrier(0)
    Unit cur, nxt; int ui = 0;
    if (!S.next(0, cur)) return;
    typedef typename std::conditional<Epi::I8, i32x4, f32x4>::type acc_t;
    acc_t acc[2][2][4][2];
#pragma unroll
    for (int a = 0; a < 2; ++a)
#pragma unroll
        for (int b = 0; b < 2; ++b)
#pragma unroll
            for (int m = 0; m < 4; ++m)
#pragma unroll
                for (int n = 0; n < 2; ++n) acc[a][b][m][n] = (acc_t){0, 0, 0, 0};
    bf16x8 At[4][2], B0[2][2], B1[2][2];
    const char* cA = (const char*)g.A + (size_t)cur.pm * tstep; const char* cB = (const char*)g.Bt + (size_t)cur.pn * tstep;
    S.a_ready(cur);
    if constexpr (SP2) {
        PG8_STAGE(PG8_SB(0, 0), cB, voffB); PG8_STAGE(PG8_SB(0, 1), cB + hstep, voffB); PG8_STAGE(PG8_SA(0, 0), cA, voffA); PG8_STAGE(PG8_SA(0, 1), cA + hstep, voffA);
        if (wr == 1) PG8_BAR;
        PG8_WAIT_V(2); PG8_BAR;
        PG8_STAGE(PG8_SB(1, 0), cB + kstep, voffB); PG8_STAGE(PG8_SA(1, 0), cA + kstep, voffA); PG8_STAGE(PG8_SB(1, 1), cB + hstep + kstep, voffB);
        PG8_WAIT_V(6); PG8_BAR;
    } else {
        PG8_STAGE(PG8_SB(0, 0), cB, voffB); PG8_STAGE(PG8_SA(0, 0), cA, voffA); PG8_STAGE(PG8_SB(0, 1), cB + hstep, voffB); PG8_STAGE(PG8_SA(0, 1), cA + hstep, voffA);
        if (wr == 1) PG8_BAR;
        PG8_WAIT_V(4); PG8_BAR;
        PG8_STAGE(PG8_SB(1, 0), cB + kstep, voffB); PG8_STAGE(PG8_SA(1, 0), cA + kstep, voffA); PG8_STAGE(PG8_SB(1, 1), cB + hstep + kstep, voffB);
        PG8_WAIT_V(6); PG8_BAR;
    }
    for (;;) {
        const bool has_next = S.next(ui + 1, nxt);
        const char* nA = has_next ? (const char*)g.A + (size_t)nxt.pm * tstep : cA; const char* nB = has_next ? (const char*)g.Bt + (size_t)nxt.pn * tstep : cB;
        for (int t = 0; t < nt; t += 2) {
            const bool last = (t == nt - 2);
            const char* a1 = cA + (size_t)(t + 1) * kstep;
            const char* a2 = last ? nA : cA + (size_t)(t + 2) * kstep; const char* b2 = last ? nB : cB + (size_t)(t + 2) * kstep;
            const char* a3 = a2 + kstep; const char* b3 = b2 + kstep;
            if (last && has_next) S.a_ready(nxt);
            if constexpr (SP2) {
            PG8_LDB(B0, 0, 0); PG8_LDB(B1, 0, 1); PG8_SCHED; PG8_LDA(At, 0, 0); PG8_STAGE(PG8_SA(1, 1), a1 + hstep, voffA);
            PG8_WAIT_V(8); PG8_WAIT_L(0); PG8_BAR; PG8_MMA(0, 0, At, B0); PG8_MMA(0, 1, At, B1); PG8_BAR; PG8_SCHED;
            PG8_LDA(At, 0, 1); PG8_STAGE(PG8_SB(0, 0), b2, voffB); PG8_STAGE(PG8_SB(0, 1), b2 + hstep, voffB); PG8_STAGE(PG8_SA(0, 0), a2, voffA);
            PG8_WAIT_V(8); PG8_WAIT_L(0); PG8_BAR; PG8_MMA(1, 0, At, B0); PG8_MMA(1, 1, At, B1); PG8_BAR; PG8_SCHED;
            PG8_LDB(B0, 1, 0); PG8_LDB(B1, 1, 1); PG8_SCHED; PG8_LDA(At, 1, 0); PG8_STAGE(PG8_SA(0, 1), a2 + hstep, voffA);
            PG8_WAIT_V(8); PG8_WAIT_L(0); PG8_BAR; PG8_MMA(0, 0, At, B0); PG8_MMA(0, 1, At, B1); PG8_BAR; PG8_SCHED;
            PG8_LDA(At, 1, 1); PG8_STAGE(PG8_SB(1, 0), b3, voffB); PG8_STAGE(PG8_SB(1, 1), b3 + hstep, voffB); PG8_STAGE(PG8_SA(1, 0), a3, voffA);
            PG8_WAIT_V(8); PG8_WAIT_L(0); PG8_BAR; PG8_MMA(1, 0, At, B0); PG8_MMA(1, 1, At, B1); PG8_BAR; PG8_SCHED;
            } else {
            PG8_LDB(B0, 0, 0); PG8_SCHED; PG8_LDA(At, 0, 0); PG8_STAGE(PG8_SA(1, 1), a1 + hstep, voffA);
            PG8_WAIT_L(8); PG8_BAR; PG8_WAIT_L(0); PG8_MMA(0, 0, At, B0); PG8_BAR; PG8_SCHED;
            PG8_LDB(B1, 0, 1); PG8_STAGE(PG8_SB(0, 0), b2, voffB);
            PG8_BAR; PG8_WAIT_L(0); PG8_MMA(0, 1, At, B1); PG8_BAR;
            PG8_LDA(At, 0, 1); PG8_STAGE(PG8_SA(0, 0), a2, voffA);
            PG8_BAR; PG8_WAIT_L(0); PG8_MMA(1, 0, At, B0); PG8_BAR; PG8_SCHED;
            PG8_STAGE(PG8_SB(0, 1), b2 + hstep, voffB);
            PG8_WAIT_V(6); PG8_BAR; PG8_MMA(1, 1, At, B1); PG8_BAR;
            PG8_LDB(B0, 1, 0); PG8_SCHED; PG8_LDA(At, 1, 0); PG8_STAGE(PG8_SA(0, 1), a2 + hstep, voffA);
            PG8_WAIT_L(8); PG8_BAR; PG8_WAIT_L(0); PG8_MMA(0, 0, At, B0); PG8_BAR; PG8_SCHED;
            PG8_LDB(B1, 1, 1); PG8_STAGE(PG8_SB(1, 0), b3, voffB);
            PG8_BAR; PG8_WAIT_L(0); PG8_MMA(0, 1, At, B1); PG8_BAR;
            PG8_LDA(At, 1, 1); PG8_STAGE(PG8_SA(1, 0), a3, voffA);
            PG8_BAR; PG8_WAIT_L(0); PG8_MMA(1, 0, At, B0); PG8_BAR; PG8_SCHED;
            PG8_STAGE(PG8_SB(1, 1), b3 + hstep, voffB);
            PG8_WAIT_V(6); PG8_BAR; PG8_MMA(1, 1, At, B1); PG8_BAR;
            }
        }
        if constexpr (ALIGN_EPI) { if (wr == 0) PG8_BAR; }
        if constexpr (!Epi::AFTER_DRAIN) { E(acc, cur, wr, wc, fr, fq); S.done(cur); }
        if (!has_next) break;
#pragma unroll
        for (int a = 0; a < 2; ++a)
#pragma unroll
            for (int b = 0; b < 2; ++b)
#pragma unroll
                for (int m = 0; m < 4; ++m)
#pragma unroll
                    for (int n = 0; n < 2; ++n) acc[a][b][m][n] = (acc_t){0, 0, 0, 0};
        cur = nxt; cA = nA; cB = nB; ++ui;
        if constexpr (ALIGN_EPI) { if (wr == 1) PG8_BAR; }
    }
    PG8_WAIT_V(0);
    if constexpr (!ALIGN_EPI) { if (wr == 0) PG8_BAR; }
    PG8_BAR;
    if constexpr (Epi::AFTER_DRAIN) { E.fused(acc, cur, wr, wc, fr, fq, lds, wid, lane); S.done(cur); }
#undef PG8_SA
#undef PG8_SB
#undef PG8_STAGE
#undef PG8_LDA
#undef PG8_LDB
#undef PG8_MMA
#undef PG8_WAIT_V
#undef PG8_WAIT_L
#undef PG8_BAR
#undef PG8_SCHED
}
}
constexpr int NB = 4, SEQ = 8192, DM = 1024, T = NB * SEQ;
constexpr int HW = 512;
constexpr int N1 = 4608;
constexpr int NEXP = 16384, PK_TOP = 16, PK_HEADS = 8;
constexpr float EPS = 1e-6f;
constexpr float QSCALE = 0.125f * 1.4426950408889634f;
constexpr float LAMBDA_INIT = 0.2f;

constexpr size_t MiB = 1u << 20;
constexpr size_t WS_CTL = 0, CTL_ZERO_BYTES = 65536;
constexpr int CW_BAR = 1024;
constexpr size_t WS_W1T = 2 * MiB;
constexpr size_t WS_WAB = 11 * MiB;
constexpr size_t WS_WO2 = 13 * MiB;
constexpr size_t WS_WEF = 17 * MiB;
constexpr size_t WS_ROPE = 21 * MiB;
constexpr size_t WS_WSM = 23 * MiB;
constexpr size_t WS_MISC = 23 * MiB + 512 * 1024;
constexpr size_t WS_UQ = 24 * MiB;
constexpr size_t WS_VQ = 40 * MiB;
constexpr size_t WS_SUQ = 56 * MiB;
constexpr size_t WS_XB = 88 * MiB;
constexpr size_t WS_W1Q = 58 * MiB;
constexpr size_t WS_XS = 63 * MiB;
constexpr size_t WS_WSC = 63 * MiB + 256 * 1024;
constexpr size_t WS_Q = 152 * MiB;
constexpr size_t WS_SU = 184 * MiB;
constexpr size_t WS_GATES = 216 * MiB;
constexpr size_t WS_K = 344 * MiB;
constexpr size_t WS_V = 376 * MiB;
constexpr size_t WS_SV = 408 * MiB;
constexpr size_t WS_G = 344 * MiB;
constexpr size_t WS_SCORES = 152 * MiB;
constexpr size_t WS_SSQ = 472 * MiB;
constexpr size_t WS_IDX = 474 * MiB;
constexpr size_t WS_GW = 490 * MiB;
constexpr size_t WS_PART = 152 * MiB;
constexpr size_t WS_COEF = 280 * MiB;
constexpr size_t WS_CSC = 284 * MiB;
constexpr size_t WS_X1H = 408 * MiB;
constexpr size_t WS_X1L = 424 * MiB;
constexpr size_t WS_X1S = 440 * MiB;
constexpr size_t WS_IDX16 = 444 * MiB;
constexpr size_t WS_YB = 216 * MiB;
constexpr size_t WS_SSQ2 = 296 * MiB;
constexpr size_t WS_END = 506 * MiB;
static_assert(WS_SCORES + (size_t)T * 2048 * 4 <= WS_SSQ && WS_G + (size_t)T * 2048 * 2 <= WS_SSQ, "ws map");

constexpr int RING_BYTES = 131072;
constexpr int BAR_LDS_OFF = 147456 - 64;
constexpr int LDS_BYTES = 147456;
constexpr int NWAVES = 8;

#define GAS __attribute__((address_space(1)))
#define LAS __attribute__((address_space(3)))
typedef unsigned short bf16;
typedef unsigned v4u __attribute__((ext_vector_type(4)));
typedef unsigned v2u __attribute__((ext_vector_type(2)));
typedef float f32x4 __attribute__((ext_vector_type(4)));
typedef float f32x2 __attribute__((ext_vector_type(2)));
typedef float f32x16 __attribute__((ext_vector_type(16)));
typedef short bf16x8 __attribute__((ext_vector_type(8)));
typedef short s16x4 __attribute__((ext_vector_type(4)));
#define LDS_WAIT() asm volatile("s_waitcnt lgkmcnt(0)" ::: "memory")
#define VM_WAIT() asm volatile("s_waitcnt vmcnt(0)" ::: "memory")
#define CFENCE() asm volatile("" ::: "memory")
__device__ __forceinline__ unsigned f2bf(float f) { unsigned u = __builtin_bit_cast(unsigned, f); return (u + 0x7fffu + ((u >> 16) & 1u)) >> 16; }
__device__ __forceinline__ unsigned pk2(float lo, float hi) { return f2bf(lo) | (f2bf(hi) << 16); }
typedef __bf16 bf16x2_t __attribute__((ext_vector_type(2)));
__device__ __forceinline__ unsigned cvtpk(float lo, float hi) { const f32x2 v = {lo, hi}; const bf16x2_t b = __builtin_convertvector(v, bf16x2_t); return __builtin_bit_cast(unsigned, b); }
__device__ __forceinline__ float bf_lo(unsigned w) { return __builtin_bit_cast(float, w << 16); }
__device__ __forceinline__ float bf_hi(unsigned w) { return __builtin_bit_cast(float, w & 0xffff0000u); }
__device__ __forceinline__ float bf2f(bf16 b) { return __builtin_bit_cast(float, (unsigned)b << 16); }
__device__ __forceinline__ float wave_sum(float v) {
    v += __builtin_bit_cast(float, __builtin_amdgcn_mov_dpp(__builtin_bit_cast(int, v), 0xB1, 0xF, 0xF, true));
    v += __builtin_bit_cast(float, __builtin_amdgcn_mov_dpp(__builtin_bit_cast(int, v), 0x4E, 0xF, 0xF, true));
    v += __builtin_bit_cast(float, __builtin_amdgcn_mov_dpp(__builtin_bit_cast(int, v), 0x141, 0xF, 0xF, true));
    v += __builtin_bit_cast(float, __builtin_amdgcn_mov_dpp(__builtin_bit_cast(int, v), 0x140, 0xF, 0xF, true));
    const int iv = __builtin_bit_cast(int, v);
    return (__builtin_bit_cast(float, __builtin_amdgcn_readlane(iv, 0)) + __builtin_bit_cast(float, __builtin_amdgcn_readlane(iv, 16))) +
           (__builtin_bit_cast(float, __builtin_amdgcn_readlane(iv, 32)) + __builtin_bit_cast(float, __builtin_amdgcn_readlane(iv, 48)));
}
__device__ __forceinline__ float gelu1(float v) {
    const float av = __builtin_fabsf(v), t = __builtin_amdgcn_rcpf(av * 0.2316418882f + 1.0f);
    float q = t * 0.5307027145f + (-0.7265760135f); q = q * t + 0.7107068705f; q = q * t + (-0.142248368f); q = q * t + 0.127414796f; q = q * t;
    const float e = __builtin_amdgcn_exp2f((v * v) * (-0.72134752044f));
    const float m = v * (q * e);
    return v < 0.f ? m : v - m;
}

struct Frame {
    LAS unsigned char* lds;
    int tid, lane, wave, vcu, G;
    const float* in[23]; float* out; unsigned char* ws;
};

__device__ __forceinline__ int rowmap_fn(int n, int rowmode, int row_off) {
    if (rowmode == 1 && n < 1024) return (n & ~63) | (2 * (n & 31) + ((n >> 5) & 1));
    return row_off + n;
}
__device__ __forceinline__ void p0_transpose_item(const float* W, int N, bf16* WT, int ldt, int koff, int rowmode, int row_off, LAS float* scr, int item, int lane) {
    const int nblk = N / 32, kb = item / nblk, nb = item % nblk, k0 = 64 * kb, n0 = 32 * nb;
#pragma unroll 8
    for (int i = 0; i < 32; ++i) { const int kk = 2 * i + (lane >> 5); scr[kk * 33 + (lane & 31)] = W[(size_t)(k0 + kk) * N + n0 + (lane & 31)]; }
    LDS_WAIT(); CFENCE();
    const int c = lane & 7;
#pragma unroll
    for (int j = 0; j < 4; ++j) { const int n = (lane >> 3) + 8 * j; const LAS float* s = scr + (8 * c) * 33 + n;
        v4u o; o.x = pk2(s[0 * 33], s[1 * 33]); o.y = pk2(s[2 * 33], s[3 * 33]); o.z = pk2(s[4 * 33], s[5 * 33]); o.w = pk2(s[6 * 33], s[7 * 33]);
        *(v4u*)(WT + (size_t)rowmap_fn(n0 + n, rowmode, row_off) * ldt + koff + k0 + 8 * c) = o; }
    LDS_WAIT(); CFENCE();
}

__device__ __forceinline__ void table_row_store(unsigned char* ws, const f32x4 (&v)[4], bool isu, int e, int lane) {
    float am = 0.f;
#pragma unroll
    for (int j = 0; j < 4; ++j) am = fmaxf(am, fmaxf(fmaxf(fabsf(v[j][0]), fabsf(v[j][1])), fmaxf(fabsf(v[j][2]), fabsf(v[j][3]))));
    { int iv = __builtin_bit_cast(int, am);
      iv = max(iv, __builtin_amdgcn_mov_dpp(iv, 0xB1, 0xF, 0xF, true)); iv = max(iv, __builtin_amdgcn_mov_dpp(iv, 0x4E, 0xF, 0xF, true));
      iv = max(iv, __builtin_amdgcn_mov_dpp(iv, 0x141, 0xF, 0xF, true)); iv = max(iv, __builtin_amdgcn_mov_dpp(iv, 0x140, 0xF, 0xF, true));
      iv = max(max(__builtin_amdgcn_readlane(iv, 0), __builtin_amdgcn_readlane(iv, 16)), max(__builtin_amdgcn_readlane(iv, 32), __builtin_amdgcn_readlane(iv, 48)));
      am = __builtin_bit_cast(float, iv); }
    float ss = 0.f;
#pragma unroll
    for (int j = 0; j < 4; ++j) ss += (v[j][0] * v[j][0] + v[j][1] * v[j][1]) + (v[j][2] * v[j][2] + v[j][3] * v[j][3]);
    const float dl = fminf(am * (1.0f / 7.0f), 0.355f * sqrtf(wave_sum(ss) * (1.0f / 1024.0f)));
    const float sc = dl > 0.f ? 1.0f / dl : 0.f;
    unsigned pk[2] = {0u, 0u};
    if (isu) {
#pragma unroll
        for (int k = 0; k < 16; ++k) pk[k >> 3] |= ((unsigned)__float2int_rn(__builtin_amdgcn_fmed3f(v[k >> 2][k & 3] * sc, -7.0f, 7.0f)) & 15u) << (4 * (k & 7));
        *(v2u*)(ws + WS_UQ + (size_t)(lane >> 4) * (NEXP * 128) + (size_t)e * 128 + 8 * (lane & 15)) = (v2u){pk[0], pk[1]};
        if (lane == 0) ((float*)(ws + WS_SUQ))[2 * e] = dl;
    } else {
#pragma unroll
        for (int k = 0; k < 16; ++k) pk[k >> 3] |= ((unsigned)__float2int_rn(__builtin_amdgcn_fmed3f(v[k >> 2][k & 3] * sc, -7.0f, 7.0f) + ((k & 1) ? 0.0f : 8.0f)) & 15u) << (4 * (k & 7));
        *(v2u*)(ws + WS_VQ + (size_t)(lane >> 4) * (NEXP * 128) + (size_t)e * 128 + 8 * (lane & 15)) = (v2u){pk[0], pk[1]};
        if (lane == 0) ((float*)(ws + WS_SUQ))[2 * e + 1] = dl;
    }
}

__device__ __forceinline__ void p0_prologue(Frame& F) {
    unsigned char* ws = F.ws;
    const int gw = F.vcu * NWAVES + F.wave, NGW = F.G * NWAVES;
    const int gt = F.vcu * (NWAVES * 64) + F.tid, NGT = F.G * NWAVES * 64;
    {
        LAS float* scr = (LAS float*)(F.lds + F.wave * 16384);
        bf16* W1T = (bf16*)(ws + WS_W1T); bf16* WAB = (bf16*)(ws + WS_WAB); bf16* WO2 = (bf16*)(ws + WS_WO2);
        constexpr int I_IN = 16 * 80, I_GT = 16 * 64, I_A = 8 * 32, I_B = 8 * 32, I_O = 16 * 32;
        constexpr int NIT = I_IN + I_GT + I_A + I_B + I_O;
        for (int it = gw; it < NIT; it += NGW) {
            int r = it;
            if (r < I_IN) { p0_transpose_item(F.in[2], 2560, W1T, 1024, 0, 1, 0, scr, r, F.lane); continue; } r -= I_IN;
            if (r < I_GT) { p0_transpose_item(F.in[14], 2048, W1T, 1024, 0, 0, 2560, scr, r, F.lane); continue; } r -= I_GT;
            if (r < I_A) { p0_transpose_item(F.in[12], 1024, WAB, 512, 0, 0, 0, scr, r, F.lane); continue; } r -= I_A;
            if (r < I_B) { p0_transpose_item(F.in[13], 1024, WAB, 512, 0, 0, 1024, scr, r, F.lane); continue; } r -= I_B;
            p0_transpose_item(F.in[16], 1024, WO2, 1024, 0, 0, 0, scr, r, F.lane);
        }
    }
    __syncthreads();
    {
        const float* wq = F.in[18]; const float* keys = F.in[19]; const float* g2 = F.in[17];
        bf16* WEF = (bf16*)(ws + WS_WEF);
        const int r32 = F.lane & 31, hi = F.lane >> 5;
        for (int task = gw; task < 16 * 4 * 32; task += NGW) {
            const int hp = task >> 7, k0 = ((task >> 5) & 3) * 32, d0 = (task & 31) * 32;
            const float* ap = keys + (size_t)(hp * 128 + k0 + r32) * 128 + 8 * hi;
            const float* bp = wq + (size_t)(d0 + r32) * 2048 + hp * 128 + 8 * hi;
            f32x16 acc = (f32x16){};
#pragma unroll 1
            for (int half = 0; half < 2; ++half) {
                f32x4 av[8], bv[8];
#pragma unroll
                for (int s = 0; s < 4; ++s) { av[2 * s] = *(const f32x4*)(ap + 16 * (4 * half + s)); av[2 * s + 1] = *(const f32x4*)(ap + 16 * (4 * half + s) + 4);
                    bv[2 * s] = *(const f32x4*)(bp + 16 * (4 * half + s)); bv[2 * s + 1] = *(const f32x4*)(bp + 16 * (4 * half + s) + 4); }
#pragma unroll
                for (int s = 0; s < 4; ++s) {
                    unsigned ah[4], al[4], bh[4], bl[4];
#pragma unroll
                    for (int q = 0; q < 4; ++q) { const f32x4 a4 = av[2 * s + (q >> 1)], b4 = bv[2 * s + (q >> 1)]; const int e = (q & 1) * 2;
                        const unsigned ha = cvtpk(a4[e], a4[e + 1]), hb = cvtpk(b4[e], b4[e + 1]);
                        ah[q] = ha; bh[q] = hb;
                        al[q] = cvtpk(a4[e] - bf_lo(ha), a4[e + 1] - bf_hi(ha)); bl[q] = cvtpk(b4[e] - bf_lo(hb), b4[e + 1] - bf_hi(hb)); }
                    const bf16x8 Ah = __builtin_bit_cast(bf16x8, (v4u){ah[0], ah[1], ah[2], ah[3]}), Al = __builtin_bit_cast(bf16x8, (v4u){al[0], al[1], al[2], al[3]});
                    const bf16x8 Bh = __builtin_bit_cast(bf16x8, (v4u){bh[0], bh[1], bh[2], bh[3]}), Bl = __builtin_bit_cast(bf16x8, (v4u){bl[0], bl[1], bl[2], bl[3]});
                    acc = __builtin_amdgcn_mfma_f32_32x32x16_bf16(Ah, Bh, acc, 0, 0, 0);
                    acc = __builtin_amdgcn_mfma_f32_32x32x16_bf16(Ah, Bl, acc, 0, 0, 0);
                    acc = __builtin_amdgcn_mfma_f32_32x32x16_bf16(Al, Bh, acc, 0, 0, 0);
                }
            }
            const float gd = g2[d0 + r32];
#pragma unroll
            for (int r = 0; r < 16; ++r) { const int k = k0 + (r & 3) + 8 * (r >> 2) + 4 * hi;
                WEF[(size_t)(hp * 128 + k) * 1024 + d0 + r32] = (bf16)f2bf(acc[r] * gd); }
        }
    }
    {
        const float* x = F.in[0]; const float* g1 = F.in[1]; unsigned char* A8 = ws + WS_XB; float* XS = (float*)(ws + WS_XS);
        f32x4 gv[4];
#pragma unroll
        for (int j = 0; j < 4; ++j) gv[j] = *((const f32x4*)g1 + F.lane + 64 * j);
        for (int m = gw; m < T; m += NGW) {
            const f32x4* xr = (const f32x4*)(x + (size_t)m * DM) + F.lane;
            f32x4 v[4]; float s = 0.f, am = 0.f;
#pragma unroll
            for (int j = 0; j < 4; ++j) { v[j] = xr[64 * j]; s += (v[j].x * v[j].x + v[j].y * v[j].y) + (v[j].z * v[j].z + v[j].w * v[j].w); }
            const float rstd = 1.0f / sqrtf(wave_sum(s) * (1.f / DM) + EPS);
#pragma unroll
            for (int j = 0; j < 4; ++j) { v[j] = v[j] * rstd * gv[j]; am = fmaxf(am, fmaxf(fmaxf(fabsf(v[j].x), fabsf(v[j].y)), fmaxf(fabsf(v[j].z), fabsf(v[j].w)))); }
            { int iv = __builtin_bit_cast(int, am);
              iv = max(iv, __builtin_amdgcn_mov_dpp(iv, 0xB1, 0xF, 0xF, true)); iv = max(iv, __builtin_amdgcn_mov_dpp(iv, 0x4E, 0xF, 0xF, true));
              iv = max(iv, __builtin_amdgcn_mov_dpp(iv, 0x141, 0xF, 0xF, true)); iv = max(iv, __builtin_amdgcn_mov_dpp(iv, 0x140, 0xF, 0xF, true));
              iv = max(max(__builtin_amdgcn_readlane(iv, 0), __builtin_amdgcn_readlane(iv, 16)), max(__builtin_amdgcn_readlane(iv, 32), __builtin_amdgcn_readlane(iv, 48)));
              am = __builtin_bit_cast(float, iv); }
            const float sc = am > 0.f ? 127.0f / am : 0.f;
            unsigned* o4 = (unsigned*)(A8 + (size_t)m * DM) + F.lane;
#pragma unroll
            for (int j = 0; j < 4; ++j) o4[64 * j] = ((unsigned)__float2int_rn(v[j].x * sc) & 0xffu) | (((unsigned)__float2int_rn(v[j].y * sc) & 0xffu) << 8) | (((unsigned)__float2int_rn(v[j].z * sc) & 0xffu) << 16) | (((unsigned)__float2int_rn(v[j].w * sc) & 0xffu) << 24);
            if (F.lane == 0) XS[m] = am * (1.0f / 127.0f);
        }
    }
    {
        float* rope = (float*)(ws + WS_ROPE);
        for (int i = gt; i < SEQ * 32; i += NGT) {
            const int pos = i >> 5, j = i & 31;
            const float inv = 1.0f / powf(10000.0f, (float)(2 * j) * (1.0f / 64.0f));
            const float ang = (float)pos * inv;
            double rv = (double)ang * 0.15915494309189535; rv -= floor(rv);
            const float fr = (float)rv; const float sn = __builtin_amdgcn_sinf(fr), cs = __builtin_amdgcn_cosf(fr);
            *(f32x2*)(rope + 2 * (size_t)i) = (f32x2){cs, sn};
        }
        const float* wsp = F.in[10]; bf16* WSM = (bf16*)(ws + WS_WSM);
        for (int i = gt; i < 4 * 128 * 128; i += NGT) { const int ii = (i >> 7) & 127, jj = i & 127; WSM[i] = (bf16)f2bf(((jj >> 6) <= (ii >> 6)) ? wsp[i] : 0.f); }
        if (F.vcu == 0 && F.wave == 0) {
            const float p1 = F.in[3][F.lane] * F.in[4][F.lane], p2 = F.in[5][F.lane] * F.in[6][F.lane];
            const float s1 = wave_sum(p1), s2 = wave_sum(p2);
            if (F.lane == 0) ((float*)(ws + WS_MISC))[0] = expf(s1) - expf(s2) + LAMBDA_INIT;
        }
    }
}

__device__ __forceinline__ void p0b_quant_weights(Frame& F) {
    unsigned char* ws = F.ws;
    const int gw = F.vcu * NWAVES + F.wave, NGW = F.G * NWAVES;
    float* WSC = (float*)(ws + WS_WSC);
    for (int n = gw; n < N1; n += NGW) {
        const bf16* src = (const bf16*)(ws + WS_W1T) + (size_t)n * DM + 16 * F.lane;
        const v4u w0 = *(const v4u*)src, w1 = *(const v4u*)(src + 8);
        const float v[16] = {bf_lo(w0.x), bf_hi(w0.x), bf_lo(w0.y), bf_hi(w0.y), bf_lo(w0.z), bf_hi(w0.z), bf_lo(w0.w), bf_hi(w0.w), bf_lo(w1.x), bf_hi(w1.x), bf_lo(w1.y), bf_hi(w1.y), bf_lo(w1.z), bf_hi(w1.z), bf_lo(w1.w), bf_hi(w1.w)};
        float am = 0.f;
#pragma unroll
        for (int j = 0; j < 16; ++j) am = fmaxf(am, fabsf(v[j]));
        { int iv = __builtin_bit_cast(int, am);
          iv = max(iv, __builtin_amdgcn_mov_dpp(iv, 0xB1, 0xF, 0xF, true)); iv = max(iv, __builtin_amdgcn_mov_dpp(iv, 0x4E, 0xF, 0xF, true));
          iv = max(iv, __builtin_amdgcn_mov_dpp(iv, 0x141, 0xF, 0xF, true)); iv = max(iv, __builtin_amdgcn_mov_dpp(iv, 0x140, 0xF, 0xF, true));
          iv = max(max(__builtin_amdgcn_readlane(iv, 0), __builtin_amdgcn_readlane(iv, 16)), max(__builtin_amdgcn_readlane(iv, 32), __builtin_amdgcn_readlane(iv, 48)));
          am = __builtin_bit_cast(float, iv); }
        const float sc = am > 0.f ? 127.0f / am : 0.f;
        unsigned wq[4];
#pragma unroll
        for (int j = 0; j < 4; ++j) wq[j] = ((unsigned)__float2int_rn(v[4 * j] * sc) & 0xffu) | (((unsigned)__float2int_rn(v[4 * j + 1] * sc) & 0xffu) << 8) | (((unsigned)__float2int_rn(v[4 * j + 2] * sc) & 0xffu) << 16) | (((unsigned)__float2int_rn(v[4 * j + 3] * sc) & 0xffu) << 24);
        *(v4u*)(ws + WS_W1Q + (size_t)n * DM + 16 * F.lane) = (v4u){wq[0], wq[1], wq[2], wq[3]};
        if (F.lane == 0) WSC[n] = am * (1.0f / 127.0f);
    }
}
#define XB_TMO      128
#define XB_XCNT(j)  (256  + 64 * (j))
#define XB_XSUB(j)  (1280 + 64 * (j))
#define XB_XGEN(j)  (2304 + 64 * (j))
#define XB_TOP      3328
#define XB_TOPGEN   3392
#define XCD_BAR_WORDS 3456
#define XB_SPIN_CAP (1u << 22)

__device__ __forceinline__ unsigned xb_ld(unsigned* p)              { return __hip_atomic_load(p, __ATOMIC_RELAXED, __HIP_MEMORY_SCOPE_AGENT); }
__device__ __forceinline__ unsigned xb_add(unsigned* p, unsigned v) { return __hip_atomic_fetch_add(p, v, __ATOMIC_RELAXED, __HIP_MEMORY_SCOPE_AGENT); }
__device__ __forceinline__ unsigned xb_xcc_id() { return (unsigned)__builtin_amdgcn_s_getreg((3 << 11) | 20) & 0xFu; }
#define XB_SPIN(cond, bar) do { unsigned _sp = 0; while (cond) { __builtin_amdgcn_s_sleep(1); \
    if ((++_sp & 255u) == 0u) { if (xb_ld(&(bar)[XB_TMO])) break; if (_sp > XB_SPIN_CAP) { atomicAdd(&(bar)[XB_TMO], 1u); break; } } } } while (0)

struct XcdBarrier {
    unsigned* bar; unsigned x;
    volatile LAS unsigned* st;
};

__device__ __forceinline__ XcdBarrier xcd_barrier_post(unsigned* bar, volatile LAS unsigned* st) {
    XcdBarrier b; b.bar = bar; b.x = xb_xcc_id(); b.st = st;
    if (threadIdx.x == 0) (void)xb_add(&bar[XB_XCNT(b.x)], 1u);
    return b;
}
__device__ __forceinline__ void xcd_barrier_complete(unsigned* bar, unsigned x, unsigned& nloc, unsigned& nx) {
    const unsigned G = gridDim.x * gridDim.y * gridDim.z;
    unsigned sum, cnt, mine, sp = 0u;
    for (;;) {
        sum = 0u; cnt = 0u; mine = 0u;
#pragma unroll
        for (unsigned j = 0; j < 16; ++j) { const unsigned c = xb_ld(&bar[XB_XCNT(j)]); sum += c; cnt += (c > 0u) ? 1u : 0u; mine = (j == x) ? c : mine; }
        if (sum == G) break;
        __builtin_amdgcn_s_sleep(1);
        if ((++sp & 255u) == 0u) { if (xb_ld(&bar[XB_TMO])) break; if (sp > XB_SPIN_CAP) { atomicAdd(&bar[XB_TMO], 1u); break; } }
    }
    nloc = mine > 0u ? mine : 1u; nx = cnt > 0u ? cnt : 1u;
}

__device__ __forceinline__ void xcd_barrier(const XcdBarrier& b) {
    asm volatile("s_waitcnt vmcnt(0)" ::: "memory");
    __syncthreads();
    if (threadIdx.x == 0) {
        unsigned* bar = b.bar;
        __builtin_amdgcn_s_waitcnt(0);
        unsigned nloc = b.st[0], nx = b.st[1];
        if (nloc == 0u) { xcd_barrier_complete(bar, b.x, nloc, nx); b.st[0] = nloc; b.st[1] = nx; }
        const unsigned old = xb_add(&bar[XB_XSUB(b.x)], 1u);
        const unsigned gen = old / nloc;
        if (old + 1u == (gen + 1u) * nloc) {
            __builtin_amdgcn_fence(__ATOMIC_RELEASE, "agent");
            asm volatile("s_waitcnt vmcnt(0)" ::: "memory");
            const unsigned og = xb_add(&bar[XB_TOP], 1u);
            const unsigned tg = og / nx;
            if (og + 1u == (tg + 1u) * nx) xb_add(&bar[XB_TOPGEN], 1u);
            else XB_SPIN(xb_ld(&bar[XB_TOPGEN]) == tg, bar);
            __builtin_amdgcn_fence(__ATOMIC_ACQUIRE, "agent");
            xb_add(&bar[XB_XGEN(b.x)], 1u);
            asm volatile("s_waitcnt vmcnt(0)" ::: "memory");
        } else {
            XB_SPIN(xb_ld(&bar[XB_XGEN(b.x)]) == gen, bar);
            __builtin_amdgcn_fence(__ATOMIC_ACQUIRE, "agent");
            asm volatile("s_waitcnt vmcnt(0)" ::: "memory");
        }
    }
    __syncthreads();
}
__device__ __forceinline__ v4u pack8(const f32x4 a, const f32x4 b) { v4u w; w.x = cvtpk(a[0], a[1]); w.y = cvtpk(a[2], a[3]); w.z = cvtpk(b[0], b[1]); w.w = cvtpk(b[2], b[3]); return w; }

struct EpiP1 {
    static constexpr bool PERM = true, AFTER_DRAIN = false, I8 = true;
    unsigned char* ws; const float* bgate; const float* rope; const float* xs; const float* wsc;
    __device__ __forceinline__ void operator()(const pg8::i32x4 (&acci)[2][2][4][2], const pg8::Unit& u, int wr, int wc, int fr, int fq) const {
        const int row0 = u.pm * 256 + wr * 64 + fr, pn = u.pn, ct = wc * 32 + 8 * fq;
        float rs[8]; f32x4 cs[2][2];
#pragma unroll
        for (int k = 0; k < 8; ++k) rs[k] = xs[row0 + (k >> 2) * 128 + (k & 3) * 16];
#pragma unroll
        for (int bj = 0; bj < 2; ++bj) { cs[bj][0] = *(const f32x4*)(wsc + pn * 256 + bj * 128 + ct); cs[bj][1] = *(const f32x4*)(wsc + pn * 256 + bj * 128 + ct + 4); }
        f32x4 acc[2][2][4][2];
#pragma unroll
        for (int ai = 0; ai < 2; ++ai)
#pragma unroll
            for (int bj = 0; bj < 2; ++bj)
#pragma unroll
                for (int m = 0; m < 4; ++m)
#pragma unroll
                    for (int n = 0; n < 2; ++n) { const pg8::i32x4 v = acci[ai][bj][m][n]; const float r = rs[4 * ai + m];
                        acc[ai][bj][m][n] = (f32x4){(float)v[0] * r * cs[bj][n][0], (float)v[1] * r * cs[bj][n][1], (float)v[2] * r * cs[bj][n][2], (float)v[3] * r * cs[bj][n][3]}; }
        if (pn < 4) {
            bf16* dst = (bf16*)(ws + (pn < 2 ? WS_Q : WS_K)); const float sc = pn < 2 ? QSCALE : 1.0f; const int cb = (pn & 1) * 256 + ct; const bool hm = pn >= 2;
#pragma unroll
            for (int ai = 0; ai < 2; ++ai)
#pragma unroll
                for (int m = 0; m < 4; ++m) { const int row = row0 + ai * 128 + m * 16, pos = row & (SEQ - 1);
#pragma unroll
                    for (int bj = 0; bj < 2; ++bj) { const int col = cb + bj * 128, i0 = (col & 63) >> 1;
                        const f32x4 r0 = *(const f32x4*)(rope + (size_t)(pos * 32 + i0) * 2), r1 = *(const f32x4*)(rope + (size_t)(pos * 32 + i0 + 2) * 2);
                        const f32x4 a = acc[ai][bj][m][0], b = acc[ai][bj][m][1]; f32x4 oa, ob;
                        oa[0] = (a[0] * r0[0] - a[1] * r0[1]) * sc; oa[1] = (a[0] * r0[1] + a[1] * r0[0]) * sc;
                        oa[2] = (a[2] * r0[2] - a[3] * r0[3]) * sc; oa[3] = (a[2] * r0[3] + a[3] * r0[2]) * sc;
                        ob[0] = (b[0] * r1[0] - b[1] * r1[1]) * sc; ob[1] = (b[0] * r1[1] + b[1] * r1[0]) * sc;
                        ob[2] = (b[2] * r1[2] - b[3] * r1[3]) * sc; ob[3] = (b[2] * r1[3] + b[3] * r1[2]) * sc;
                        const size_t off = hm ? ((size_t)(((row >> 13) * 4 + (col >> 7)) * SEQ + pos) * 128 + (col & 127)) : ((size_t)row * HW + col);
                        *(v4u*)(dst + off) = pack8(oa, ob); } }
        } else if (pn < 10) {
            bf16* dst = (bf16*)(ws + (pn < 6 ? WS_V : (pn < 8 ? WS_SU : WS_SV))); const bool act = pn >= 6; const int cb = (pn & 1) * 256 + ct;
#pragma unroll
            for (int ai = 0; ai < 2; ++ai)
#pragma unroll
                for (int m = 0; m < 4; ++m) { const int row = row0 + ai * 128 + m * 16;
#pragma unroll
                    for (int bj = 0; bj < 2; ++bj) { const int col = cb + bj * 128; f32x4 a = acc[ai][bj][m][0], b = acc[ai][bj][m][1];
                        if (act) {
#pragma unroll
                            for (int e = 0; e < 4; ++e) { a[e] = gelu1(a[e]); b[e] = gelu1(b[e]); } }
                        const size_t off = (pn < 6) ? ((size_t)(((row >> 13) * 4 + (col >> 7)) * SEQ + (row & (SEQ - 1))) * 128 + (col & 127)) : ((size_t)row * HW + col);
                        *(v4u*)(dst + off) = pack8(a, b); } }
        } else {
            const int cb = (pn - 10) * 256 + ct;
#pragma unroll
            for (int bj = 0; bj < 2; ++bj) { const int col = cb + bj * 128;
                const f32x4 b0 = *(const f32x4*)(bgate + col), b1 = *(const f32x4*)(bgate + col + 4);
#pragma unroll
                for (int ai = 0; ai < 2; ++ai)
#pragma unroll
                    for (int m = 0; m < 4; ++m) { const int row = row0 + ai * 128 + m * 16; f32x4 a = acc[ai][bj][m][0] + b0, b = acc[ai][bj][m][1] + b1;
#pragma unroll
                        for (int e = 0; e < 4; ++e) { a[e] = __builtin_amdgcn_rcpf(1.0f + __builtin_amdgcn_exp2f(a[e] * -1.4426950408889634f)); b[e] = __builtin_amdgcn_rcpf(1.0f + __builtin_amdgcn_exp2f(b[e] * -1.4426950408889634f)); }
                        unsigned w0 = 0u, w1 = 0u;
#pragma unroll
                        for (int e = 0; e < 4; ++e) { w0 = __builtin_amdgcn_cvt_pk_u8_f32(a[e] * 255.0f, e, w0); w1 = __builtin_amdgcn_cvt_pk_u8_f32(b[e] * 255.0f, e, w1); }
                        *(v2u*)(ws + WS_GATES + (size_t)row * 2048 + col) = (v2u){w0, w1}; } }
        }
    }
};

struct EpiGate {
    static constexpr bool PERM = true, AFTER_DRAIN = false, I8 = false;
    bf16* M; const unsigned char* gates;
    __device__ __forceinline__ void operator()(const f32x4 (&acc)[2][2][4][2], const pg8::Unit& u, int wr, int wc, int fr, int fq) const {
        const int br = u.pn >> 2, pm = u.pm - 128 * br, pn = u.pn & 3;
        const int row0 = pm * 256 + wr * 64 + fr, col0 = pn * 256 + wc * 32 + 8 * fq;
#pragma unroll
        for (int ai = 0; ai < 2; ++ai) {
            v2u g[8]; v4u o[8];
#pragma unroll
            for (int m = 0; m < 4; ++m)
#pragma unroll
                for (int bj = 0; bj < 2; ++bj) g[2 * m + bj] = *(const v2u*)(gates + (size_t)(row0 + ai * 128 + m * 16) * 2048 + br * 1024 + col0 + bj * 128);
            if (br) {
#pragma unroll
                for (int m = 0; m < 4; ++m)
#pragma unroll
                    for (int bj = 0; bj < 2; ++bj) o[2 * m + bj] = *(const v4u*)(M + (size_t)(row0 + ai * 128 + m * 16) * DM + col0 + bj * 128);
            } else {
#pragma unroll
                for (int k = 0; k < 8; ++k) o[k] = (v4u){0u, 0u, 0u, 0u};
            }
#pragma unroll
            for (int m = 0; m < 4; ++m)
#pragma unroll
                for (int bj = 0; bj < 2; ++bj) { const v2u gg = g[2 * m + bj]; const v4u oo = o[2 * m + bj]; f32x4 a = acc[ai][bj][m][0] * (1.0f / 255.0f), b = acc[ai][bj][m][1] * (1.0f / 255.0f);
                    a[0] = a[0] * (float)(gg.x & 0xffu) + bf_lo(oo.x); a[1] = a[1] * (float)((gg.x >> 8) & 0xffu) + bf_hi(oo.x); a[2] = a[2] * (float)((gg.x >> 16) & 0xffu) + bf_lo(oo.y); a[3] = a[3] * (float)(gg.x >> 24) + bf_hi(oo.y);
                    b[0] = b[0] * (float)(gg.y & 0xffu) + bf_lo(oo.z); b[1] = b[1] * (float)((gg.y >> 8) & 0xffu) + bf_hi(oo.z); b[2] = b[2] * (float)((gg.y >> 16) & 0xffu) + bf_lo(oo.w); b[3] = b[3] * (float)(gg.y >> 24) + bf_hi(oo.w);
                    *(v4u*)(M + (size_t)(row0 + ai * 128 + m * 16) * DM + col0 + bj * 128) = pack8(a, b); }
        }
    }
};

struct EpiX1 {
    static constexpr bool PERM = true, AFTER_DRAIN = false, I8 = false;
    const float* x; float* out; bf16* x1b; float* ssq;
    __device__ __forceinline__ void operator()(const f32x4 (&acc)[2][2][4][2], const pg8::Unit& u, int wr, int wc, int fr, int fq) const {
        const int row0 = u.pm * 256 + wr * 64 + fr, col0 = u.pn * 256 + wc * 32 + 8 * fq;
#pragma unroll
        for (int ai = 0; ai < 2; ++ai) {
            f32x4 xa[8], xb[8];
#pragma unroll
            for (int m = 0; m < 4; ++m)
#pragma unroll
                for (int bj = 0; bj < 2; ++bj) { const size_t off = (size_t)(row0 + ai * 128 + m * 16) * DM + col0 + bj * 128; xa[2 * m + bj] = *(const f32x4*)(x + off); xb[2 * m + bj] = *(const f32x4*)(x + off + 4); }
            float ssv[4];
#pragma unroll
            for (int m = 0; m < 4; ++m) { float ss = 0.f;
#pragma unroll
                for (int bj = 0; bj < 2; ++bj) { const size_t off = (size_t)(row0 + ai * 128 + m * 16) * DM + col0 + bj * 128;
                    const f32x4 a = acc[ai][bj][m][0] + xa[2 * m + bj], b = acc[ai][bj][m][1] + xb[2 * m + bj];
                    *(v4u*)(x1b + off) = pack8(a, b);
                    ss += (a[0] * a[0] + a[1] * a[1]) + (a[2] * a[2] + a[3] * a[3]) + (b[0] * b[0] + b[1] * b[1]) + (b[2] * b[2] + b[3] * b[3]); }
                ss += __shfl_xor(ss, 16); ss += __shfl_xor(ss, 32); ssv[m] = ss; }
            if (fq == 0) {
#pragma unroll
                for (int m = 0; m < 4; ++m) ssq[(size_t)(row0 + ai * 128 + m * 16) * 16 + u.pn * 4 + wc] = ssv[m]; }
        }
    }
};

typedef _Float16 h16x2 __attribute__((ext_vector_type(2)));
__device__ __forceinline__ unsigned pkh(float a, float b) { const f32x2 v = {a, b}; const h16x2 h = __builtin_convertvector(v, h16x2); return __builtin_bit_cast(unsigned, h); }
struct EpiScores {
    static constexpr bool PERM = true, AFTER_DRAIN = false, I8 = false;
    unsigned short* S;
    __device__ __forceinline__ void operator()(const f32x4 (&acc)[2][2][4][2], const pg8::Unit& u, int wr, int wc, int fr, int fq) const {
        const int row0 = u.pm * 256 + wr * 64 + fr, col0 = u.pn * 256 + wc * 32 + 8 * fq;
#pragma unroll
        for (int ai = 0; ai < 2; ++ai)
#pragma unroll
            for (int m = 0; m < 4; ++m) { const int row = row0 + ai * 128 + m * 16;
#pragma unroll
                for (int bj = 0; bj < 2; ++bj) { const f32x4 a = acc[ai][bj][m][0], b = acc[ai][bj][m][1];
                    *(v4u*)(S + (size_t)row * 2048 + col0 + bj * 128) = (v4u){pkh(a[0], a[1]), pkh(a[2], a[3]), pkh(b[0], b[1]), pkh(b[2], b[3])}; } }
    }
};

struct BranchOrder {
    pg8::StaticOrder so;
    __device__ __forceinline__ bool next(int i, pg8::Unit& u) const { if (!so.next(i >> 1, u)) return false; const int br = i & 1; u.pm += 128 * br; u.pn += 4 * br; return true; }
    __device__ __forceinline__ void a_ready(const pg8::Unit&) const {}
    __device__ __forceinline__ void done(const pg8::Unit&) const {}
};
namespace att {
constexpr int SLOT = 64 * 256;
constexpr int KRING = 0, VRING = 3 * SLOT;
constexpr int XROW = 132, XBYTES = 128 * XROW * 4;
constexpr int WSF_OFF = 2 * XBYTES;
static_assert(VRING + 3 * SLOT <= WSF_OFF && WSF_OFF + 8 * 256 <= BAR_LDS_OFF, "attention LDS map");
__device__ __forceinline__ int crow(int r, int hi) { return (r & 3) + 8 * (r >> 2) + 4 * hi; }
__device__ __forceinline__ void glds16s(const unsigned char* sbase, unsigned voff, unsigned lds_dst) { unsigned keep;
    asm volatile("s_mov_b32 %0, m0\n\ts_mov_b32 m0, %3\n\ts_nop 2\n\tglobal_load_lds_dwordx4 %1, %2\n\ts_mov_b32 m0, %0" : "=&s"(keep) : "v"(voff), "s"(sbase), "s"(lds_dst) : "memory"); }
__device__ __forceinline__ float max3f(float a, float b, float c) { float r; asm("v_max3_f32 %0, %1, %2, %3" : "=v"(r) : "v"(a), "v"(b), "v"(c)); return r; }
__device__ __forceinline__ float max2f(float a, float b) { float r; asm("v_max_f32_e32 %0, %1, %2" : "=v"(r) : "v"(a), "v"(b)); return r; }
__device__ __forceinline__ s16x4 vtr(LAS const unsigned char* p) {
    typedef short v4i16_t __attribute__((ext_vector_type(4)));
    return __builtin_bit_cast(s16x4, __builtin_amdgcn_ds_read_tr16_b64_v4i16((LAS v4i16_t*)p));
}
__device__ __forceinline__ void halves32(float v, float& lo, float& hh) {
    float a = v, b2 = v;
    asm("s_nop 1\n\tv_permlane32_swap_b32_e32 %0, %1" : "+v"(a), "+v"(b2));
    lo = a; hh = b2;
}
#ifndef ATT_MX
#define ATT_MX 1
#endif
#if ATT_MX
#define MX3_(a, b, c) __builtin_fmaxf(__builtin_fmaxf((a), (b)), (c))
#define MX2_(a, b) __builtin_fmaxf((a), (b))
#define ATT_PAD(C0, C1) do { } while (0)
#else
#define MX3_(a, b, c) max3f((a), (b), (c))
#define MX2_(a, b) max2f((a), (b))
#define ATT_PAD(C0, C1) asm volatile("s_nop 15\n\ts_nop 7" : "+v"(C0), "+v"(C1))
#endif
__device__ __forceinline__ float rowmax(const f32x16& p0, const f32x16& p1) {
    float a = MX3_(p0[0], p0[1], p1[0]), b = MX3_(p0[2], p0[3], p1[1]); a = MX3_(a, p1[2], p1[3]);
#pragma unroll
    for (int r = 4; r < 16; r += 4) { a = MX3_(a, p0[r], p0[r + 1]); b = MX3_(b, p0[r + 2], p0[r + 3]); a = MX3_(a, p1[r], p1[r + 1]); b = MX3_(b, p1[r + 2], p1[r + 3]); }
    const float m = MX2_(a, b);
    float lo, hh; halves32(m, lo, hh);
    return MX2_(lo, hh);
}
#ifndef ATT_THR
#define ATT_THR 8
#endif
#ifndef ATT_AHEAD
#define ATT_AHEAD 6
#endif

template <int VAR> __device__ __forceinline__ void attn_unit(const Frame& F, int b, int h, int qb, bf16* Q, const bf16* K, const bf16* V, float lam, const float* subg) {
    LAS unsigned char* lds = F.lds;
    int tid = F.tid; asm volatile("" : "+v"(tid));
    const int lane = tid & 63, r32 = lane & 31, hi = lane >> 5, wid = F.wave;
    const int c = wid >> 2, wq = wid & 3;
    const size_t rowbase = (size_t)b * SEQ;
    const int q0 = qb * 128 + wq * 32;
    const int NT = 2 * qb + 2;
    const int dkey = lane >> 4, dpos = lane & 15;
    unsigned kvo[2], vvo[2];
#pragma unroll
    for (int i2 = 0; i2 < 2; ++i2) { const int key = 4 * (2 * wid + i2) + dkey;
        kvo[i2] = (unsigned)(key * 256 + ((dpos ^ (key & 15)) << 4));
        vvo[i2] = (unsigned)(key * 256 + ((dpos ^ ((key & 3) << 2)) << 4)); }
    const unsigned char* Kb = (const unsigned char*)(K + (size_t)(b * 4 + h) * SEQ * 128);
    const unsigned char* Vb = (const unsigned char*)(V + (size_t)(b * 4 + h) * SEQ * 128);
    const unsigned lds0 = (unsigned)(uintptr_t)lds;
    const unsigned kdst = lds0 + KRING + 2 * wid * 1024, vdst = lds0 + VRING + 2 * wid * 1024;
#define RFL(x) ((unsigned)__builtin_amdgcn_readfirstlane((int)(x)))
#define DMA_K(t, slot) do { const unsigned char* s_ = Kb + (size_t)(t) * SLOT; glds16s(s_, kvo[0], RFL(kdst + (slot))); glds16s(s_, kvo[1], RFL(kdst + (slot) + 1024)); } while (0)
#define DMA_V(t, slot) do { const unsigned char* s_ = Vb + (size_t)(t) * SLOT; glds16s(s_, vvo[0], RFL(vdst + (slot))); glds16s(s_, vvo[1], RFL(vdst + (slot) + 1024)); } while (0)
    const int kb0 = KRING + r32 * 256 + (((c * 8 + hi) ^ (r32 & 15)) << 4);
    const int grp = lane >> 4, qi = (lane & 15) >> 2, pi = lane & 3;
    const int vb0 = VRING + (4 * (grp >> 1) + qi) * 256 + ((2 * (grp & 1) + (pi >> 1)) << 4) + (pi & 1) * 8 + (qi << 6);
    LAS float* wsf = (LAS float*)(lds + WSF_OFF) + wid * 64;

    DMA_K(0, 0); DMA_V(0, 0); DMA_K(1, SLOT);
    bf16x8 qr[4];
    { const bf16* Qw = Q + (rowbase + q0 + r32) * HW + h * 128 + c * 64 + hi * 8;
#pragma unroll
      for (int s = 0; s < 4; ++s) qr[s] = *(const bf16x8*)(Qw + s * 16); }
    if (NT > 2) DMA_K(2, 2 * SLOT);
    float mhat = 0.f, l_reg = 0.f;
    f32x16 o[4];
#pragma unroll
    for (int d = 0; d < 4; ++d) o[d] = (f32x16){};
    f32x16 negm = (f32x16){}; asm volatile("" : "+v"(negm));
    bool resc = false;
    f32x16 pA0, pA1, pB0, pB1; bf16x8 kf[8]; s16x4 vlo[16], vhi[16]; v4u pw0, pw1, pw2, pw3;
    int sl_prev = 0, sl_cur = 0, sl_next = SLOT;
    if (VAR & 32) { s16x4 z = (s16x4){}; asm volatile("" : "+v"(z));
#pragma unroll
        for (int i = 0; i < 16; ++i) { vlo[i] = z; vhi[i] = z; } }
    if (VAR & 16) { v4u z = (v4u){}; asm volatile("" : "+v"(z)); pw0 = pw1 = pw2 = pw3 = z; }
#define SBAR() __builtin_amdgcn_sched_barrier(0)
#define PIN(x) asm volatile("" : "+v"(x))
#define MFMA(a, b, cc) __builtin_amdgcn_mfma_f32_32x32x16_bf16(a, b, cc, 0, 0, 0)
#define WAIT_BAR(N) asm volatile("s_waitcnt vmcnt(" #N ") lgkmcnt(0)\n\ts_barrier" ::: "memory")
#define ROT() do { sl_prev = sl_cur; sl_cur = sl_next; sl_next = (sl_next == 2 * SLOT) ? 0 : sl_next + SLOT; } while (0)
#define KLOAD2(ka, j) do { kf[2 * (j)] = *(LAS const bf16x8*)(lds + ((ka) ^ ((j) << 5))); kf[2 * (j) + 1] = *(LAS const bf16x8*)(lds + ((ka) ^ ((j) << 5)) + 8192); } while (0)
#define RESC() do { if (resc) { \
        _Pragma("unroll") for (int g = 0; g < 4; ++g) { const f32x4 f = *(LAS const f32x4*)(wsf + 8 * g + 4 * hi); \
            _Pragma("unroll") for (int d = 0; d < 4; ++d) { o[d][4 * g + 0] *= f[0]; o[d][4 * g + 1] *= f[1]; o[d][4 * g + 2] *= f[2]; o[d][4 * g + 3] *= f[3]; } } } } while (0)
#define ENDW(tt) do { if ((tt) + 3 < NT) { WAIT_BAR(4); } else if ((tt) + 2 < NT) { WAIT_BAR(2); } else { WAIT_BAR(0); } } while (0)
    if (NT > 2) { WAIT_BAR(10); } else { WAIT_BAR(8); }
    { const int ka = kb0;
#pragma unroll
      for (int j = 0; j < 4; ++j) KLOAD2(ka, j); }
    pA0 = MFMA(kf[0], qr[0], negm); pA1 = MFMA(kf[1], qr[0], negm); pA0 = MFMA(kf[2], qr[1], pA0); pA1 = MFMA(kf[3], qr[1], pA1);
    pA0 = MFMA(kf[4], qr[2], pA0); pA1 = MFMA(kf[5], qr[2], pA1); pA0 = MFMA(kf[6], qr[3], pA0); pA1 = MFMA(kf[7], qr[3], pA1);
    ATT_PAD(pA0, pA1);
    { const float rm = rowmax(pA0, pA1); mhat = rm;
#pragma unroll
      for (int r = 0; r < 16; ++r) { pA0[r] = __builtin_amdgcn_exp2f(pA0[r] - rm); pA1[r] = __builtin_amdgcn_exp2f(pA1[r] - rm); }
#pragma unroll
      for (int r = 0; r < 16; ++r) negm[r] = -mhat;
      asm volatile("" : "+v"(negm)); }
    WAIT_BAR(0);
    if (NT > 3) DMA_K(3, 0);
    DMA_V(1, SLOT); ROT();
    { const int ka = kb0 + sl_cur;
#pragma unroll
      for (int j = 0; j < 4; ++j) KLOAD2(ka, j); }
    ENDW(0);
#define PKW(P, i) cvtpk(P[i], P[(i) + 1])
#define PAF(k) __builtin_bit_cast(bf16x8, pw##k)
#define VFR(i) (bf16x8){vlo[i][0], vlo[i][1], vlo[i][2], vlo[i][3], vhi[i][0], vhi[i][1], vhi[i][2], vhi[i][3]}
#define VADR(i, half) (lds + ((va_ ^ ((((i) & 15) & 3) << 6)) + (16 * (((i) & 15) >> 2) + 8 * (half)) * 256))
#define VRD(i) do { if (!(VAR & 32) && (i) >= 0 && (i) < 16) { \
        if (VAR & 128) { const bf16x8 w_ = *(LAS const bf16x8*)(lds + (((va_ ^ ((((i) & 15) & 3) << 6)) + (16 * (((i) & 15) >> 2)) * 256) & ~15)); vlo[(i) & 15] = (s16x4){w_[0], w_[1], w_[2], w_[3]}; vhi[(i) & 15] = (s16x4){w_[4], w_[5], w_[6], w_[7]}; } \
        else if (VAR & 256) { vlo[(i) & 15] = *(LAS const s16x4*)VADR(i, 0); vhi[(i) & 15] = *(LAS const s16x4*)VADR(i, 1); } \
        else { vlo[(i) & 15] = vtr(VADR(i, 0)); vhi[(i) & 15] = vtr(VADR(i, 1)); } SBAR(); } } while (0)
#define KRD(G, j) do { if (!(VAR & 64) && (G)) { KLOAD2(ka_, j); SBAR(); } } while (0)
#define GAPA(MF, a0, a1, a2, a3, W0, W1, PW) do { MF; if (!(VAR & 16)) { sacc += a0; sacc2 += a1; sacc += a2; sacc2 += a3; PIN(sacc); PIN(sacc2); W0; W1; } PIN(PW); SBAR(); } while (0)
#define GAPB(j, X, i) do { VRD((j) + ATT_AHEAD); o[(j) & 3] = MFMA(PAF_((j) >> 2), VFR(j), o[(j) & 3]); if (!(VAR & 4)) { X[i] = __builtin_amdgcn_exp2f(X[i]); X[(i) + 1] = __builtin_amdgcn_exp2f(X[(i) + 1]); } PIN(X); SBAR(); } while (0)
#define PAF_(k) ((k) == 0 ? PAF(0) : (k) == 1 ? PAF(1) : (k) == 2 ? PAF(2) : PAF(3))
#define STEP(C0, C1, P0, P1, t, GK, GV, GL, MASK) do { SBAR(); \
    const int va_ = vb0 + sl_prev; const int ka_ = kb0 + sl_next; \
    float sacc = P0[0], sacc2 = P0[1]; \
    GAPA(C0 = MFMA(kf[0], qr[0], negm), P0[2], P0[3], P0[4], P0[5],     pw0[0] = PKW(P0, 0),  pw0[1] = PKW(P0, 2),  pw0); \
    GAPA(C1 = MFMA(kf[1], qr[0], negm), P0[6], P0[7], P0[8], P0[9],     pw0[2] = PKW(P0, 4),  pw0[3] = PKW(P0, 6),  pw0); \
    VRD(ATT_AHEAD - 6); GAPA(C0 = MFMA(kf[2], qr[1], C0),   P0[10], P0[11], P0[12], P0[13], pw1[0] = PKW(P0, 8),  pw1[1] = PKW(P0, 10), pw1); \
    VRD(ATT_AHEAD - 5); GAPA(C1 = MFMA(kf[3], qr[1], C1),   P0[14], P0[15], P1[0], P1[1],   pw1[2] = PKW(P0, 12), pw1[3] = PKW(P0, 14), pw1); \
    VRD(ATT_AHEAD - 4); GAPA(C0 = MFMA(kf[4], qr[2], C0),   P1[2], P1[3], P1[4], P1[5],     pw2[0] = PKW(P1, 0),  pw2[1] = PKW(P1, 2),  pw2); \
    VRD(ATT_AHEAD - 3); GAPA(C1 = MFMA(kf[5], qr[2], C1),   P1[6], P1[7], P1[8], P1[9],     pw2[2] = PKW(P1, 4),  pw2[3] = PKW(P1, 6),  pw2); \
    VRD(ATT_AHEAD - 2); GAPA(C0 = MFMA(kf[6], qr[3], C0),   P1[10], P1[11], P1[12], P1[13], pw3[0] = PKW(P1, 8),  pw3[1] = PKW(P1, 10), pw3); \
    VRD(ATT_AHEAD - 1); GAPA(C1 = MFMA(kf[7], qr[3], C1),   P1[14], P1[15], 0.f, 0.f,       pw3[2] = PKW(P1, 12), pw3[3] = PKW(P1, 14), pw3); \
    l_reg += sacc + sacc2; \
    if (!(VAR & 2)) { if (GK) DMA_K((t) + 3, sl_cur); if (GV) DMA_V((t) + 1, sl_next); }                                    \
    ATT_PAD(C0, C1); \
    if (MASK) { _Pragma("unroll") for (int r = 0; r < 16; ++r) { C0[r] = -INFINITY; C1[r] = -INFINITY; } }                                   \
    { const float rm = (VAR & 8) ? 0.f : rowmax(C0, C1); resc = false;                                                        \
      if (__builtin_expect(__any(rm > (float)ATT_THR), 0)) { const float dl = __builtin_fmaxf(rm, 0.f); mhat += dl;        \
          _Pragma("unroll") for (int r = 0; r < 16; ++r) { C0[r] -= dl; C1[r] -= dl; } \
          _Pragma("unroll") for (int r = 0; r < 16; ++r) negm[r] = -mhat; \
          asm volatile("" : "+v"(negm)); \
          const float f = __builtin_amdgcn_exp2f(-dl); l_reg *= f; if (hi == 0) wsf[r32] = f; resc = true; } } \
    SBAR(); \
    GAPB(0, C0, 0);  GAPB(1, C0, 2);  GAPB(2, C0, 4);  GAPB(3, C0, 6); \
    KRD(GL, 0); GAPB(4, C0, 8);  GAPB(5, C0, 10); KRD(GL, 1); GAPB(6, C0, 12); GAPB(7, C0, 14); \
    KRD(GL, 2); GAPB(8, C1, 0);  GAPB(9, C1, 2);  KRD(GL, 3); GAPB(10, C1, 4); GAPB(11, C1, 6); \
    GAPB(12, C1, 8); GAPB(13, C1, 10); GAPB(14, C1, 12); GAPB(15, C1, 14); \
    } while (0)
#define DRAIN(P0, P1, vs) do { float sacc = P0[0] + P0[1]; \
      _Pragma("unroll") for (int r = 2; r < 16; ++r) sacc += P0[r]; \
      _Pragma("unroll") for (int r = 0; r < 16; ++r) sacc += P1[r]; \
      l_reg += sacc; \
      pw0 = (v4u){PKW(P0, 0), PKW(P0, 2), PKW(P0, 4), PKW(P0, 6)}; pw1 = (v4u){PKW(P0, 8), PKW(P0, 10), PKW(P0, 12), PKW(P0, 14)}; \
      pw2 = (v4u){PKW(P1, 0), PKW(P1, 2), PKW(P1, 4), PKW(P1, 6)}; pw3 = (v4u){PKW(P1, 8), PKW(P1, 10), PKW(P1, 12), PKW(P1, 14)}; \
      const int va_ = vb0 + (vs); \
      _Pragma("unroll") for (int ks = 0; ks < 4; ++ks) { \
          _Pragma("unroll") for (int d = 0; d < 4; ++d) { \
              const s16x4 lo = vtr(lds + ((va_ ^ (d << 6)) + (16 * ks) * 256)); const s16x4 hh = vtr(lds + ((va_ ^ (d << 6)) + (16 * ks + 8) * 256)); \
              const bf16x8 vf = (bf16x8){lo[0], lo[1], lo[2], lo[3], hh[0], hh[1], hh[2], hh[3]}; \
              o[d] = MFMA(PAF_(ks), vf, o[d]); } SBAR(); } } while (0)
    int t = 1;
    for (; t + 5 < NT; t += 2) {
        STEP(pB0, pB1, pA0, pA1, t, true, true, true, false);     WAIT_BAR(4); RESC(); ROT();
        STEP(pA0, pA1, pB0, pB1, t + 1, true, true, true, false); WAIT_BAR(4); RESC(); ROT();
    }
    for (; t + 1 < NT; t += 2) {
        STEP(pB0, pB1, pA0, pA1, t, (t + 3 < NT), (t + 1 < NT), (t + 1 < NT), false);         ENDW(t);     RESC(); ROT();
        STEP(pA0, pA1, pB0, pB1, t + 1, (t + 4 < NT), (t + 2 < NT), (t + 2 < NT), false);     ENDW(t + 1); RESC(); ROT();
    }
    STEP(pB0, pB1, pA0, pA1, NT - 1, false, false, false, (wq < 2)); RESC();
    DRAIN(pB0, pB1, sl_cur);
    const float l_run = l_reg;
    __syncthreads();
#undef STEP
#undef DRAIN
#undef GAPA
#undef GAPB
#undef PAF_
#undef PAF
#undef PKW
#undef VFR
#undef VRD
#undef VADR
#undef KRD
#undef ENDW
#undef RESC
#undef KLOAD2
#undef ROT
#undef WAIT_BAR
#undef MFMA
#undef PIN
#undef SBAR
#undef DMA_K
#undef DMA_V
#undef RFL
    int tide = F.tid; asm volatile("" : "+v"(tide));
    const int lane_e = tide & 63, r32e = lane_e & 31, hie = lane_e >> 5;
    LAS float* wse = (LAS float*)(lds + WSF_OFF) + wid * 64;
    float lt; { float lo_, hh_; halves32(l_run, lo_, hh_); lt = lo_ + hh_; }
    CFENCE();
    if (hie == 0) wse[32 + r32e] = lt;
    CFENCE(); LDS_WAIT();
    {
        const float csc = c ? lam : 1.0f;
        LAS float* Xc = (LAS float*)(lds + c * XBYTES) + (wq * 32) * XROW + r32e;
#pragma unroll
        for (int g = 0; g < 4; ++g) { const f32x4 f = *(LAS const f32x4*)(wse + 32 + 8 * g + 4 * hie);
#pragma unroll
            for (int e = 0; e < 4; ++e) { const float sc = csc * __builtin_amdgcn_rcpf(f[e]); const int q = 8 * g + 4 * hie + e;
#pragma unroll
                for (int d = 0; d < 4; ++d) Xc[q * XROW + 32 * d] = o[d][4 * g + e] * sc; } }
    }
    __syncthreads();
    {
        const int row = tide >> 2, sg = tide & 3;
        const LAS float* x0 = (const LAS float*)lds + row * XROW + sg * 32;
        const LAS float* x1 = (const LAS float*)(lds + XBYTES) + row * XROW + sg * 32;
        f32x4 dv[8]; float ss = 0.f;
#pragma unroll
        for (int j = 0; j < 8; ++j) { dv[j] = *(const LAS f32x4*)(x0 + 4 * j) - *(const LAS f32x4*)(x1 + 4 * j); ss += (dv[j][0] * dv[j][0] + dv[j][1] * dv[j][1]) + (dv[j][2] * dv[j][2] + dv[j][3] * dv[j][3]); }
        ss += __builtin_bit_cast(float, __builtin_amdgcn_mov_dpp(__builtin_bit_cast(int, ss), 0xB1, 0xF, 0xF, true)); ss += __builtin_bit_cast(float, __builtin_amdgcn_mov_dpp(__builtin_bit_cast(int, ss), 0x4E, 0xF, 0xF, true));
        const float rs = (1.0f - LAMBDA_INIT) * __builtin_amdgcn_rsqf(ss * (1.0f / 128.0f) + EPS);
        bf16* yr = Q + (rowbase + qb * 128 + row) * HW + h * 128 + sg * 32;
        const float* sgp = subg + sg * 32;
#pragma unroll
        for (int j = 0; j < 4; ++j) { const f32x4 ga = *(const f32x4*)(sgp + 8 * j), gb = *(const f32x4*)(sgp + 8 * j + 4);
            v4u w; w.x = cvtpk(dv[2 * j][0] * rs * ga[0], dv[2 * j][1] * rs * ga[1]); w.y = cvtpk(dv[2 * j][2] * rs * ga[2], dv[2 * j][3] * rs * ga[3]);
            w.z = cvtpk(dv[2 * j + 1][0] * rs * gb[0], dv[2 * j + 1][1] * rs * gb[1]); w.w = cvtpk(dv[2 * j + 1][2] * rs * gb[2], dv[2 * j + 1][3] * rs * gb[3]);
            if (!(VAR & 1)) *(v4u*)(yr + 8 * j) = w; }
    }
    __syncthreads();
}
}

namespace sgu {
constexpr int VROW = 320, VN_BYTES = 128 * VROW;
constexpr int STAT_OFF = VN_BYTES;
__device__ __forceinline__ float dppx(float v, int ctrl_sel) {
    const int iv = __builtin_bit_cast(int, v);
    return __builtin_bit_cast(float, ctrl_sel == 0 ? __builtin_amdgcn_mov_dpp(iv, 0xB1, 0xF, 0xF, true) : ctrl_sel == 1 ? __builtin_amdgcn_mov_dpp(iv, 0x4E, 0xF, 0xF, true)
                                   : ctrl_sel == 2 ? __builtin_amdgcn_mov_dpp(iv, 0x141, 0xF, 0xF, true) : __builtin_amdgcn_mov_dpp(iv, 0x140, 0xF, 0xF, true));
}
__device__ __forceinline__ float wsum(float v) {
    v += dppx(v, 0); v += dppx(v, 1); v += dppx(v, 2); v += dppx(v, 3);
    const int iv = __builtin_bit_cast(int, v);
    return (__builtin_bit_cast(float, __builtin_amdgcn_readlane(iv, 0)) + __builtin_bit_cast(float, __builtin_amdgcn_readlane(iv, 16))) +
           (__builtin_bit_cast(float, __builtin_amdgcn_readlane(iv, 32)) + __builtin_bit_cast(float, __builtin_amdgcn_readlane(iv, 48)));
}
__device__ __forceinline__ void sgu_unit(const Frame& F, int blk, bf16* SU, const bf16* SV, const bf16* WSM, const float* lng, const float* lnb, const float* bs) {
    LAS unsigned char* lds = F.lds;
    int tid = F.tid; asm volatile("" : "+v"(tid));
    const int lane = tid & 63, r32 = lane & 31, hi = lane >> 5, wid = F.wave;
    const size_t R0 = (size_t)blk * 128;
    LAS float* stat = (LAS float*)(lds + STAT_OFF);
    { v4u wv[16];
#pragma unroll
      for (int i = 0; i < 16; ++i) wv[i] = *(const v4u*)(SV + (R0 + wid * 16 + i) * HW + lane * 8);
#pragma unroll
      for (int i = 0; i < 16; ++i) { const v4u w = wv[i];
        const float x[8] = {bf_lo(w.x), bf_hi(w.x), bf_lo(w.y), bf_hi(w.y), bf_lo(w.z), bf_hi(w.z), bf_lo(w.w), bf_hi(w.w)};
        float sm = 0.f;
#pragma unroll
        for (int e = 0; e < 8; ++e) sm += x[e];
        const float mu = wsum(sm) * (1.0f / 512.0f); float qv = 0.f;
#pragma unroll
        for (int e = 0; e < 8; ++e) { const float d = x[e] - mu; qv += d * d; }
        const float rstd = __builtin_amdgcn_rsqf(wsum(qv) * (1.0f / 512.0f) + EPS);
        if (lane == 0) { stat[2 * (wid * 16 + i)] = mu; stat[2 * (wid * 16 + i) + 1] = rstd; } } }
    __syncthreads();
    const int ib = wid & 3, chf = wid >> 2;
    const int grp = lane >> 4, qi = (lane & 15) >> 2, pi = lane & 3;
    const int vbase = (8 * (grp >> 1) + qi) * VROW + (16 * (grp & 1) + 4 * pi) * 2;
    for (int g = 0; g < 4; ++g) {
        { const int j = tid >> 2, sg = tid & 3; const float mu = stat[2 * j], rstd = stat[2 * j + 1];
          const bf16* src = SV + (R0 + j) * HW + g * 128 + sg * 32;
          v4u wv[4];
#pragma unroll
          for (int q = 0; q < 4; ++q) wv[q] = *(const v4u*)(src + q * 8);
#pragma unroll
          for (int q = 0; q < 4; ++q) { const v4u w = wv[q]; const int ch = g * 128 + sg * 32 + q * 8;
              const f32x4 ga = *(const f32x4*)(lng + ch), gb = *(const f32x4*)(lng + ch + 4), ba = *(const f32x4*)(lnb + ch), bb = *(const f32x4*)(lnb + ch + 4);
              v4u o;
              o.x = cvtpk((bf_lo(w.x) - mu) * rstd * ga[0] + ba[0], (bf_hi(w.x) - mu) * rstd * ga[1] + ba[1]);
              o.y = cvtpk((bf_lo(w.y) - mu) * rstd * ga[2] + ba[2], (bf_hi(w.y) - mu) * rstd * ga[3] + ba[3]);
              o.z = cvtpk((bf_lo(w.z) - mu) * rstd * gb[0] + bb[0], (bf_hi(w.z) - mu) * rstd * gb[1] + bb[1]);
              o.w = cvtpk((bf_lo(w.w) - mu) * rstd * gb[2] + bb[2], (bf_hi(w.w) - mu) * rstd * gb[3] + bb[3]);
              *(LAS v4u*)(lds + j * VROW + (sg * 32 + q * 8) * 2) = o; } }
        bf16x8 wf[8];
        { const bf16* Wg = WSM + (size_t)g * 128 * 128 + (size_t)(32 * ib + r32) * 128 + hi * 8;
#pragma unroll
          for (int s = 0; s < 8; ++s) wf[s] = *(const bf16x8*)(Wg + 16 * s); }
        bf16* sup = SU + (R0 + 32 * ib + r32) * HW + g * 128 + chf * 64 + 4 * hi;
        v2u sw[8];
#pragma unroll
        for (int k = 0; k < 8; ++k) sw[k] = *(const v2u*)(sup + (k >> 2) * 32 + (k & 3) * 8);
        const float bi = bs[g * 128 + 32 * ib + r32];
        __syncthreads();
        f32x16 acc[2]; acc[0] = (f32x16){}; acc[1] = (f32x16){};
#pragma unroll
        for (int s = 0; s < 8; ++s) {
#pragma unroll
            for (int cb = 0; cb < 2; ++cb) { const int cblk = 2 * chf + cb;
                const s16x4 lo = att::vtr(lds + vbase + (16 * s) * VROW + cblk * 64);
                const s16x4 hh = att::vtr(lds + vbase + (16 * s + 4) * VROW + cblk * 64);
                const bf16x8 vf = (bf16x8){lo[0], lo[1], lo[2], lo[3], hh[0], hh[1], hh[2], hh[3]};
                acc[cb] = __builtin_amdgcn_mfma_f32_32x32x16_bf16(vf, wf[s], acc[cb], 0, 0, 0); }
        }
#pragma unroll
        for (int k = 0; k < 8; ++k) { const int cb = k >> 2, q = k & 3; const v2u w = sw[k];
            const unsigned o0 = cvtpk(bf_lo(w.x) * (acc[cb][4 * q + 0] + bi), bf_hi(w.x) * (acc[cb][4 * q + 1] + bi));
            const unsigned o1 = cvtpk(bf_lo(w.y) * (acc[cb][4 * q + 2] + bi), bf_hi(w.y) * (acc[cb][4 * q + 3] + bi));
            *(v2u*)(sup + cb * 32 + q * 8) = (v2u){o0, o1}; }
        __syncthreads();
    }
}
}
namespace peer {
__device__ __forceinline__ float dpp_xor1(float v) { return __builtin_bit_cast(float, __builtin_amdgcn_mov_dpp(__builtin_bit_cast(int, v), 0xB1, 0xF, 0xF, true)); }
__device__ __forceinline__ float dpp_xor2(float v) { return __builtin_bit_cast(float, __builtin_amdgcn_mov_dpp(__builtin_bit_cast(int, v), 0x4E, 0xF, 0xF, true)); }
__device__ __forceinline__ void ins16(float (&L)[16], const float x, const float pinf) {
#pragma unroll
    for (int i = 15; i >= 1; --i) L[i] = __builtin_amdgcn_fmed3f(L[i - 1], L[i], x);
    L[0] = __builtin_amdgcn_fmed3f(L[0], x, pinf);
}
#define CE_(s, i, j) { const float a_ = s[i], b_ = s[j]; s[i] = __builtin_amdgcn_fmed3f(a_, b_, PINF); s[j] = __builtin_amdgcn_fmed3f(a_, b_, NINF); }
#define SORT16(s) do { CE_(s, 0, 1); CE_(s, 2, 3); CE_(s, 0, 2); CE_(s, 1, 3); CE_(s, 1, 2); CE_(s, 4, 5); CE_(s, 6, 7); CE_(s, 4, 6); CE_(s, 5, 7); CE_(s, 5, 6); CE_(s, 0, 4); CE_(s, 2, 6); CE_(s, 2, 4); CE_(s, 1, 5); CE_(s, 3, 7); CE_(s, 3, 5); CE_(s, 1, 2); CE_(s, 3, 4); CE_(s, 5, 6); CE_(s, 8, 9); CE_(s, 10, 11); CE_(s, 8, 10); CE_(s, 9, 11); CE_(s, 9, 10); CE_(s, 12, 13); CE_(s, 14, 15); CE_(s, 12, 14); CE_(s, 13, 15); CE_(s, 13, 14); CE_(s, 8, 12); CE_(s, 10, 14); CE_(s, 10, 12); CE_(s, 9, 13); CE_(s, 11, 15); CE_(s, 11, 13); CE_(s, 9, 10); CE_(s, 11, 12); CE_(s, 13, 14); CE_(s, 0, 8); CE_(s, 4, 12); CE_(s, 4, 8); CE_(s, 2, 10); CE_(s, 6, 14); CE_(s, 6, 10); CE_(s, 2, 4); CE_(s, 6, 8); CE_(s, 10, 12); CE_(s, 1, 9); CE_(s, 5, 13); CE_(s, 5, 9); CE_(s, 3, 11); CE_(s, 7, 15); CE_(s, 7, 11); CE_(s, 3, 5); CE_(s, 7, 9); CE_(s, 11, 13); CE_(s, 1, 2); CE_(s, 3, 4); CE_(s, 5, 6); CE_(s, 7, 8); CE_(s, 9, 10); CE_(s, 11, 12); CE_(s, 13, 14); } while (0)
#define SORT12(s) do { CE_(s, 0, 1); CE_(s, 2, 3); CE_(s, 0, 2); CE_(s, 1, 3); CE_(s, 1, 2); CE_(s, 4, 5); CE_(s, 6, 7); CE_(s, 4, 6); CE_(s, 5, 7); CE_(s, 5, 6); CE_(s, 0, 4); CE_(s, 2, 6); CE_(s, 2, 4); CE_(s, 1, 5); CE_(s, 3, 7); CE_(s, 3, 5); CE_(s, 1, 2); CE_(s, 3, 4); CE_(s, 5, 6); CE_(s, 8, 9); CE_(s, 10, 11); CE_(s, 8, 10); CE_(s, 9, 11); CE_(s, 9, 10); CE_(s, 9, 10); CE_(s, 0, 8); CE_(s, 4, 8); CE_(s, 2, 10); CE_(s, 6, 10); CE_(s, 2, 4); CE_(s, 6, 8); CE_(s, 1, 9); CE_(s, 5, 9); CE_(s, 3, 11); CE_(s, 7, 11); CE_(s, 3, 5); CE_(s, 7, 9); CE_(s, 1, 2); CE_(s, 3, 4); CE_(s, 5, 6); CE_(s, 7, 8); CE_(s, 9, 10); } while (0)
#define BITONIC16(s) do { CE_(s, 0, 8); CE_(s, 1, 9); CE_(s, 2, 10); CE_(s, 3, 11); CE_(s, 4, 12); CE_(s, 5, 13); CE_(s, 6, 14); CE_(s, 7, 15); CE_(s, 0, 4); CE_(s, 1, 5); CE_(s, 2, 6); CE_(s, 3, 7); CE_(s, 8, 12); CE_(s, 9, 13); CE_(s, 10, 14); CE_(s, 11, 15); CE_(s, 0, 2); CE_(s, 1, 3); CE_(s, 4, 6); CE_(s, 5, 7); CE_(s, 8, 10); CE_(s, 9, 11); CE_(s, 12, 14); CE_(s, 13, 15); CE_(s, 0, 1); CE_(s, 2, 3); CE_(s, 4, 5); CE_(s, 6, 7); CE_(s, 8, 9); CE_(s, 10, 11); CE_(s, 12, 13); CE_(s, 14, 15); } while (0)
#define MERGE16(L, C) do { _Pragma("unroll") for (int i_ = 0; i_ < 16; ++i_) L[i_] = __builtin_amdgcn_fmed3f(L[i_], C[15 - i_], PINF); BITONIC16(L); } while (0)
__device__ __forceinline__ float tagf(float v, unsigned mask, unsigned tag) { return __builtin_bit_cast(float, (__builtin_bit_cast(unsigned, v) & ~mask) | tag); }
__device__ __forceinline__ float sel16(const float (&A)[16], int i) {
    float r = A[0];
#pragma unroll
    for (int k = 1; k < 16; ++k) { const float ak = A[k]; r = (i == k) ? ak : r; }
    return r;
}
__device__ __forceinline__ void topk_phase(const Frame& F) {
    const unsigned short* S = (const unsigned short*)(F.ws + WS_SCORES); const float* ssq = (const float*)(F.ws + WS_SSQ);
    float* GW = (float*)(F.ws + WS_GW);
    const int gw = F.vcu * NWAVES + F.wave, NGW = F.G * NWAVES, lane = F.lane;
    const int q = lane & 3;
    static_assert(T * PK_HEADS / 16 == NEXP, "two table rows per top-k wave-item");
    float PINF = __builtin_inff(), NINF = -__builtin_inff(); asm volatile("" : "+s"(PINF), "+s"(NINF));
    f32x4 g2v[4];
#pragma unroll
    for (int j = 0; j < 4; ++j) g2v[j] = *(const f32x4*)(F.in[17] + 16 * lane + 4 * j);
    for (int it = gw; it < T * PK_HEADS / 16; it += NGW) {
        const bool isu = it < NEXP / 2; const int e0 = isu ? 2 * it : 2 * it - NEXP;
        f32x4 tr0[4], tr1[4];
        const int th = it * 16 + (lane >> 2), t = th >> 3, h = th & 7;
        const unsigned short* sp = S + (size_t)t * 2048 + h * 256 + q * 64;
        typedef _Float16 h16x8 __attribute__((ext_vector_type(8)));
        h16x8 hv[8];
#pragma unroll
        for (int j = 0; j < 8; ++j) hv[j] = *(const h16x8*)(sp + 8 * j);
        float L[16];
#pragma unroll
        for (int e = 0; e < 8; ++e) { L[e] = tagf((float)hv[0][e], 127u, (unsigned)((q & 1) * 64 + e)); L[8 + e] = tagf((float)hv[1][e], 127u, (unsigned)((q & 1) * 64 + 8 + e)); }
        SORT16(L);
#pragma unroll
        for (int c4 = 1; c4 < 4; ++c4) { float C[16];
#pragma unroll
            for (int e = 0; e < 8; ++e) { C[e] = tagf((float)hv[2 * c4][e], 127u, (unsigned)((q & 1) * 64 + 16 * c4 + e)); C[8 + e] = tagf((float)hv[2 * c4 + 1][e], 127u, (unsigned)((q & 1) * 64 + 16 * c4 + 8 + e)); }
            SORT16(C); MERGE16(L, C); }
        __builtin_amdgcn_sched_barrier(0);
        { const float* src = (isu ? F.in[20] : F.in[21]) + (size_t)e0 * DM + 16 * lane;
#pragma unroll
          for (int j = 0; j < 4; ++j) { tr0[j] = *(const f32x4*)(src + 4 * j); tr1[j] = *(const f32x4*)(src + DM + 4 * j); } }
        __builtin_amdgcn_sched_barrier(0);
        { float P[16];
#pragma unroll
          for (int i = 0; i < 16; ++i) P[i] = dpp_xor1(L[i]);
          MERGE16(L, P); }
        float A[16], B[16];
        { const bool lowp = q < 2;
#pragma unroll
          for (int i = 0; i < 16; ++i) { const float o = dpp_xor2(L[i]); A[i] = lowp ? L[i] : o; B[i] = lowp ? o : L[i]; } }
        float Bc[16], W[16];
#pragma unroll
        for (int b = 0; b < 16; ++b) Bc[b] = tagf(B[b], 127u, 0u);
        { const float sa = tagf(A[0], 127u, 0u);
#pragma unroll
          for (int b = 0; b < 16; ++b) W[b] = tagf(sa + Bc[b], 255u, (unsigned)(255 - b)); }
        { const float sa = tagf(A[1], 127u, 0u);
#pragma unroll
          for (int i = 8; i < 16; ++i) W[i] = __builtin_amdgcn_fmed3f(W[i], tagf(sa + Bc[15 - i], 255u, (unsigned)(255 - (16 + 15 - i))), PINF);
          BITONIC16(W); }
#define CAND_(a, b) tagf(tagf(A[a], 127u, 0u) + Bc[b], 255u, (unsigned)(255 - ((a) * 16 + (b))))
        { float X[14];
#pragma unroll
          for (int k = 0; k < 14; ++k) X[k] = CAND_(2 + k, 0);
#pragma unroll
          for (int i = 2; i < 16; ++i) W[i] = __builtin_amdgcn_fmed3f(W[i], X[15 - i], PINF);
          BITONIC16(W); }
        { float Y[16];
#pragma unroll
          for (int k = 0; k < 6; ++k) Y[k] = CAND_(2 + k, 1);
#pragma unroll
          for (int k = 0; k < 3; ++k) Y[6 + k] = CAND_(2 + k, 2);
          Y[9] = CAND_(2, 3); Y[10] = CAND_(3, 3); Y[11] = CAND_(2, 4);
          Y[12] = NINF; Y[13] = NINF; Y[14] = NINF; Y[15] = NINF;
          SORT12(Y);
#pragma unroll
          for (int i = 4; i < 16; ++i) W[i] = __builtin_amdgcn_fmed3f(W[i], Y[15 - i], PINF);
          BITONIC16(W); }
#undef CAND_
        const f32x4 pq = *(const f32x4*)(ssq + (size_t)t * 16 + 4 * q);
        float pss = (pq[0] + pq[1]) + (pq[2] + pq[3]); pss += dpp_xor1(pss); pss += dpp_xor2(pss);
        const float rstd = 1.0f / sqrtf(pss * (1.0f / DM) + EPS);
        const float z0 = tagf(W[0], 255u, 0u) * rstd; float es = 0.f;
#pragma unroll
        for (int i = 0; i < 16; ++i) es += __expf(tagf(W[i], 255u, 0u) * rstd - z0);
        const float inv = 1.0f / es;
        int eo[4]; float go[4];
        unsigned PA[4], PB[4];
#pragma unroll
        for (int d = 0; d < 4; ++d) {
            const unsigned a01 = __builtin_amdgcn_perm(__builtin_bit_cast(unsigned, A[4 * d + 1]), __builtin_bit_cast(unsigned, A[4 * d]), 0x0c0c0400u), a23 = __builtin_amdgcn_perm(__builtin_bit_cast(unsigned, A[4 * d + 3]), __builtin_bit_cast(unsigned, A[4 * d + 2]), 0x0c0c0400u);
            const unsigned b01 = __builtin_amdgcn_perm(__builtin_bit_cast(unsigned, B[4 * d + 1]), __builtin_bit_cast(unsigned, B[4 * d]), 0x0c0c0400u), b23 = __builtin_amdgcn_perm(__builtin_bit_cast(unsigned, B[4 * d + 3]), __builtin_bit_cast(unsigned, B[4 * d + 2]), 0x0c0c0400u);
            PA[d] = __builtin_amdgcn_perm(a23, a01, 0x05040100u); PB[d] = __builtin_amdgcn_perm(b23, b01, 0x05040100u); }
#pragma unroll
        for (int j = 0; j < 4; ++j) {
            const float w0 = W[j], w1 = W[4 + j], w2 = W[8 + j], w3 = W[12 + j];
            float w = w0; w = (q == 1) ? w1 : w; w = (q == 2) ? w2 : w; w = (q == 3) ? w3 : w;
            const unsigned bits = __builtin_bit_cast(unsigned, w);
            const int ai = 15 - (int)((bits >> 4) & 15), bi = 15 - (int)(bits & 15);
            const unsigned sa_ = ((unsigned)ai & 7u) | 0x0c0c0c00u, sb_ = ((unsigned)bi & 7u) | 0x0c0c0c00u;
            const unsigned i1 = ((ai & 8) ? __builtin_amdgcn_perm(PA[3], PA[2], sa_) : __builtin_amdgcn_perm(PA[1], PA[0], sa_)) & 127u;
            const unsigned i2 = ((bi & 8) ? __builtin_amdgcn_perm(PB[3], PB[2], sb_) : __builtin_amdgcn_perm(PB[1], PB[0], sb_)) & 127u;
            eo[j] = (int)(i1 * 128u + i2);
            go[j] = __expf(tagf(w, 255u, 0u) * rstd - z0) * inv;
        }
        typedef int i32x4 __attribute__((ext_vector_type(4)));
        *(v2u*)((unsigned*)(F.ws + WS_IDX16) + (size_t)t * 64 + h * 8 + 2 * q) = (v2u){(unsigned)eo[0] | ((unsigned)eo[1] << 16), (unsigned)eo[2] | ((unsigned)eo[3] << 16)};
        *(f32x4*)(GW + (size_t)t * 128 + h * 16 + 4 * q) = (f32x4){go[0], go[1], go[2], go[3]};
        if (isu) {
#pragma unroll
            for (int j = 0; j < 4; ++j) { tr0[j] = tr0[j] * g2v[j]; tr1[j] = tr1[j] * g2v[j]; } }
        table_row_store(F.ws, tr0, isu, e0, lane); table_row_store(F.ws, tr1, isu, e0 + 1, lane);
    }
    {
        unsigned char* X1H = F.ws + WS_X1H; unsigned char* X1L = F.ws + WS_X1L; float* X1S = (float*)(F.ws + WS_X1S);
        for (int t = gw; t < T; t += NGW) {
            f32x4 v[4]; float am = 0.f;
            { const bf16* xb = (const bf16*)(F.ws + WS_XB) + (size_t)t * DM + 16 * lane;
              const v4u w0 = *(const v4u*)xb, w1 = *(const v4u*)(xb + 8);
              v[0] = (f32x4){bf_lo(w0.x), bf_hi(w0.x), bf_lo(w0.y), bf_hi(w0.y)}; v[1] = (f32x4){bf_lo(w0.z), bf_hi(w0.z), bf_lo(w0.w), bf_hi(w0.w)};
              v[2] = (f32x4){bf_lo(w1.x), bf_hi(w1.x), bf_lo(w1.y), bf_hi(w1.y)}; v[3] = (f32x4){bf_lo(w1.z), bf_hi(w1.z), bf_lo(w1.w), bf_hi(w1.w)}; }
#pragma unroll
            for (int j = 0; j < 4; ++j) am = fmaxf(am, fmaxf(fmaxf(fabsf(v[j][0]), fabsf(v[j][1])), fmaxf(fabsf(v[j][2]), fabsf(v[j][3]))));
            { int iv = __builtin_bit_cast(int, am);
              iv = max(iv, __builtin_amdgcn_mov_dpp(iv, 0xB1, 0xF, 0xF, true)); iv = max(iv, __builtin_amdgcn_mov_dpp(iv, 0x4E, 0xF, 0xF, true));
              iv = max(iv, __builtin_amdgcn_mov_dpp(iv, 0x141, 0xF, 0xF, true)); iv = max(iv, __builtin_amdgcn_mov_dpp(iv, 0x140, 0xF, 0xF, true));
              am = __builtin_bit_cast(float, iv); }
            const float sx = am > 0.f ? 119.0f / am : 0.f;
            unsigned ph[2] = {0u, 0u}, pl[2] = {0u, 0u};
#pragma unroll
            for (int k = 0; k < 16; ++k) { const int x = __float2int_rn(v[k >> 2][k & 3] * sx);
                ph[k >> 3] |= (((unsigned)(x + 8) >> 4) & 15u) << (4 * (k & 7)); pl[k >> 3] |= ((unsigned)x & 15u) << (4 * (k & 7)); }
            *(v2u*)(X1H + (size_t)t * 512 + 8 * lane) = (v2u){ph[0], ph[1]};
            *(v2u*)(X1L + (size_t)t * 512 + 8 * lane) = (v2u){pl[0], pl[1]};
            if ((lane & 15) == 0) X1S[(size_t)t * 4 + (lane >> 4)] = am * (1.0f / 119.0f);
        }
    }
}
struct Slice { int p0, np, wrank, wcount; };
__device__ __forceinline__ Slice slice_of(const Frame& F) {
    Slice s; const int b = (int)blockIdx.x;
    if (F.G % 8 == 0) { s.p0 = b & 7; s.np = 1; s.wrank = (b >> 3) * NWAVES + F.wave; s.wcount = (F.G >> 3) * NWAVES; }
    else { s.p0 = 0; s.np = 8; s.wrank = b * NWAVES + F.wave; s.wcount = F.G * NWAVES; }
    return s;
}
typedef int i32x4 __attribute__((ext_vector_type(4)));
__device__ __forceinline__ void expert_u_phase(const Frame& F, const int tb, const int te) {
    bf16* PART = (bf16*)(F.ws + WS_PART);
    const int lane = F.lane, g = lane >> 3, i = lane & 7;
    const Slice sl = slice_of(F);
    for (int p = sl.p0; p < sl.p0 + sl.np; ++p) {
    const int sp = p >> 1, par = p & 1, nu = (te - tb) >> 1;
    const int ufirst = sl.wrank;
    if (ufirst >= nu) continue;
    const int ulast = ufirst + ((nu - 1 - ufirst) / sl.wcount) * sl.wcount;
    const unsigned* ID16 = (const unsigned*)(F.ws + WS_IDX16);
    const unsigned char* UQs = F.ws + WS_UQ + (size_t)sp * (NEXP * 128);
    const unsigned char* X1H = F.ws + WS_X1H + 128 * sp + 16 * i; const unsigned char* X1L = F.ws + WS_X1L + 128 * sp + 16 * i;
    const int odd = lane & 1;
#define U_SPLIT(ev, m) do { const v4u nb_ = (v4u){(unsigned)__builtin_amdgcn_mov_dpp((int)m.x, 0xB1, 0xF, 0xF, true), (unsigned)__builtin_amdgcn_mov_dpp((int)m.y, 0xB1, 0xF, 0xF, true), \
                                                  (unsigned)__builtin_amdgcn_mov_dpp((int)m.z, 0xB1, 0xF, 0xF, true), (unsigned)__builtin_amdgcn_mov_dpp((int)m.w, 0xB1, 0xF, 0xF, true)}; \
        ev[0] = odd ? nb_ : m; ev[1] = odd ? m : nb_; } while (0)
#define U_GATHER(W, m) do { v4u ev_[2]; U_SPLIT(ev_, m); \
        _Pragma("unroll") for (int s = 0; s < 16; ++s) { const unsigned pk = ev_[s >> 3][(s >> 1) & 3]; const unsigned e = (s & 1) ? (pk >> 16) : (pk & 0xffffu); W[s] = *(const v4u*)(UQs + (e * 128u + 16u * i)); } } while (0)
#define U_TOK(u_) (tb + 2 * (u_) + par)
#define U_CLAMP(x) (((x) <= ulast) ? (x) : ulast)
#define U_STEP(Wc, Wn, uc) do { \
        const int u1_ = U_CLAMP((uc) + sl.wcount), u2_ = U_CLAMP(u1_ + sl.wcount); const int t_ = U_TOK(uc), t1_ = U_TOK(u1_), t2_ = U_TOK(u2_); \
        U_GATHER(Wn, evn); \
        const v4u ev2_ = *(const v4u*)(ID16 + (size_t)t2_ * 64 + 8 * g + 4 * odd); \
        const i32x4 xhn = *(const i32x4*)(X1H + (size_t)t1_ * 512), xln = *(const i32x4*)(X1L + (size_t)t1_ * 512); \
        __builtin_amdgcn_sched_barrier(0); \
        int part[16]; \
        _Pragma("unroll") for (int s = 0; s < 16; ++s) { \
            int ah = __builtin_amdgcn_sdot8((int)Wc[s].x, xh[0], 0, false); ah = __builtin_amdgcn_sdot8((int)Wc[s].y, xh[1], ah, false); \
            ah = __builtin_amdgcn_sdot8((int)Wc[s].z, xh[2], ah, false); ah = __builtin_amdgcn_sdot8((int)Wc[s].w, xh[3], ah, false); \
            int al = __builtin_amdgcn_sdot8((int)Wc[s].x, xl[0], 0, false); al = __builtin_amdgcn_sdot8((int)Wc[s].y, xl[1], al, false); \
            al = __builtin_amdgcn_sdot8((int)Wc[s].z, xl[2], al, false); al = __builtin_amdgcn_sdot8((int)Wc[s].w, xl[3], al, false); \
            part[s] = ah * 16 + al; } \
          \
        { const bool up = (i & 4) != 0; \
          _Pragma("unroll") for (int k = 0; k < 8; ++k) { const int lo_ = part[k], hi_ = part[k + 8]; const int keep = up ? hi_ : lo_, send = up ? lo_ : hi_; part[k] = keep + __builtin_amdgcn_mov_dpp(send, 0x141, 0xF, 0xF, true); } }        \
        { const bool up = (i & 2) != 0; \
          _Pragma("unroll") for (int k = 0; k < 4; ++k) { const int lo_ = part[k], hi_ = part[k + 4]; const int keep = up ? hi_ : lo_, send = up ? lo_ : hi_; part[k] = keep + __builtin_amdgcn_mov_dpp(send, 0x4E, 0xF, 0xF, true); } } \
        { const bool up = (i & 1) != 0; \
          _Pragma("unroll") for (int k = 0; k < 2; ++k) { const int lo_ = part[k], hi_ = part[k + 2]; const int keep = up ? hi_ : lo_, send = up ? lo_ : hi_; part[k] = keep + __builtin_amdgcn_mov_dpp(send, 0xB1, 0xF, 0xF, true); } } \
        *(unsigned*)(PART + ((size_t)sp * T + t_) * 128 + 16 * g + 2 * i) = cvtpk((float)part[0], (float)part[1]);     \
        evn = ev2_; xh = xhn; xl = xln; } while (0)
    v4u WA[16], WB[16], evn; i32x4 xh, xl;
    int u = ufirst;
    { const int t0 = U_TOK(u), t1 = U_TOK(U_CLAMP(u + sl.wcount));
      const v4u ev0 = *(const v4u*)(ID16 + (size_t)t0 * 64 + 8 * g + 4 * odd);
      evn = *(const v4u*)(ID16 + (size_t)t1 * 64 + 8 * g + 4 * odd);
      xh = *(const i32x4*)(X1H + (size_t)t0 * 512); xl = *(const i32x4*)(X1L + (size_t)t0 * 512);
      U_GATHER(WA, ev0); }
    for (;;) {
        U_STEP(WA, WB, u);
        if (u + sl.wcount > ulast) break;
        u += sl.wcount;
        U_STEP(WB, WA, u);
        if (u + sl.wcount > ulast) break;
        u += sl.wcount;
    }
#undef U_SPLIT
#undef U_GATHER
#undef U_TOK
#undef U_CLAMP
#undef U_STEP
    }
}
struct CoefIn { v4u pp[4]; v4u idw; f32x4 g0, g1, dq0, sq[4]; };
__device__ __forceinline__ void expert_coef_phase(const Frame& F, const int tb, const int te) {
    const bf16* PART = (const bf16*)(F.ws + WS_PART); const float* GW = (const float*)(F.ws + WS_GW);
    const float* ssq = (const float*)(F.ws + WS_SSQ);
    const unsigned short* ID16 = (const unsigned short*)(F.ws + WS_IDX16); const float* X1S = (const float*)(F.ws + WS_X1S);
    const int gt = F.vcu * (NWAVES * 64) + F.tid, NGT = F.G * NWAVES * 64;
#define C_LOAD(D, i8_) do { const int it_ = (i8_) * 8, t_ = (i8_) >> 4; \
        _Pragma("unroll") for (int p = 0; p < 4; ++p) D.pp[p] = *(const v4u*)(PART + (size_t)p * T * 128 + it_); \
        D.idw = *(const v4u*)(ID16 + it_); \
        D.g0 = *(const f32x4*)(GW + it_); D.g1 = *(const f32x4*)(GW + it_ + 4); \
        D.dq0 = *(const f32x4*)(X1S + (size_t)t_ * 4); \
        _Pragma("unroll") for (int j = 0; j < 4; ++j) D.sq[j] = *(const f32x4*)(ssq + (size_t)t_ * 16 + 4 * j); } while (0)
#define C_ITEM(D, N, i8c, i8n) do { const int it = (i8c) * 8, t = (i8c) >> 4; \
        const v4u idw = D.idw; \
        const unsigned ids[8] = {idw.x & 0xffffu, idw.x >> 16, idw.y & 0xffffu, idw.y >> 16, idw.z & 0xffffu, idw.z >> 16, idw.w & 0xffffu, idw.w >> 16}; \
        float su[8], sv[8]; \
        _Pragma("unroll") for (int k = 0; k < 8; ++k) { const f32x2 s2 = SUVL[ids[k]]; su[k] = s2[0]; sv[k] = s2[1]; } \
        __builtin_amdgcn_sched_barrier(0); \
        C_LOAD(N, i8n); \
        __builtin_amdgcn_sched_barrier(0); \
        float q = 0.f; \
        _Pragma("unroll") for (int j = 0; j < 4; ++j) q += (D.sq[j][0] + D.sq[j][1]) + (D.sq[j][2] + D.sq[j][3]); \
        const float rstd = __builtin_amdgcn_rsqf(q * (1.0f / DM) + EPS); \
        float s[8]; \
        _Pragma("unroll") for (int k = 0; k < 8; ++k) s[k] = 0.f; \
        _Pragma("unroll") for (int p = 0; p < 4; ++p) { const float d = D.dq0[p];       \
            const v4u pv = D.pp[p]; \
            s[0] += bf_lo(pv.x) * d; s[1] += bf_hi(pv.x) * d; s[2] += bf_lo(pv.y) * d; s[3] += bf_hi(pv.y) * d; s[4] += bf_lo(pv.z) * d; s[5] += bf_hi(pv.z) * d; s[6] += bf_lo(pv.w) * d; s[7] += bf_hi(pv.w) * d; } \
        const float gw[8] = {D.g0[0], D.g0[1], D.g0[2], D.g0[3], D.g1[0], D.g1[1], D.g1[2], D.g1[3]}; \
        float c[8]; \
        _Pragma("unroll") for (int k = 0; k < 8; ++k) c[k] = gelu1(s[k] * rstd * su[k]) * gw[k] * sv[k]; \
          \
        float am = 0.f; \
        _Pragma("unroll") for (int k = 0; k < 8; ++k) am = fmaxf(am, fabsf(c[k])); \
        { int iv = __builtin_bit_cast(int, am); \
          iv = max(iv, __builtin_amdgcn_mov_dpp(iv, 0xB1, 0xF, 0xF, true)); iv = max(iv, __builtin_amdgcn_mov_dpp(iv, 0x4E, 0xF, 0xF, true)); \
          iv = max(iv, __builtin_amdgcn_mov_dpp(iv, 0x141, 0xF, 0xF, true)); iv = max(iv, __builtin_amdgcn_mov_dpp(iv, 0x140, 0xF, 0xF, true)); \
          am = __builtin_bit_cast(float, iv); } \
        const float qs = am > 0.f ? 127.0f / am : 0.f; \
        unsigned q0 = 0u, q1 = 0u; int sm = 0; \
        _Pragma("unroll") for (int k = 0; k < 4; ++k) { const int a_ = __float2int_rn(c[k] * qs), b_ = __float2int_rn(c[4 + k] * qs); sm += a_ + b_; q0 |= ((unsigned)a_ & 0xffu) << (8 * k); q1 |= ((unsigned)b_ & 0xffu) << (8 * k); } \
        *(v2u*)(F.ws + WS_COEF + it) = (v2u){q0, q1}; \
        sm += __builtin_amdgcn_mov_dpp(sm, 0xB1, 0xF, 0xF, true); sm += __builtin_amdgcn_mov_dpp(sm, 0x4E, 0xF, 0xF, true);        \
        sm += __builtin_amdgcn_mov_dpp(sm, 0x141, 0xF, 0xF, true); sm += __builtin_amdgcn_mov_dpp(sm, 0x140, 0xF, 0xF, true); \
        if (((i8c) & 15) == 0) ((f32x2*)(F.ws + WS_CSC))[t] = (f32x2){am * (1.0f / 127.0f), am * (8.0f / 127.0f) * (float)sm}; } while (0)
    LAS const f32x2* SUVL = (LAS const f32x2*)F.lds;
    { const v4u* src = (const v4u*)(F.ws + WS_SUQ); LAS v4u* dst = (LAS v4u*)F.lds;
      for (int k = F.tid; k < NEXP * 8 / 16; k += NWAVES * 64) dst[k] = src[k];
      __syncthreads(); }
    const int end8 = te * 16;
    int it8 = tb * 16 + gt;
    if (it8 >= end8) return;
    CoefIn A, B;
    C_LOAD(A, it8);
    for (;;) {
        { const int nx = (it8 + NGT < end8) ? it8 + NGT : it8; C_ITEM(A, B, it8, nx); }
        if (it8 + NGT >= end8) break;
        it8 += NGT;
        { const int nx = (it8 + NGT < end8) ? it8 + NGT : it8; C_ITEM(B, A, it8, nx); }
        if (it8 + NGT >= end8) break;
        it8 += NGT;
    }
#undef C_LOAD
#undef C_ITEM
}
__device__ __forceinline__ float bfly32(float keep_lo, float keep_hi) { asm("s_nop 1\n\tv_permlane32_swap_b32_e32 %0, %1" : "+v"(keep_lo), "+v"(keep_hi)); return keep_lo + keep_hi; }
__device__ __forceinline__ float bfly16(float keep_lo, float keep_hi) { asm("s_nop 1\n\tv_permlane16_swap_b32_e32 %0, %1" : "+v"(keep_lo), "+v"(keep_hi)); return keep_lo + keep_hi; }
__device__ __forceinline__ float dpp_ror8(float v) { return __builtin_bit_cast(float, __builtin_amdgcn_mov_dpp(__builtin_bit_cast(int, v), 0x128, 0xF, 0xF, true)); }
__device__ __forceinline__ float wave_sum_dpp(float v) {
    v += dpp_xor1(v); v += dpp_xor2(v);
    v += __builtin_bit_cast(float, __builtin_amdgcn_mov_dpp(__builtin_bit_cast(int, v), 0x141, 0xF, 0xF, true));
    v += __builtin_bit_cast(float, __builtin_amdgcn_mov_dpp(__builtin_bit_cast(int, v), 0x140, 0xF, 0xF, true));
    const int iv = __builtin_bit_cast(int, v);
    return (__builtin_bit_cast(float, __builtin_amdgcn_readlane(iv, 0)) + __builtin_bit_cast(float, __builtin_amdgcn_readlane(iv, 16))) +
           (__builtin_bit_cast(float, __builtin_amdgcn_readlane(iv, 32)) + __builtin_bit_cast(float, __builtin_amdgcn_readlane(iv, 48)));
}
#ifndef VBURST
#define VBURST 0
#endif
__device__ __forceinline__ v2u vtr8(LAS const unsigned char* p) {
    typedef int v2i32_t __attribute__((ext_vector_type(2)));
    return __builtin_bit_cast(v2u, __builtin_amdgcn_ds_read_tr8_b64_v2i32((LAS v2i32_t*)p));
}
__device__ __forceinline__ void expert_v_phase(const Frame& F, const int tb, const int te) {
    const int lane = F.lane, g = lane >> 3, i = lane & 7;
    const int n16 = lane & 15, qd = lane >> 4, q8 = n16 >> 1, h8 = lane & 1, odd = lane & 1;
    LAS unsigned char* buf = F.lds + F.wave * 16384;
    const Slice sl = slice_of(F);
    for (int p = sl.p0; p < sl.p0 + sl.np; ++p) {
    const int sp = p >> 1, par = p & 1, nu = (te - tb) >> 1;
#define TOK(u) (tb + 2 * (u) + par)
    const int ufirst = sl.wrank;
    if (ufirst >= nu) continue;
    const int ulast = ufirst + ((nu - 1 - ufirst) / sl.wcount) * sl.wcount;
    const unsigned* ID16 = (const unsigned*)(F.ws + WS_IDX16) + 8 * g;
    const unsigned char* VQs = F.ws + WS_VQ + (size_t)sp * (NEXP * 128);
    const unsigned lo16 = 16u * i;
    const bf16* XBp = (const bf16*)(F.ws + WS_XB) + 256 * sp + 64 * qd + 2 * n16;
    bf16* YBp = (bf16*)(F.ws + WS_YB) + 256 * sp + 64 * qd + 2 * n16;
    const unsigned char* C8p = F.ws + WS_COEF + 16 * qd;
    const f32x2* CSC = (const f32x2*)(F.ws + WS_CSC);
    LAS unsigned char* const wrb = buf + (16 * g) * 128;
    const int iw = i ^ ((g & 1) << 2);
    const int fr = ((q8 >> 1) & 3) | ((qd & 1) << 2);
    const int trb = (16 * qd + q8) * 128 + 8 * h8;
    LAS const unsigned char* tr[8];
#pragma unroll
    for (int T = 0; T < 8; ++T) tr[T] = buf + trb + ((T ^ fr) << 4);
#define V_IDS(ev, tt) do { ev = *(const v4u*)(ID16 + (size_t)(tt) * 64 + 4 * odd); } while (0)
#define V_SMALL(c8, tt) do { c8 = *(const v4u*)(C8p + (size_t)(tt) * 128 + 64 * odd); } while (0)
#define V_XLOAD(xa, xb, cs, tt) do { xa = *(const unsigned*)(XBp + (size_t)(tt) * DM); xb = *(const unsigned*)(XBp + (size_t)(tt) * DM + 32); cs = CSC[tt]; } while (0)
#define V_NB(x) ((unsigned)__builtin_amdgcn_mov_dpp((int)(x), 0xB1, 0xF, 0xF, true))
#define V_SPLIT(o0, o1, m) do { const v4u nb_ = (v4u){V_NB(m.x), V_NB(m.y), V_NB(m.z), V_NB(m.w)}; \
        o0 = odd ? nb_ : m; o1 = odd ? m : nb_; } while (0)
#define V_GATHER(W, evm) do { v4u ev[2]; V_SPLIT(ev[0], ev[1], evm); \
        _Pragma("unroll") for (int s = 0; s < 16; ++s) { const unsigned pk = ev[s >> 3][(s >> 1) & 3]; const unsigned e = (s & 1) ? (pk >> 16) : (pk & 0xffffu); W[s] = *(const v4u*)(VQs + (e * 128u + lo16)); } } while (0)
#define V_WRITE(W) do { _Pragma("unroll") for (int s = 0; s < 16; ++s) *(LAS v4u*)(wrb + s * 128 + ((iw ^ ((s >> 1) & 3)) << 4)) = W[s]; } while (0)
#define V_BREAD(B, h4) do { \
        _Pragma("unroll") for (int T = 0; T < 4; ++T) { B[2 * T] = vtr8(tr[4 * ((h4) & 1) + T] + ((h4) >> 1) * 8192); B[2 * T + 1] = vtr8(tr[4 * ((h4) & 1) + T] + ((h4) >> 1) * 8192 + 1024); } } while (0)
#define V_MFMA(B, h4) do { \
        const i32x4 A0 = __builtin_bit_cast(i32x4, c8c_[(h4) >> 1]); const unsigned m_ = 0x0f0f0f0fu; \
        _Pragma("unroll") for (int T = 0; T < 4; ++T) { \
            const i32x4 Bv = __builtin_bit_cast(i32x4, (v4u){B[2 * T].x, B[2 * T].y, B[2 * T + 1].x, B[2 * T + 1].y}); \
            const i32x4 Bl = __builtin_bit_cast(i32x4, (v4u){B[2 * T].x & m_, B[2 * T].y & m_, B[2 * T + 1].x & m_, B[2 * T + 1].y & m_}); \
            accR[T] = __builtin_amdgcn_mfma_i32_16x16x64_i8(A0, Bv, accR[T], 0, 0, 0); accL[T] = __builtin_amdgcn_mfma_i32_16x16x64_i8(A0, Bl, accL[T], 0, 0, 0); } } while (0)
#define V_REFILL(W, q_) do { _Pragma("unroll") for (int s = 4 * (q_); s < 4 * (q_) + 4; ++s) { const unsigned pk = ev2_[s >> 3][(s >> 1) & 3]; const unsigned e = (s & 1) ? (pk >> 16) : (pk & 0xffffu); W[s] = *(const v4u*)(VQs + (e * 128u + lo16)); } } while (0)
#define V_MFMA2(B, h4, FIRST) do { const i32x4 z_ = (i32x4){0, 0, 0, 0}; \
        const i32x4 A0 = __builtin_bit_cast(i32x4, c8c_[(h4) >> 1]); const unsigned m_ = 0x0f0f0f0fu; \
        _Pragma("unroll") for (int T = 0; T < 4; ++T) { \
            const i32x4 Bv = __builtin_bit_cast(i32x4, (v4u){B[2 * T].x, B[2 * T].y, B[2 * T + 1].x, B[2 * T + 1].y}); \
            const i32x4 Bl = __builtin_bit_cast(i32x4, (v4u){B[2 * T].x & m_, B[2 * T].y & m_, B[2 * T + 1].x & m_, B[2 * T + 1].y & m_}); \
            accR[T] = __builtin_amdgcn_mfma_i32_16x16x64_i8(A0, Bv, (FIRST) ? z_ : accR[T], 0, 0, 0); accL[T] = __builtin_amdgcn_mfma_i32_16x16x64_i8(A0, Bl, (FIRST) ? z_ : accL[T], 0, 0, 0); } } while (0)
#define V_TAKE(ra, la, rb, lb) do { ra = (qd & 1) ? accR[2][0] : accR[0][0]; la = (qd & 1) ? accL[2][0] : accL[0][0]; rb = (qd & 1) ? accR[3][0] : accR[1][0]; lb = (qd & 1) ? accL[3][0] : accL[1][0]; } while (0)
#define V_COMPUTE(ra0, la0, rb0, lb0, ra1, la1, rb1, lb1) do { \
        i32x4 accR[4], accL[4]; \
        v2u Ba[8], Bb[8]; \
        V_BREAD(Ba, 0); V_BREAD(Bb, 2); __builtin_amdgcn_sched_barrier(0); \
        V_MFMA2(Ba, 0, 1); __builtin_amdgcn_sched_barrier(0); \
        V_BREAD(Ba, 1); __builtin_amdgcn_sched_barrier(0); \
        V_MFMA2(Bb, 2, 0); __builtin_amdgcn_sched_barrier(0); \
        V_TAKE(ra0, la0, rb0, lb0); __builtin_amdgcn_sched_barrier(0); \
        V_BREAD(Bb, 3); __builtin_amdgcn_sched_barrier(0); \
        V_MFMA2(Ba, 1, 1); __builtin_amdgcn_sched_barrier(0); \
        V_MFMA2(Bb, 3, 0); __builtin_amdgcn_sched_barrier(0); \
        V_TAKE(ra1, la1, rb1, lb1); } while (0)
#define V_STEP(W, c8c, tc, c8n, tn, ev2, ev3, t3) do { \
        unsigned xac, xbc; f32x2 csc; \
        V_IDS(ev3, t3); V_SMALL(c8n, tn); V_XLOAD(xac, xbc, csc, tc);        \
        __builtin_amdgcn_sched_barrier(0); \
        V_WRITE(W); \
        v4u c8c_[2]; V_SPLIT(c8c_[0], c8c_[1], c8c); \
        v4u ev2_[2]; V_SPLIT(ev2_[0], ev2_[1], ev2); \
        int ra0, la0, rb0, lb0, ra1, la1, rb1, lb1; \
        V_REFILL(W, 0); V_REFILL(W, 1); V_REFILL(W, 2); V_REFILL(W, 3); __builtin_amdgcn_sched_barrier(0);        \
        V_COMPUTE(ra0, la0, rb0, lb0, ra1, la1, rb1, lb1); \
        const int ra = (qd & 2) ? ra1 : ra0, la = (qd & 2) ? la1 : la0, rb = (qd & 2) ? rb1 : rb0, lb = (qd & 2) ? lb1 : lb0;        \
        const float k0_ = csc[0], k1_ = csc[1]; \
        *(unsigned*)(YBp + (size_t)(tc) * DM) = cvtpk(bf_lo(xac) + ((float)la * k0_ - k1_), bf_hi(xac) + (float)((ra - la) >> 4) * k0_); \
        *(unsigned*)(YBp + (size_t)(tc) * DM + 32) = cvtpk(bf_lo(xbc) + ((float)lb * k0_ - k1_), bf_hi(xbc) + (float)((rb - lb) >> 4) * k0_); } while (0)
#define V_CLAMP(x) (((x) <= ulast) ? (x) : ulast)
    v4u evA, evB, WA[16], WB[16]; v4u c8A, c8B;
    int u = ufirst;
    { const int u1 = V_CLAMP(u + sl.wcount), u2 = V_CLAMP(u1 + sl.wcount);
      V_IDS(evA, TOK(u)); V_IDS(evB, TOK(u1));
      V_GATHER(WA, evA); V_GATHER(WB, evB); V_SMALL(c8A, TOK(u));
      __builtin_amdgcn_sched_barrier(0);
      V_IDS(evA, TOK(u2)); }
    for (;;) {
        { const int u1 = V_CLAMP(u + sl.wcount), u2 = V_CLAMP(u1 + sl.wcount), u3 = V_CLAMP(u2 + sl.wcount);
          V_STEP(WA, c8A, TOK(u), c8B, TOK(u1), evA, evB, TOK(u3)); }
        if (u + sl.wcount > ulast) break;
        u += sl.wcount;
        { const int u1 = V_CLAMP(u + sl.wcount), u2 = V_CLAMP(u1 + sl.wcount), u3 = V_CLAMP(u2 + sl.wcount);
          V_STEP(WB, c8B, TOK(u), c8A, TOK(u1), evB, evA, TOK(u3)); }
        if (u + sl.wcount > ulast) break;
        u += sl.wcount;
    }
#undef TOK
#undef V_IDS
#undef V_SMALL
#undef V_XLOAD
#undef V_NB
#undef V_SPLIT
#undef V_GATHER
#undef V_WRITE
#undef V_BREAD
#undef V_MFMA
#undef V_MFMA2
#undef V_TAKE
#undef V_REFILL
#undef V_COMPUTE
#undef V_STEP
#undef V_CLAMP
    }
}
__device__ __forceinline__ void final_norm_phase(const Frame& F) {
    const float* gf = F.in[22]; float* out = F.out;
    const int gw = F.vcu * NWAVES + F.wave, NGW = F.G * NWAVES, lane = F.lane;
    f32x4 gv[4];
#pragma unroll
    for (int j = 0; j < 4; ++j) gv[j] = *((const f32x4*)gf + lane + 64 * j);
    if (gw >= T) return;
    const bf16* YB = (const bf16*)(F.ws + WS_YB);
    v2u yv[4];
#pragma unroll
    for (int j = 0; j < 4; ++j) yv[j] = ((const v2u*)(YB + (size_t)gw * DM) + lane)[64 * j];
    for (int t = gw; t < T; t += NGW) {
        const int tn = (t + NGW < T) ? t + NGW : t;
        v2u yn[4];
#pragma unroll
        for (int j = 0; j < 4; ++j) yn[j] = ((const v2u*)(YB + (size_t)tn * DM) + lane)[64 * j];
        f32x4* row = (f32x4*)(out + (size_t)t * DM) + lane;
        float q = 0.f;
#pragma unroll
        for (int j = 0; j < 4; ++j) { const float a0 = bf_lo(yv[j].x), a1 = bf_hi(yv[j].x), a2 = bf_lo(yv[j].y), a3 = bf_hi(yv[j].y); q += (a0 * a0 + a1 * a1) + (a2 * a2 + a3 * a3); }
        const float r = 1.0f / sqrtf(wave_sum_dpp(q) * (1.0f / DM) + EPS);
#pragma unroll
        for (int j = 0; j < 4; ++j) { const f32x4 v = {bf_lo(yv[j].x), bf_hi(yv[j].x), bf_lo(yv[j].y), bf_hi(yv[j].y)}; __builtin_nontemporal_store(v * r * gv[j], &row[64 * j]); }
#pragma unroll
        for (int j = 0; j < 4; ++j) yv[j] = yn[j];
    }
}
}
struct Args { const float* in[23]; float* out; unsigned char* ws; };
constexpr int N_PHASES = 8;

template <int K> __device__ __forceinline__ void run_phase(Frame& F) {
    asm volatile("" : "+v"(F.tid), "+v"(F.lane));
    unsigned char* ws = F.ws;
    if constexpr (K == 0) { p0_prologue(F); }
    if constexpr (K == 13) { p0b_quant_weights(F); }
    if constexpr (K == 1) {
        pg8::Gemm g{(const pg8::bf16_t*)(ws + WS_XB), (const pg8::bf16_t*)(ws + WS_W1Q), T, N1, DM / 2};
        pg8::StaticOrder S; S.init(T, N1, F.G, (int)blockIdx.x);
        EpiP1 E{ws, F.in[15], (const float*)(ws + WS_ROPE), (const float*)(ws + WS_XS), (const float*)(ws + WS_WSC)};
        pg8::gemm_phase<EpiP1, pg8::StaticOrder, true, true>(F.lds, g, S, E);
    }
    if constexpr (K == 2) {
        const float lam = ((const float*)(ws + WS_MISC))[0];
        for (int pi = F.vcu; pi < 512; pi += F.G) {
            const int bh = pi >> 5, s = pi & 31;
            att::attn_unit<0>(F, bh >> 2, bh & 3, 63 - s, (bf16*)(ws + WS_Q), (const bf16*)(ws + WS_K), (const bf16*)(ws + WS_V), lam, F.in[7]);
            att::attn_unit<0>(F, bh >> 2, bh & 3, s, (bf16*)(ws + WS_Q), (const bf16*)(ws + WS_K), (const bf16*)(ws + WS_V), lam, F.in[7]);
        }
#ifndef NO_SGU
        for (int u = F.vcu; u < T / 128; u += F.G)
            sgu::sgu_unit(F, u, (bf16*)(ws + WS_SU), (const bf16*)(ws + WS_SV), (const bf16*)(ws + WS_WSM), F.in[8], F.in[9], F.in[11]);
#endif
    }
#ifdef ATT_PROBE
    if constexpr (K == 11) {
        const float lam = ((const float*)(ws + WS_MISC))[0];
        for (int pi = F.vcu; pi < 512; pi += F.G) {
            const int bh = pi >> 5, s = pi & 31;
            att::attn_unit<ATT_PROBE>(F, bh >> 2, bh & 3, 63 - s, (bf16*)(ws + WS_Q), (const bf16*)(ws + WS_K), (const bf16*)(ws + WS_V), lam, F.in[7]);
            att::attn_unit<ATT_PROBE>(F, bh >> 2, bh & 3, s, (bf16*)(ws + WS_Q), (const bf16*)(ws + WS_K), (const bf16*)(ws + WS_V), lam, F.in[7]);
        }
    }
#endif
    if constexpr (K == 3) {
#ifdef P3_STAGGER
        if (F.vcu & 1) { for (int i_ = 0; i_ < P3_STAGGER; ++i_) __builtin_amdgcn_s_sleep(127); }
#endif
        pg8::Gemm g{(const pg8::bf16_t*)(ws + WS_Q), (const pg8::bf16_t*)(ws + WS_WAB), 2 * T, 2048, 512};
        BranchOrder S; S.so.init(T, DM, F.G, (int)blockIdx.x);
        EpiGate E{(bf16*)(ws + WS_G), (const unsigned char*)(ws + WS_GATES)};
        pg8::gemm_phase<EpiGate, BranchOrder, true, true>(F.lds, g, S, E);
    }
    if constexpr (K == 4) {
        pg8::Gemm g{(const pg8::bf16_t*)(ws + WS_G), (const pg8::bf16_t*)(ws + WS_WO2), T, DM, DM};
        pg8::StaticOrder S; S.init(T, DM, F.G, (int)blockIdx.x);
        EpiX1 E{F.in[0], F.out, (bf16*)(ws + WS_XB), (float*)(ws + WS_SSQ)};
        pg8::gemm_phase<EpiX1, pg8::StaticOrder, true, true>(F.lds, g, S, E);
    }
    if constexpr (K == 5) {
        pg8::Gemm g{(const pg8::bf16_t*)(ws + WS_XB), (const pg8::bf16_t*)(ws + WS_WEF), T, 2048, DM};
        pg8::StaticOrder S; S.init(T, 2048, F.G, (int)blockIdx.x);
        EpiScores E{(unsigned short*)(ws + WS_SCORES)};
        pg8::gemm_phase<EpiScores, pg8::StaticOrder, true, true>(F.lds, g, S, E);
    }
    if constexpr (K == 6) { peer::topk_phase(F); }
    if constexpr (K == 7) { peer::expert_u_phase(F, 0, T); }
    if constexpr (K == 8) { peer::expert_coef_phase(F, 0, T); }
    if constexpr (K == 9) { peer::expert_v_phase(F, 0, T); }
    if constexpr (K == 10) { peer::final_norm_phase(F); }
}

#ifndef PROGRAM
#define PROGRAM P(0) S0 P(13) S P(1) S P(2) S P(3) S P(4) S P(5) S P(6) S P(7) S P(8) S P(9) S P(10)
#endif

__global__ void __launch_bounds__(NWAVES * 64, 2) mk_fwd(Args args) {
    extern __shared__ __attribute__((aligned(16))) unsigned char lds[];
    cg::grid_group grid = cg::this_grid();
    Frame F;
    F.lds = (LAS unsigned char*)lds;
    F.tid = threadIdx.x; F.lane = F.tid & 63; F.wave = __builtin_amdgcn_readfirstlane(F.tid >> 6);
    F.G = gridDim.x; { const int bx = blockIdx.x; F.vcu = (F.G % 8 == 0) ? (bx % 8) * (F.G / 8) + bx / 8 : bx; }
#pragma unroll
    for (int i = 0; i < 23; ++i) F.in[i] = args.in[i];
    F.out = args.out; F.ws = args.ws;
    volatile LAS unsigned* bst = (volatile LAS unsigned*)(F.lds + BAR_LDS_OFF);
    if (F.tid < 2) bst[F.tid] = 0u;
    __syncthreads();
    unsigned* const barw = (unsigned*)(F.ws + WS_CTL) + CW_BAR;
    if (blockIdx.x == 0) { for (int i_ = F.tid; i_ < XCD_BAR_WORDS; i_ += NWAVES * 64) barw[i_] = 0u; }
    XcdBarrier bar;
#define P(k) run_phase<k>(F);
#define S0 { __syncthreads(); grid.sync(); bar = xcd_barrier_post(barw, bst); }
#define S { xcd_barrier(bar); }
    PROGRAM
#undef P
#undef S
#undef S0
}

#if DBG
struct DumpEnt { unsigned long long off; unsigned n; int type; };
struct DumpArgs { DumpEnt e[10]; int cnt; int pad; unsigned char* ws; float* out; };
__global__ void dbg_dump(DumpArgs a) {
    const unsigned NOUT = (unsigned)T * DM;
    for (unsigned i = blockIdx.x * blockDim.x + threadIdx.x; i < NOUT; i += gridDim.x * blockDim.x) {
        float acc = 0.f;
        for (int k = 0; k < a.cnt; ++k) {
            const DumpEnt en = a.e[k];
            const unsigned char* base = (en.off == ~0ull) ? (const unsigned char*)a.out : a.ws + en.off;
            for (unsigned j = i; j < en.n; j += NOUT) {
                float v;
                if (en.type == 0) v = bf2f(((const bf16*)base)[j]); else if (en.type == 1) v = ((const float*)base)[j]; else v = (float)((const int*)base)[j];
                acc += v;
            }
        }
        a.out[i] = acc;
    }
}
#endif
extern "C" void kernel_launch(void* const* d_in, const int* in_sizes, int n_in, void* d_out, int out_size, void* d_ws, size_t ws_size, hipStream_t stream) {
    static int grid = 0;
    if (grid == 0) {
        if (n_in != 23 || in_sizes[0] != T * DM || out_size != T * DM || ws_size < WS_END) { fprintf(stderr, "kernel_launch: unexpected shapes (n_in %d, in0 %d, out %d, ws %zu)\n", n_in, n_in > 0 ? in_sizes[0] : -1, out_size, ws_size); grid = -1; return; }
        int dev = 0, cus = 0, per_cu = 0;
        if (hipGetDevice(&dev) != hipSuccess || hipDeviceGetAttribute(&cus, hipDeviceAttributeMultiprocessorCount, dev) != hipSuccess) { grid = -1; return; }
        if (hipFuncSetAttribute((const void*)mk_fwd, hipFuncAttributeMaxDynamicSharedMemorySize, LDS_BYTES) != hipSuccess) { fprintf(stderr, "kernel_launch: hipFuncSetAttribute failed\n"); grid = -1; return; }
        if (hipOccupancyMaxActiveBlocksPerMultiprocessor(&per_cu, (const void*)mk_fwd, NWAVES * 64, LDS_BYTES) != hipSuccess || per_cu < 1) { fprintf(stderr, "kernel_launch: occupancy query says %d\n", per_cu); per_cu = 1; }
        (void)hipGetLastError();
        grid = cus;
    }
    if (grid < 0) return;
    Args a{};
    for (int i = 0; i < 23; ++i) a.in[i] = (const float*)d_in[i];
    a.out = (float*)d_out; a.ws = (unsigned char*)d_ws;
    void* kargs[] = {&a};
    hipError_t e = hipLaunchCooperativeKernel((const void*)mk_fwd, dim3(grid), dim3(NWAVES * 64), kargs, LDS_BYTES, stream);
    if (e != hipSuccess) fprintf(stderr, "kernel_launch: cooperative launch failed: %s (grid %d)\n", hipGetErrorString(e), grid);
#if DBG
    const int last_phase = (DBG - 1) % 10;
#endif
#if DBG
    {
        DumpArgs d{}; d.ws = (unsigned char*)d_ws; d.out = (float*)d_out; int c = 0;
        auto add = [&](unsigned long long off, unsigned n, int type) { d.e[c].off = off; d.e[c].n = n; d.e[c].type = type; ++c; };
        const unsigned M1 = 1u << 20;
        switch (last_phase) {
            case 0: if (DBG >= 10) { add(WS_W1T, 4608 * 1024, 0); break; } add(WS_XB, 32 * M1, 0); add(WS_W1T, 4608 * 1024, 0); add(WS_WAB, M1, 0); add(WS_WO2, 2 * M1, 0); add(WS_WEF, 2 * M1, 0);  add(WS_ROPE, 512 * 1024, 1); add(WS_WSM, 65536, 0); add(WS_MISC, 1, 1); break;
            case 1: if (DBG < 10) { add(WS_Q, 16 * M1, 0); add(WS_SU, 16 * M1, 0); add(WS_GATES, 64 * M1, 0); add(WS_K, 16 * M1, 0); add(WS_V, 16 * M1, 0); add(WS_SV, 16 * M1, 0); }
                    else if (DBG < 20) add(WS_GATES, 64 * M1, 0);
                    else if (DBG < 30) { add(WS_Q, 16 * M1, 0); add(WS_K, 16 * M1, 0); }
                    else if (DBG < 40) { add(WS_V, 16 * M1, 0); }
                    else { add(WS_SU, 16 * M1, 0); add(WS_SV, 16 * M1, 0); } break;
            case 2: if (DBG < 10) { add(WS_Q, 16 * M1, 0); add(WS_SU, 16 * M1, 0); } else if (DBG < 20) add(WS_Q, 16 * M1, 0); else add(WS_SU, 16 * M1, 0); break;
            case 3: add(WS_G, 64 * M1, 0); break;
            case 4: add(~0ull, 32 * M1, 1); add(WS_XB, 32 * M1, 0); add(WS_SSQ, 512 * 1024, 1); break;
            case 5: add(WS_SCORES, 64 * M1, 1); break;
            case 6: add(WS_IDX, 4 * M1, 2); add(WS_GW, 4 * M1, 1); break;
            default: break;
        }
        d.cnt = c;
        if (c) hipLaunchKernelGGL(dbg_dump, dim3(2048), dim3(256), 0, stream, d);
    }
#endif
}
```
